# Optimizing an MI355X kernel written in HIP

```python
import math
import jax, jax.numpy as jnp
from jax import lax
import numpy as np

D_MODEL = 1024
BATCH = 8
SEQ = 2048
DEPTH = 4

DIFF_HEADS = 4
DIFF_QK_DIM = 64
DIFF_V_DIM = 2 * DIFF_QK_DIM
DIFF_WIDTH = DIFF_HEADS * DIFF_V_DIM
MLA_HEADS = 8
MLA_NOPE_DIM = 64
MLA_ROPE_DIM = 32
MLA_V_DIM = 64
MLA_Q_RANK = 384
MLA_KV_RANK = 256
MLA_WIDTH = MLA_HEADS * MLA_V_DIM
MIX_WIDTH = DIFF_WIDTH + MLA_WIDTH
ROPE_THETA = 10000.0
IN_DQ = DIFF_HEADS * 2 * DIFF_QK_DIM
IN_DK = DIFF_HEADS * 2 * DIFF_QK_DIM
IN_DV = DIFF_WIDTH
IN_MQ = MLA_Q_RANK
IN_MKV = MLA_KV_RANK + MLA_ROPE_DIM
IN_WIDTH = IN_DQ + IN_DK + IN_DV + IN_MQ + IN_MKV
N_BUCKETS = 32
MAX_EXACT = 16
MAX_DISTANCE = 128
D_FF = 2816
N_EXPERTS = 8
TOP_K = 2
Q_BLOCK = 128
NORM_EPS = 1e-6
ADA_CHUNKS = 6

kernel_name = 'hybrid_diffattn_mla_moe_adaln'


def rms_norm(x, g):
    xf = x.astype(jnp.float32)
    y = xf * lax.rsqrt(jnp.mean(xf * xf, axis=-1, keepdims=True) + NORM_EPS)
    return (y * g.astype(jnp.float32)).astype(x.dtype)


def rel_bucket(dist):
    n = jnp.maximum(dist, 0)
    nf = jnp.maximum(n, 1).astype(jnp.float32)
    large = MAX_EXACT + (jnp.log(nf / MAX_EXACT) / math.log(MAX_DISTANCE / MAX_EXACT)
                         * (N_BUCKETS - MAX_EXACT)).astype(jnp.int32)
    large = jnp.minimum(large, N_BUCKETS - 1)
    return jnp.where(n < MAX_EXACT, n, large)


def rope(x, positions):
    half = MLA_ROPE_DIM // 2
    inv_freq = ROPE_THETA ** (-jnp.arange(half, dtype=jnp.float32) / half)
    ang = positions.astype(jnp.float32)[..., None] * inv_freq
    ang = ang.reshape(ang.shape[:2] + (1,) * (x.ndim - 3) + (half,))
    cos = jnp.cos(ang).astype(x.dtype)
    sin = jnp.sin(ang).astype(x.dtype)
    x1, x2 = x[..., :half], x[..., half:]
    return jnp.concatenate([x1 * cos - x2 * sin, x2 * cos + x1 * sin], axis=-1)


def diff_attention(q, k, v, lam, positions, rel_bias):
    s = q.shape[1]
    scale = DIFF_QK_DIM ** -0.5
    outs = []
    for i in range(s // Q_BLOCK):
        q0, q1 = i * Q_BLOCK, (i + 1) * Q_BLOCK
        qb, kp, vp = q[:, q0:q1], k[:, :q1], v[:, :q1]
        dist = positions[:, q0:q1, None] - positions[:, None, :q1]
        bias = jnp.transpose(rel_bias[rel_bucket(dist)], (0, 3, 1, 2)).astype(jnp.float32)
        causal = jnp.arange(q0, q1)[:, None] >= jnp.arange(q1)[None, :]
        logits = jnp.einsum('bqhmd,bkhmd->bhmqk', qb, kp).astype(jnp.float32) * scale + bias[:, :, None]
        logits = jnp.where(causal, logits, -jnp.inf)
        p = jax.nn.softmax(logits, axis=-1)
        a = p[:, :, 0] - lam * p[:, :, 1]
        outs.append(jnp.einsum('bhqk,bkhd->bqhd', a.astype(v.dtype), vp))
    return jnp.concatenate(outs, axis=1)


def mla_attention(q_nope, q_rope, k_nope, k_rope, v):
    s = q_nope.shape[1]
    scale = (MLA_NOPE_DIM + MLA_ROPE_DIM) ** -0.5
    outs = []
    for i in range(s // Q_BLOCK):
        q0, q1 = i * Q_BLOCK, (i + 1) * Q_BLOCK
        causal = jnp.arange(q0, q1)[:, None] >= jnp.arange(q1)[None, :]
        logits = (jnp.einsum('bqhd,bkhd->bhqk', q_nope[:, q0:q1], k_nope[:, :q1])
                  + jnp.einsum('bqhr,bkr->bhqk', q_rope[:, q0:q1], k_rope[:, :q1])).astype(jnp.float32) * scale
        logits = jnp.where(causal, logits, -jnp.inf)
        p = jax.nn.softmax(logits, axis=-1)
        outs.append(jnp.einsum('bhqk,bkhd->bqhd', p.astype(v.dtype), v[:, :q1]))
    return jnp.concatenate(outs, axis=1)


def token_mixer(h, positions, layer, w_in, diff_lambda, diff_subln_g, rel_bias,
                mla_q_norm, w_uq, mla_kv_norm, w_ukv, w_o):
    b, s, _ = h.shape
    proj = h @ w_in
    cuts = [IN_DQ, IN_DQ + IN_DK, IN_DQ + IN_DK + IN_DV, IN_DQ + IN_DK + IN_DV + IN_MQ]
    dq, dk, dv, mq, mkv = jnp.split(proj, cuts, axis=-1)
    lam_init = 0.8 - 0.6 * math.exp(-0.3 * layer)
    lv = diff_lambda.astype(jnp.float32)
    lam = jnp.exp(jnp.sum(lv[0] * lv[1])) - jnp.exp(jnp.sum(lv[2] * lv[3])) + lam_init
    o_diff = diff_attention(dq.reshape(b, s, DIFF_HEADS, 2, DIFF_QK_DIM),
                            dk.reshape(b, s, DIFF_HEADS, 2, DIFF_QK_DIM),
                            dv.reshape(b, s, DIFF_HEADS, DIFF_V_DIM),
                            lam, positions, rel_bias)
    o_diff = (rms_norm(o_diff, diff_subln_g) * (1.0 - lam_init)).reshape(b, s, DIFF_WIDTH)
    q = (rms_norm(mq, mla_q_norm) @ w_uq).reshape(b, s, MLA_HEADS, MLA_NOPE_DIM + MLA_ROPE_DIM)
    q_nope = q[..., :MLA_NOPE_DIM]
    q_rope = rope(q[..., MLA_NOPE_DIM:], positions)
    kv = (rms_norm(mkv[..., :MLA_KV_RANK], mla_kv_norm) @ w_ukv).reshape(b, s, MLA_HEADS, MLA_NOPE_DIM + MLA_V_DIM)
    k_nope, v = kv[..., :MLA_NOPE_DIM], kv[..., MLA_NOPE_DIM:]
    k_rope = rope(mkv[..., MLA_KV_RANK:], positions)
    o_mla = mla_attention(q_nope, q_rope, k_nope, k_rope, v).reshape(b, s, MLA_WIDTH)
    return jnp.concatenate([o_diff, o_mla], axis=-1) @ w_o


def swiglu(h, w1, w3, w2):
    return (jax.nn.silu(h @ w1) * (h @ w3)) @ w2


def moe_ffn(h, w_router, w1, w3, w2):
    logits = (h @ w_router).astype(jnp.float32)
    top_v, top_i = lax.top_k(logits, TOP_K)
    top_w = jax.nn.softmax(top_v, axis=-1)
    gates = jnp.sum(jax.nn.one_hot(top_i, N_EXPERTS, dtype=jnp.float32) * top_w[..., None], axis=-2)
    y = jnp.zeros_like(h)
    for e in range(N_EXPERTS):
        y = y + gates[..., e:e + 1].astype(h.dtype) * swiglu(h, w1[e], w3[e], w2[e])
    return y


def setup_inputs(seed: int = 0) -> dict:
    key = jax.random.key(seed)
    ks = jax.random.split(key, 32)
    n_dense = (DEPTH + 1) // 2
    n_moe = DEPTH // 2
    f32 = jnp.float32

    def nrm(k, shape, scale):
        return jax.random.normal(k, shape, f32) * scale

    def gain(k, shape):
        return 1.0 + 0.01 * jax.random.normal(k, shape, f32)

    x = jax.random.normal(ks[0], (BATCH, SEQ, D_MODEL), f32)
    c = jax.random.normal(ks[1], (BATCH, D_MODEL), f32)
    offsets = jax.random.randint(ks[2], (BATCH, 1), 0, 4096, dtype=jnp.int32)
    positions = offsets + jnp.arange(SEQ, dtype=jnp.int32)[None, :]
    return {
        'x': x,
        'c': c,
        'positions': positions,
        'w_ada': nrm(ks[3], (DEPTH, D_MODEL, ADA_CHUNKS * D_MODEL), 0.1 * D_MODEL ** -0.5),
        'b_ada': nrm(ks[4], (DEPTH, ADA_CHUNKS * D_MODEL), 0.01),
        'g_attn': gain(ks[5], (DEPTH, D_MODEL)),
        'w_in': nrm(ks[6], (DEPTH, D_MODEL, IN_WIDTH), D_MODEL ** -0.5),
        'diff_lambda': nrm(ks[7], (DEPTH, 4, DIFF_QK_DIM), 0.1),
        'diff_subln_g': gain(ks[8], (DEPTH, DIFF_V_DIM)),
        'rel_bias': nrm(ks[9], (N_BUCKETS, DIFF_HEADS), 0.5),
        'mla_q_norm': gain(ks[10], (DEPTH, MLA_Q_RANK)),
        'w_uq': nrm(ks[11], (DEPTH, MLA_Q_RANK, MLA_HEADS * (MLA_NOPE_DIM + MLA_ROPE_DIM)), MLA_Q_RANK ** -0.5),
        'mla_kv_norm': gain(ks[12], (DEPTH, MLA_KV_RANK)),
        'w_ukv': nrm(ks[13], (DEPTH, MLA_KV_RANK, MLA_HEADS * (MLA_NOPE_DIM + MLA_V_DIM)), MLA_KV_RANK ** -0.5),
        'w_o': nrm(ks[14], (DEPTH, MIX_WIDTH, D_MODEL), MIX_WIDTH ** -0.5),
        'g_ffn': gain(ks[15], (DEPTH, D_MODEL)),
        'ffn_w1': nrm(ks[16], (n_dense, D_MODEL, D_FF), D_MODEL ** -0.5),
        'ffn_w3': nrm(ks[17], (n_dense, D_MODEL, D_FF), D_MODEL ** -0.5),
        'ffn_w2': nrm(ks[18], (n_dense, D_FF, D_MODEL), D_FF ** -0.5),
        'moe_router': nrm(ks[19], (n_moe, D_MODEL, N_EXPERTS), D_MODEL ** -0.5),
        'moe_w1': nrm(ks[20], (n_moe, N_EXPERTS, D_MODEL, D_FF), D_MODEL ** -0.5),
        'moe_w3': nrm(ks[21], (n_moe, N_EXPERTS, D_MODEL, D_FF), D_MODEL ** -0.5),
        'moe_w2': nrm(ks[22], (n_moe, N_EXPERTS, D_FF, D_MODEL), D_FF ** -0.5),
        'g_final': gain(ks[23], (D_MODEL,)),
    }


def reference(x, c, positions, w_ada, b_ada, g_attn, w_in, diff_lambda, diff_subln_g, rel_bias,
              mla_q_norm, w_uq, mla_kv_norm, w_ukv, w_o, g_ffn, ffn_w1, ffn_w3, ffn_w2,
              moe_router, moe_w1, moe_w3, moe_w2, g_final):
    cond = jax.nn.silu(c)
    for l in range(DEPTH):
        mod = cond @ w_ada[l] + b_ada[l]
        sh_a, sc_a, gt_a, sh_f, sc_f, gt_f = jnp.split(mod[:, None, :], ADA_CHUNKS, axis=-1)
        h = rms_norm(x, g_attn[l]) * (1.0 + sc_a) + sh_a
        x = x + (1.0 + gt_a) * token_mixer(h, positions, l, w_in[l], diff_lambda[l], diff_subln_g[l],
                                           rel_bias, mla_q_norm[l], w_uq[l], mla_kv_norm[l],
                                           w_ukv[l], w_o[l])
        h = rms_norm(x, g_ffn[l]) * (1.0 + sc_f) + sh_f
        if l % 2 == 0:
            y = swiglu(h, ffn_w1[l // 2], ffn_w3[l // 2], ffn_w2[l // 2])
        else:
            y = moe_ffn(h, moe_router[l // 2], moe_w1[l // 2], moe_w3[l // 2], moe_w2[l // 2])
        x = x + (1.0 + gt_f) * y
    return rms_norm(x, g_final)
```

```cpp
#include <hip/hip_runtime.h>
#include <cstdio>
#include <cstdint>

#ifndef PROBE_DUP
#define PROBE_DUP 0
#endif
#ifndef PROBE_ABL
#define PROBE_ABL -1
#endif
#define PREPS(bit) (((PROBE_DUP >> (bit)) & 1) ? 2 : 1)
#ifndef F8_UP
#define F8_UP 2
#endif
#ifndef IN_I8
#define IN_I8 1
#endif
#ifndef MK_SPLIT
#define MK_SPLIT 0
#endif

constexpr int DM = 1024, NB = 8, SEQ = 2048, DEPTH = 4, M = NB * SEQ;
constexpr int INW = 2208, INP = 2304;
constexpr int C_DQ = 0, C_DK = 512, C_DV = 1024, C_MQ = 1536, C_MKV = 1920, C_KR = 2176;
constexpr int QR = 384, KVR = 256, NQ = 768, NKV = 1024;
constexpr int DFF = 2816, NEXP = 8;
constexpr int SLOTS = 34816;
constexpr float EPS = 1e-6f, LOG2E = 1.4426950408889634f;
constexpr float C2D = 0.125f * LOG2E;
constexpr float C2M = 0.10206207261596577f * LOG2E;
constexpr int F8_W_LOG2 = 7, F8_H_LOG2 = 4, F8_U_LOG2 = 2;
constexpr float WSCALE = 128.f, HSCALE = 16.f, USCALE = 4.f;
constexpr int NPH_L = 9, NPHASE = 2 + NPH_L * DEPTH;

constexpr size_t MiB = 1u << 20;
constexpr size_t WS_CTL = 0, CTL_ZERO_BYTES = 1 * MiB;
constexpr size_t WS_MOD = 1 * MiB;
constexpr size_t WS_CS = 2 * MiB;
constexpr size_t WS_ROWSS = 4 * MiB;
constexpr size_t WS_ROUTE = 6 * MiB;
constexpr size_t WS_GSLOT = 7 * MiB;
constexpr size_t WS_MISC = 7 * MiB + 512 * 1024;
constexpr size_t WS_WSC = WS_MISC + 65536;
constexpr size_t WS_WSC2 = WS_GSLOT + 400 * 1024;
constexpr size_t WS_ASL = WS_GSLOT + 256 * 1024;
constexpr size_t WS_WIN = 8 * MiB;
constexpr size_t WS_WUQ = 26 * MiB;
constexpr size_t WS_WUKV = 29 * MiB;
constexpr size_t WS_WO = 31 * MiB;
constexpr size_t WS_WD13 = 39 * MiB;
constexpr size_t WS_WD2 = 61 * MiB;
constexpr size_t WS_WM13 = 72 * MiB;
constexpr size_t WS_WM2 = 248 * MiB;
constexpr size_t WS_H = 336 * MiB;
constexpr size_t WS_ACT = 368 * MiB;
constexpr size_t WS_PROJ = WS_ACT;
constexpr size_t WS_QM = WS_ACT + 72 * MiB;
constexpr size_t WS_KN = WS_ACT + 96 * MiB;
constexpr size_t WS_VM = WS_ACT + 112 * MiB;
constexpr size_t WS_AO = WS_ACT + 128 * MiB;
constexpr size_t WS_STASH = WS_ACT + 160 * MiB;
constexpr size_t WS_U = WS_ACT;
constexpr size_t WS_HPERM = WS_ACT + 188 * MiB;
constexpr size_t WS_YP = WS_ACT + 256 * MiB;
constexpr size_t WS_XB = WS_ACT + 324 * MiB;
constexpr size_t WS_END = WS_XB + 32 * MiB;
constexpr int CW_TMO = 0, CW_CODE = 1;
constexpr int CW_BAR = 4096;
constexpr int CW_QCTR = 8192;
constexpr int CW_CNT = 8704;

constexpr int RING_BYTES = 131072, LDSCTL_OFF = RING_BYTES, MISC_OFF = LDSCTL_OFF + 320, LDS_BYTES = 147456;

#define GAS __attribute__((address_space(1)))
#define LAS __attribute__((address_space(3)))
typedef unsigned short bf16_t;
typedef short bf16x8 __attribute__((ext_vector_type(8)));
typedef short s16x4 __attribute__((ext_vector_type(4)));
typedef float f32x4 __attribute__((ext_vector_type(4)));
typedef float f32x2 __attribute__((ext_vector_type(2)));
typedef float f32x16 __attribute__((ext_vector_type(16)));
typedef unsigned u32x4 __attribute__((ext_vector_type(4)));
typedef unsigned u32x8 __attribute__((ext_vector_type(8)));
typedef unsigned u32x2 __attribute__((ext_vector_type(2)));
typedef GAS unsigned gu32;
#define RLX_AGENT __ATOMIC_RELAXED, __HIP_MEMORY_SCOPE_AGENT
#define LDS_WAIT() asm volatile("s_waitcnt lgkmcnt(0)" ::: "memory")
#define VM_WAIT() asm volatile("s_waitcnt vmcnt(0)" ::: "memory")

__device__ __forceinline__ unsigned cvt_pk_bf16(float lo, float hi) { unsigned r; asm volatile("v_cvt_pk_bf16_f32 %0, %1, %2" : "=v"(r) : "v"(lo), "v"(hi)); return r; }
__device__ __forceinline__ unsigned pk_fp8x4(float a, float b, float c, float d) {
    a = __builtin_amdgcn_fmed3f(a, -448.f, 448.f); b = __builtin_amdgcn_fmed3f(b, -448.f, 448.f); c = __builtin_amdgcn_fmed3f(c, -448.f, 448.f); d = __builtin_amdgcn_fmed3f(d, -448.f, 448.f);
    int w = 0; w = __builtin_amdgcn_cvt_pk_fp8_f32(a, b, w, false); w = __builtin_amdgcn_cvt_pk_fp8_f32(c, d, w, true); return (unsigned)w; }
__device__ __forceinline__ float bf_lo(unsigned w) { return __uint_as_float(w << 16); }
__device__ __forceinline__ float bf_hi(unsigned w) { return __uint_as_float(w & 0xffff0000u); }
template <int K> __device__ __forceinline__ float sx(float v) { return __int_as_float(__builtin_amdgcn_ds_swizzle(__float_as_int(v), (K << 10) | 0x1f)); }
__device__ __forceinline__ float x32_sum(float v) { auto rr = __builtin_amdgcn_permlane32_swap(__float_as_uint(v), __float_as_uint(v), false, false); return __uint_as_float(rr[0]) + __uint_as_float(rr[1]); }
__device__ __forceinline__ float wave_max(float v) { v = fmaxf(v, sx<1>(v)); v = fmaxf(v, sx<2>(v)); v = fmaxf(v, sx<4>(v)); v = fmaxf(v, sx<8>(v)); v = fmaxf(v, sx<16>(v));
    auto rr = __builtin_amdgcn_permlane32_swap(__float_as_uint(v), __float_as_uint(v), false, false); return fmaxf(__uint_as_float(rr[0]), __uint_as_float(rr[1])); }
__device__ __forceinline__ unsigned pk_i8x4(float a, float b, float c, float d) {
    const int ia = (int)__builtin_rintf(a), ib = (int)__builtin_rintf(b), ic = (int)__builtin_rintf(c), id = (int)__builtin_rintf(d);
    return (unsigned)(ia & 0xff) | ((unsigned)(ib & 0xff) << 8) | ((unsigned)(ic & 0xff) << 16) | ((unsigned)id << 24); }
__device__ __forceinline__ float wave_sum(float v) { v += sx<1>(v); v += sx<2>(v); v += sx<4>(v); v += sx<8>(v); v += sx<16>(v); return x32_sum(v); }


__device__ __forceinline__ int otid(int wv) { int l; asm volatile("v_mbcnt_lo_u32_b32 %0, -1, 0\n\tv_mbcnt_hi_u32_b32 %0, -1, %0" : "=v"(l)); return (wv << 6) | l; }
template <class T> __device__ __forceinline__ T* optr(T* p) { asm volatile("" : "+s"(p)); return p; }
__device__ __forceinline__ int osi(int v) { asm volatile("" : "+s"(v)); return v; }
typedef __attribute__((address_space(4))) const unsigned char* kptr_t;
__device__ __forceinline__ kptr_t okarg() { kptr_t p = (kptr_t)__builtin_amdgcn_kernarg_segment_ptr(); asm volatile("" : "+s"(p)); return p; }
typedef const float* cfp_t; typedef float* fp_t; typedef unsigned char* ucp_t;
typedef __attribute__((address_space(4))) const cfp_t* k_cfp; typedef __attribute__((address_space(4))) const fp_t* k_fp; typedef __attribute__((address_space(4))) const ucp_t* k_ucp; typedef __attribute__((address_space(4))) const int* k_int;
__device__ __forceinline__ const float* karg_in(kptr_t k, int i) { return (const float*)(GAS const float*)(*(k_cfp)(k + 8 * i)); }
__device__ __forceinline__ float* karg_out(kptr_t k) { return (float*)(GAS float*)(*(k_fp)(k + 192)); }
__device__ __forceinline__ unsigned char* karg_ws(kptr_t k) { return (unsigned char*)(GAS unsigned char*)(*(k_ucp)(k + 200)); }
__device__ __forceinline__ int karg_lo(kptr_t k) { return *(k_int)(k + 208); }
__device__ __forceinline__ int karg_hi(kptr_t k) { return *(k_int)(k + 212); }
namespace pg8 {
constexpr int BM = 256, BK = 64, HALF = 128, HTB = HALF * BK * 2, STAGE_BYTES = 8 * HTB, NXCD = 8, WGM = 8;
__host__ __device__ __forceinline__ int lds_byte(int r, int c) { const int st = (r >> 4) * 2 + (c >> 5), rr = r & 15, cc = c & 31, ob = rr * 64 + cc * 2; return st * 1024 + (ob ^ (((ob >> 9) & 1) << 5)); }
__host__ __device__ __forceinline__ void stage_rc(int b, int& R, int& C) { const int st = b / 1024, sb = b % 1024, swz = sb ^ (((sb >> 9) & 1) << 5); R = (st >> 1) * 16 + swz / 64; C = (st & 1) * 32 + (swz % 64) / 2; }
__host__ __device__ __forceinline__ int perm32(int rho) { const int n = rho >> 4, i = rho & 15; return 8 * (i >> 2) + 4 * n + (i & 3); }

struct Unit { int pm, pn, e; };
struct Gemm { const bf16_t* A; const bf16_t* Bt; int lda, ldb, K; size_t estride; };

struct GroupOrder {
    int nM, nN, nwg, G, c; const int* pexp;
    __device__ __forceinline__ void init(int nM_, int nN_, int G_, int c_, const int* pexp_) { nM = nM_; nN = nN_; nwg = nM * nN; G = G_; c = c_; pexp = pexp_; }
    __device__ __forceinline__ bool next(int i, Unit& u) const {
        const long L = (long)i * G + c; if (L >= nwg) return false;
        int wgid = (int)L; { const int q = nwg / NXCD, r = nwg % NXCD, xcd = wgid % NXCD, off = wgid / NXCD; wgid = (xcd < r ? xcd * (q + 1) : r * (q + 1) + (xcd - r) * q) + off; }
        const int nig = WGM * nN, gid = wgid / nig, fm = gid * WGM, gsz = (nM - fm) < WGM ? (nM - fm) : WGM;
        u.pm = fm + ((wgid % nig) % gsz); u.pn = (wgid % nig) / gsz;
        u.e = pexp ? __builtin_amdgcn_readfirstlane(pexp[u.pm]) : 0; return true;
    }
};

typedef int v8i32 __attribute__((ext_vector_type(8)));
typedef int i32x4 __attribute__((ext_vector_type(4)));
template <class Epi, bool ALIGN_EPI, int F8 = 0  , int SCA = 127, int SCB = 127>
__device__ __forceinline__ void gemm_phase(LAS unsigned char* lds, const Gemm g, const GroupOrder& S, const Epi& E, int wv) {
    const int tid = otid(wv), wid = wv, lane = tid & 63, wr = wid >> 2, wc = wid & 3, fr = lane & 15, fq = lane >> 4;
    const int nt = g.K / BK;
    unsigned voffA[2], voffB[2];
#pragma unroll
    for (int i = 0; i < 2; ++i) { int R, C; stage_rc(tid * 16 + i * 8192, R, C); const int Rb = Epi::PERM ? ((R & ~31) + perm32(R & 31)) : R;
        voffA[i] = (unsigned)(R * g.lda + C) * 2u; voffB[i] = (unsigned)(Rb * g.ldb + C) * 2u; }
    const size_t kstep = (size_t)(BK * 2);
    const size_t hstepA = (size_t)HALF * g.lda * 2, hstepB = (size_t)HALF * g.ldb * 2;
    const size_t tstepA = 2 * hstepA, tstepB = 2 * hstepB;
    const unsigned ldsw = (unsigned)wid * 1024u;
    const int aoff = lds_byte(wr * 64 + fr, fq * 8), boff = lds_byte(wc * 32 + fr, fq * 8);
#define PG8_SA(b, h) (((b) * 2 + (h)) * HTB)
#define PG8_SB(b, h) ((4 + (b) * 2 + (h)) * HTB)
#define PG8_STAGE(bufoff, gbase, voff) do { _Pragma("unroll") for (int _i = 0; _i < 2; ++_i) { unsigned _vo = (voff)[_i]; asm volatile("" : "+v"(_vo)); \
        __builtin_amdgcn_global_load_lds((const unsigned*)((const char*)(gbase) + _vo), (LAS unsigned*)(lds + (bufoff) + ldsw + _i * 8192), 16, 0, 0); } } while (0)
#define PG8_LD2(p) __builtin_shufflevector(*(const LAS u32x4*)(p), *(const LAS u32x4*)((p) + 1024), 0, 1, 2, 3, 4, 5, 6, 7)
#define PG8_LDA(dst, b, h) do { _Pragma("unroll") for (int m = 0; m < 4; ++m) dst[m] = PG8_LD2(lds + PG8_SA(b, h) + aoff + m * 2048); } while (0)
#define PG8_LDB(dst, b, h) do { _Pragma("unroll") for (int n = 0; n < 2; ++n) dst[n] = PG8_LD2(lds + PG8_SB(b, h) + boff + n * 2048); } while (0)
#define PG8_LO(x) __builtin_bit_cast(bf16x8, __builtin_shufflevector(x, x, 0, 1, 2, 3))
#define PG8_HI(x) __builtin_bit_cast(bf16x8, __builtin_shufflevector(x, x, 4, 5, 6, 7))
#define PG8_MMA(ai, bj, At, Bt) do { __builtin_amdgcn_s_setprio(1); _Pragma("unroll") for (int m = 0; m < 4; ++m) _Pragma("unroll") for (int n = 0; n < 2; ++n) { \
        if constexpr (F8 == 1) acc[ai][bj][m][n] = __builtin_amdgcn_mfma_scale_f32_16x16x128_f8f6f4(__builtin_bit_cast(v8i32, Bt[n]), __builtin_bit_cast(v8i32, At[m]), acc[ai][bj][m][n], 0, 0, 0, SCB, 0, SCA); \
        else if constexpr (F8 == 2) { i32x4 c_ = __builtin_bit_cast(i32x4, acc[ai][bj][m][n]); \
               c_ = __builtin_amdgcn_mfma_i32_16x16x64_i8(__builtin_bit_cast(i32x4, PG8_LO(Bt[n])), __builtin_bit_cast(i32x4, PG8_LO(At[m])), c_, 0, 0, 0); \
               c_ = __builtin_amdgcn_mfma_i32_16x16x64_i8(__builtin_bit_cast(i32x4, PG8_HI(Bt[n])), __builtin_bit_cast(i32x4, PG8_HI(At[m])), c_, 0, 0, 0); acc[ai][bj][m][n] = __builtin_bit_cast(f32x4, c_); } \
        else { acc[ai][bj][m][n] = __builtin_amdgcn_mfma_f32_16x16x32_bf16(PG8_LO(Bt[n]), PG8_LO(At[m]), acc[ai][bj][m][n], 0, 0, 0); \
               acc[ai][bj][m][n] = __builtin_amdgcn_mfma_f32_16x16x32_bf16(PG8_HI(Bt[n]), PG8_HI(At[m]), acc[ai][bj][m][n], 0, 0, 0); } } \
        __builtin_amdgcn_s_setprio(0); } while (0)
#define PG8_WAIT_V(n) asm volatile("s_waitcnt vmcnt(" #n ")" ::: "memory")
#define PG8_WAIT_L(n) asm volatile("s_waitcnt lgkmcnt(" #n ")" ::: "memory")
#define PG8_BAR __builtin_amdgcn_s_barrier()
#define PG8_SCHED __builtin_amdgcn_sched_barrier(0)
    Unit cur, nxt; int ui = 0;
    if (!S.next(0, cur)) return;
    f32x4 acc[2][2][4][2];
#pragma unroll
    for (int a = 0; a < 2; ++a)
#pragma unroll
        for (int b = 0; b < 2; ++b)
#pragma unroll
            for (int m = 0; m < 4; ++m)
#pragma unroll
                for (int n = 0; n < 2; ++n) acc[a][b][m][n] = (f32x4){0.f, 0.f, 0.f, 0.f};
    u32x8 At[4], B0[2], B1[2];
    const char* cA = (const char*)g.A + (size_t)cur.pm * tstepA; const char* cB = (const char*)g.Bt + ((size_t)cur.e * g.estride) * 2 + (size_t)cur.pn * tstepB;
    PG8_STAGE(PG8_SB(0, 0), cB, voffB); PG8_STAGE(PG8_SB(0, 1), cB + hstepB, voffB); PG8_STAGE(PG8_SA(0, 0), cA, voffA); PG8_STAGE(PG8_SA(0, 1), cA + hstepA, voffA);
    if (wr == 1) PG8_BAR;
    PG8_WAIT_V(2); PG8_BAR;
    PG8_STAGE(PG8_SB(1, 0), cB + kstep, voffB); PG8_STAGE(PG8_SA(1, 0), cA + kstep, voffA); PG8_STAGE(PG8_SB(1, 1), cB + hstepB + kstep, voffB);
    PG8_WAIT_V(6); PG8_BAR;
    for (;;) {
        const bool has_next = S.next(ui + 1, nxt);
        const char* nA = has_next ? (const char*)g.A + (size_t)nxt.pm * tstepA : cA;
        const char* nB = has_next ? (const char*)g.Bt + ((size_t)nxt.e * g.estride) * 2 + (size_t)nxt.pn * tstepB : cB;
#pragma clang loop unroll(disable)
        for (int t = 0; t < nt; t += 2) {
            const bool last = (t == nt - 2);
            const char* a1 = cA + (size_t)(t + 1) * kstep;
            const char* a2 = last ? nA : cA + (size_t)(t + 2) * kstep; const char* b2 = last ? nB : cB + (size_t)(t + 2) * kstep;
            const char* a3 = a2 + kstep; const char* b3 = b2 + kstep;
            PG8_LDB(B0, 0, 0); PG8_LDB(B1, 0, 1); PG8_SCHED; PG8_LDA(At, 0, 0); PG8_STAGE(PG8_SA(1, 1), a1 + hstepA, voffA);
            PG8_WAIT_V(8); PG8_WAIT_L(0); PG8_BAR; PG8_MMA(0, 0, At, B0); PG8_MMA(0, 1, At, B1); PG8_BAR; PG8_SCHED;
            PG8_LDA(At, 0, 1); PG8_STAGE(PG8_SB(0, 0), b2, voffB); PG8_STAGE(PG8_SB(0, 1), b2 + hstepB, voffB); PG8_STAGE(PG8_SA(0, 0), a2, voffA);
            PG8_WAIT_V(8); PG8_WAIT_L(0); PG8_BAR; PG8_MMA(1, 0, At, B0); PG8_MMA(1, 1, At, B1); PG8_BAR; PG8_SCHED;
            PG8_LDB(B0, 1, 0); PG8_LDB(B1, 1, 1); PG8_SCHED; PG8_LDA(At, 1, 0); PG8_STAGE(PG8_SA(0, 1), a2 + hstepA, voffA);
            PG8_WAIT_V(8); PG8_WAIT_L(0); PG8_BAR; PG8_MMA(0, 0, At, B0); PG8_MMA(0, 1, At, B1); PG8_BAR; PG8_SCHED;
            PG8_LDA(At, 1, 1); PG8_STAGE(PG8_SB(1, 0), b3, voffB); PG8_STAGE(PG8_SB(1, 1), b3 + hstepB, voffB); PG8_STAGE(PG8_SA(1, 0), a3, voffA);
            PG8_WAIT_V(8); PG8_WAIT_L(0); PG8_BAR; PG8_MMA(1, 0, At, B0); PG8_MMA(1, 1, At, B1); PG8_BAR; PG8_SCHED;
        }
        if constexpr (ALIGN_EPI) { if (wr == 0) PG8_BAR; }
        { const int l2 = otid(wv) & 63; E(acc, cur, wr, wc, l2 & 15, l2 >> 4); }
        if (!has_next) break;
#pragma unroll
        for (int a = 0; a < 2; ++a)
#pragma unroll
            for (int b = 0; b < 2; ++b)
#pragma unroll
                for (int m = 0; m < 4; ++m)
#pragma unroll
                    for (int n = 0; n < 2; ++n) acc[a][b][m][n] = (f32x4){0.f, 0.f, 0.f, 0.f};
        cur = nxt; cA = nA; cB = nB; ++ui;
        if constexpr (ALIGN_EPI) { if (wr == 1) PG8_BAR; }
    }
    PG8_WAIT_V(0);
    if constexpr (!ALIGN_EPI) { if (wr == 0) PG8_BAR; }
    PG8_BAR;
#undef PG8_SA
#undef PG8_SB
#undef PG8_STAGE
#undef PG8_LDA
#undef PG8_LDB
#undef PG8_MMA
#undef PG8_LO
#undef PG8_HI
#undef PG8_LD2
#undef PG8_WAIT_V
#undef PG8_WAIT_L
#undef PG8_BAR
#undef PG8_SCHED
}

__device__ __forceinline__ void st8(bf16_t* p, f32x4 v0, f32x4 v1) {
    u32x4 w; w.x = cvt_pk_bf16(v0[0], v0[1]); w.y = cvt_pk_bf16(v0[2], v0[3]); w.z = cvt_pk_bf16(v1[0], v1[1]); w.w = cvt_pk_bf16(v1[2], v1[3]); *(u32x4*)p = w; }
__device__ __forceinline__ void rope8(f32x4& v0, f32x4& v1, const float* cs8) {
    const f32x4 c0 = *(const f32x4*)cs8, c1 = *(const f32x4*)(cs8 + 4);
    const float a0 = v0[0] * c0[0] - v0[1] * c0[1], a1 = v0[1] * c0[0] + v0[0] * c0[1];
    const float a2 = v0[2] * c0[2] - v0[3] * c0[3], a3 = v0[3] * c0[2] + v0[2] * c0[3];
    const float b0 = v1[0] * c1[0] - v1[1] * c1[1], b1 = v1[1] * c1[0] + v1[0] * c1[1];
    const float b2 = v1[2] * c1[2] - v1[3] * c1[3], b3 = v1[3] * c1[2] + v1[2] * c1[3];
    v0 = (f32x4){a0, a1, a2, a3}; v1 = (f32x4){b0, b1, b2, b3};
}

template <bool I8>
struct EpiProj {
    static constexpr bool PERM = true;
    bf16_t* P; float* rowss; const float* cs; const float* asc; const float* wsc;
    __device__ __forceinline__ void operator()(const f32x4 (&acc)[2][2][4][2], const Unit& u, int wr, int wc, int fr, int fq) const {
        const int row0 = u.pm * BM + wr * 64 + fr;
        float sa[2][4];
        if (I8) {
#pragma unroll
            for (int ai = 0; ai < 2; ++ai)
#pragma unroll
                for (int m = 0; m < 4; ++m) sa[ai][m] = asc[row0 + ai * HALF + m * 16]; }
#pragma unroll
        for (int bj = 0; bj < 2; ++bj) {
            const int cg = u.pn * BM + bj * HALF + wc * 32, col0 = cg + 8 * fq;
            const float sc = (cg < C_DK) ? C2D : 1.f;
            f32x4 sw0, sw1; if (I8) { sw0 = *(const f32x4*)(wsc + col0) * sc; sw1 = *(const f32x4*)(wsc + col0 + 4) * sc; }
            const bool do_ss = (cg >= C_MQ && cg < C_KR), do_rope = (cg == C_KR);
#pragma unroll
            for (int ai = 0; ai < 2; ++ai)
#pragma unroll
                for (int m = 0; m < 4; ++m) {
                    const int row = row0 + ai * HALF + m * 16;
                    f32x4 v0, v1;
                    if (I8) { const i32x4 i0 = __builtin_bit_cast(i32x4, acc[ai][bj][m][0]), i1 = __builtin_bit_cast(i32x4, acc[ai][bj][m][1]);
                        v0 = (f32x4){(float)i0[0], (float)i0[1], (float)i0[2], (float)i0[3]} * sw0 * sa[ai][m]; v1 = (f32x4){(float)i1[0], (float)i1[1], (float)i1[2], (float)i1[3]} * sw1 * sa[ai][m]; }
                    else { v0 = acc[ai][bj][m][0] * sc; v1 = acc[ai][bj][m][1] * sc; }
                    if (do_ss) { float s = (v0[0] * v0[0] + v0[1] * v0[1]) + (v0[2] * v0[2] + v0[3] * v0[3]) + (v1[0] * v1[0] + v1[1] * v1[1]) + (v1[2] * v1[2] + v1[3] * v1[3]);
                        s += sx<16>(s); s = x32_sum(s); if (fq == 0) rowss[(size_t)row * 20 + ((cg - C_MQ) >> 5)] = s; }
                    if (do_rope) rope8(v0, v1, cs + (size_t)row * 32 + 8 * fq);
                    st8(P + (size_t)row * INP + col0, v0, v1);
                }
        }
    }
};
struct EpiQ {
    static constexpr bool PERM = true;
    bf16_t* Q; const float* rowss; const float* cs;
    __device__ __forceinline__ void operator()(const f32x4 (&acc)[2][2][4][2], const Unit& u, int wr, int wc, int fr, int fq) const {
        const int row0 = u.pm * BM + wr * 64 + fr;
#pragma unroll
        for (int ai = 0; ai < 2; ++ai)
#pragma unroll
            for (int m = 0; m < 4; ++m) {
                const int row = row0 + ai * HALF + m * 16;
                const f32x4* rp = (const f32x4*)(rowss + (size_t)row * 20);
                const f32x4 s0 = rp[0], s1 = rp[1], s2 = rp[2];
                const float ss = ((s0[0] + s0[1]) + (s0[2] + s0[3])) + ((s1[0] + s1[1]) + (s1[2] + s1[3])) + ((s2[0] + s2[1]) + (s2[2] + s2[3]));
                const float rs = __builtin_amdgcn_rsqf(ss * (1.f / QR) + EPS) * C2M;
#pragma unroll
                for (int bj = 0; bj < 2; ++bj) {
                    const int cg = u.pn * BM + bj * HALF + wc * 32, col0 = cg + 8 * fq;
                    f32x4 v0 = acc[ai][bj][m][0] * rs, v1 = acc[ai][bj][m][1] * rs;
                    if ((cg % 96) == 64) rope8(v0, v1, cs + (size_t)row * 32 + 8 * fq);
                    st8(Q + (size_t)row * NQ + col0, v0, v1);
                }
            }
    }
};
struct EpiKV {
    static constexpr bool PERM = true;
    bf16_t* Kn; bf16_t* Vm; const float* rowss;
    __device__ __forceinline__ void operator()(const f32x4 (&acc)[2][2][4][2], const Unit& u, int wr, int wc, int fr, int fq) const {
        const int row0 = u.pm * BM + wr * 64 + fr;
        bf16_t* base = (u.pn < 2) ? Kn : Vm; const int colt = (u.pn & 1) * BM;
#pragma unroll
        for (int ai = 0; ai < 2; ++ai)
#pragma unroll
            for (int m = 0; m < 4; ++m) {
                const int row = row0 + ai * HALF + m * 16;
                const f32x4* rp = (const f32x4*)(rowss + (size_t)row * 20 + 12);
                const f32x4 s0 = rp[0], s1 = rp[1];
                const float ss = ((s0[0] + s0[1]) + (s0[2] + s0[3])) + ((s1[0] + s1[1]) + (s1[2] + s1[3]));
                const float rs = __builtin_amdgcn_rsqf(ss * (1.f / KVR) + EPS);
#pragma unroll
                for (int bj = 0; bj < 2; ++bj) {
                    const int col0 = colt + bj * HALF + wc * 32 + 8 * fq;
                    st8(base + (size_t)row * 512 + col0, acc[ai][bj][m][0] * rs, acc[ai][bj][m][1] * rs);
                }
            }
    }
};
struct EpiRes {
    static constexpr bool PERM = true;
    const float* base32; const bf16_t* base16; bf16_t* out; const float* gate;
    __device__ __forceinline__ void operator()(const f32x4 (&acc)[2][2][4][2], const Unit& u, int wr, int wc, int fr, int fq) const {
        const int row0 = u.pm * BM + wr * 64 + fr; const float* gp = gate + (size_t)(u.pm >> 3) * 6144;
#pragma unroll
        for (int bj = 0; bj < 2; ++bj) {
            const int col = u.pn * BM + bj * HALF + wc * 32 + 8 * fq;
            const f32x4 g0 = *(const f32x4*)(gp + col) + 1.0f, g1 = *(const f32x4*)(gp + col + 4) + 1.0f;
#pragma unroll
            for (int ai = 0; ai < 2; ++ai)
#pragma unroll
                for (int m = 0; m < 4; ++m) { const size_t off = (size_t)(row0 + ai * HALF + m * 16) * DM + col;
                    f32x4 b0, b1;
                    if (base32) { b0 = *(const f32x4*)(base32 + off); b1 = *(const f32x4*)(base32 + off + 4); }
                    else { const u32x4 w = *(const u32x4*)(base16 + off); b0 = (f32x4){bf_lo(w.x), bf_hi(w.x), bf_lo(w.y), bf_hi(w.y)}; b1 = (f32x4){bf_lo(w.z), bf_hi(w.z), bf_lo(w.w), bf_hi(w.w)}; }
                    st8(out + off, b0 + g0 * acc[ai][bj][m][0], b1 + g1 * acc[ai][bj][m][1]); }
        }
    }
};
template <bool I8>
struct EpiSwiGLU {
    static constexpr bool PERM = true;
    unsigned char* U;
    int dummy;
    const float* asc; const float* wsc;
    __device__ __forceinline__ void operator()(const f32x4 (&acc)[2][2][4][2], const Unit& u, int wr, int wc, int fr, int fq) const {
        if (dummy) return;
        const int row0 = u.pm * BM + wr * 64 + fr, col0 = u.pn * HALF + wc * 32 + 8 * fq;
        f32x4 sw[2][2];
        if (I8) { const float* wp = wsc + (size_t)u.e * (2 * DFF) + u.pn * BM + wc * 32 + 8 * fq;
#pragma unroll
            for (int bj = 0; bj < 2; ++bj) { sw[bj][0] = *(const f32x4*)(wp + bj * HALF); sw[bj][1] = *(const f32x4*)(wp + bj * HALF + 4); } }
#pragma unroll
        for (int ai = 0; ai < 2; ++ai)
#pragma unroll
            for (int m = 0; m < 4; ++m) {
                const int row = row0 + ai * HALF + m * 16;
                float sa = 1.f; if (I8) sa = asc[row];
                f32x4 r[2];
#pragma unroll
                for (int n = 0; n < 2; ++n) { f32x4 a = acc[ai][0][m][n], b = acc[ai][1][m][n];
                    if (I8) { const i32x4 ia = __builtin_bit_cast(i32x4, a), ib = __builtin_bit_cast(i32x4, b);
                        a = (f32x4){(float)ia[0], (float)ia[1], (float)ia[2], (float)ia[3]} * sw[0][n] * sa; b = (f32x4){(float)ib[0], (float)ib[1], (float)ib[2], (float)ib[3]} * sw[1][n] * sa; }
#pragma unroll
                    for (int k = 0; k < 4; ++k) { const float e = __builtin_amdgcn_exp2f(-a[k] * LOG2E); r[n][k] = a[k] * __builtin_amdgcn_rcpf(1.f + e) * b[k] * USCALE; } }
                u32x2 w; w.x = pk_fp8x4(r[0][0], r[0][1], r[0][2], r[0][3]); w.y = pk_fp8x4(r[1][0], r[1][1], r[1][2], r[1][3]);
                *(u32x2*)(U + (size_t)row * DFF + col0) = w;
            }
    }
};
struct EpiDown {
    static constexpr bool PERM = true;
    bf16_t* Y; const float* gslot;
    __device__ __forceinline__ void operator()(const f32x4 (&acc)[2][2][4][2], const Unit& u, int wr, int wc, int fr, int fq) const {
        const int row0 = u.pm * BM + wr * 64 + fr;
#pragma unroll
        for (int ai = 0; ai < 2; ++ai)
#pragma unroll
            for (int m = 0; m < 4; ++m) {
                const int row = row0 + ai * HALF + m * 16; const float gv = gslot ? gslot[row] : 1.f;
#pragma unroll
                for (int bj = 0; bj < 2; ++bj) st8(Y + (size_t)row * DM + u.pn * BM + bj * HALF + wc * 32 + 8 * fq, acc[ai][bj][m][0] * gv, acc[ai][bj][m][1] * gv);
            }
    }
};
}

namespace att {
constexpr int NSLOT = 4, KBMAX = 12288, VBMAX = 16384;
constexpr int OFF_V = NSLOT * KBMAX, OFF_WS = OFF_V + NSLOT * VBMAX, OFF_LUT = OFF_WS + 8 * 256, OFF_Q = OFF_LUT + 512;
static_assert(OFF_Q + 16 <= RING_BYTES, "attention LDS map");
__device__ __forceinline__ void glds16(const void* gsrc, unsigned lds_dst) { unsigned keep;
    asm volatile("s_mov_b32 %0, m0\n\ts_mov_b32 m0, %2\n\ts_nop 0\n\tglobal_load_lds_dwordx4 %1, off\n\ts_mov_b32 m0, %0" : "=&s"(keep) : "v"(gsrc), "s"(lds_dst) : "memory"); }
constexpr float THR = 8.f;
#define SBAR() __builtin_amdgcn_sched_barrier(0)
__device__ __forceinline__ int crow(int r, int hi) { return (r & 3) + 8 * (r >> 2) + 4 * hi; }
template <int DV> __device__ __forceinline__ int v_st(int k, int c) { const int kk = (k & ~0xC) | ((k & 4) << 1) | ((k & 8) >> 1); return ((kk >> 3) * (DV / 32) + (c >> 5)) * 512 + ((kk & 7) * 32 + (c & 31)) * 2; }
__device__ __forceinline__ int v_rd_base(int lane) { return ((lane & 3) << 3) | (((lane >> 2) & 3) << 6) | (((lane >> 4) & 1) << 5) | (((lane >> 5) & 1) << 8); }
template <int DV> constexpr int v_rd_off(int d0, int ks, int half) { return ((2 * ks + half) * (DV / 32) + d0) * 512; }
template <int OFF> __device__ __forceinline__ s16x4 tr_read(int vb) { s16x4 r; asm volatile("ds_read_b64_tr_b16 %0, %1 offset:%2" : "=&v"(r) : "v"(vb), "i"(OFF) : "memory"); return r; }
template <int DV, int D0> __device__ __forceinline__ void pv_one(f32x16& od, int vb, bf16x8 pa0, bf16x8 pa1, bf16x8 pa2, bf16x8 pa3) {
    const s16x4 l0 = tr_read<v_rd_off<DV>(D0, 0, 0)>(vb), h0 = tr_read<v_rd_off<DV>(D0, 0, 1)>(vb), l1 = tr_read<v_rd_off<DV>(D0, 1, 0)>(vb), h1 = tr_read<v_rd_off<DV>(D0, 1, 1)>(vb);
    const s16x4 l2 = tr_read<v_rd_off<DV>(D0, 2, 0)>(vb), h2 = tr_read<v_rd_off<DV>(D0, 2, 1)>(vb), l3 = tr_read<v_rd_off<DV>(D0, 3, 0)>(vb), h3 = tr_read<v_rd_off<DV>(D0, 3, 1)>(vb);
    asm volatile("s_waitcnt lgkmcnt(0)" ::: "memory"); SBAR();
#define PK(L, H) (bf16x8){L[0], L[1], L[2], L[3], H[0], H[1], H[2], H[3]}
    od = __builtin_amdgcn_mfma_f32_32x32x16_bf16(pa0, PK(l0, h0), od, 0, 0, 0);
    od = __builtin_amdgcn_mfma_f32_32x32x16_bf16(pa1, PK(l1, h1), od, 0, 0, 0);
    od = __builtin_amdgcn_mfma_f32_32x32x16_bf16(pa2, PK(l2, h2), od, 0, 0, 0);
    od = __builtin_amdgcn_mfma_f32_32x32x16_bf16(pa3, PK(l3, h3), od, 0, 0, 0);
#undef PK
}
template <int DV, int KS_, int D0> __device__ __forceinline__ void pv_rd(s16x4 (&lo)[DV / 32], s16x4 (&hi)[DV / 32], int vb) {
    lo[D0] = tr_read<v_rd_off<DV>(D0, KS_, 0)>(vb); hi[D0] = tr_read<v_rd_off<DV>(D0, KS_, 1)>(vb);
    if constexpr (D0 + 1 < DV / 32) pv_rd<DV, KS_, D0 + 1>(lo, hi, vb);
}
template <int DV> __device__ __forceinline__ void pv_all(f32x16 (&o)[DV / 32], f32x16& lacc, int vb, bf16x8 pa0, bf16x8 pa1, bf16x8 pa2, bf16x8 pa3) {
    constexpr int NO = DV / 32;
    const bf16x8 ones = {0x3F80, 0x3F80, 0x3F80, 0x3F80, 0x3F80, 0x3F80, 0x3F80, 0x3F80};
    s16x4 la[NO], ha[NO], lb[NO], hb[NO];
#define PK(L, H) (bf16x8){L[0], L[1], L[2], L[3], H[0], H[1], H[2], H[3]}
#define PVW(n) do { if (n == 8) asm volatile("s_waitcnt lgkmcnt(8)" ::: "memory"); else if (n == 4) asm volatile("s_waitcnt lgkmcnt(4)" ::: "memory"); else asm volatile("s_waitcnt lgkmcnt(0)" ::: "memory"); SBAR(); } while (0)
    pv_rd<DV, 0, 0>(la, ha, vb); pv_rd<DV, 1, 0>(lb, hb, vb); PVW(2 * NO);
#pragma unroll
    for (int d = 0; d < NO; ++d) o[d] = __builtin_amdgcn_mfma_f32_32x32x16_bf16(pa0, PK(la[d], ha[d]), o[d], 0, 0, 0);
    lacc = __builtin_amdgcn_mfma_f32_32x32x16_bf16(pa0, ones, lacc, 0, 0, 0);
    SBAR(); pv_rd<DV, 2, 0>(la, ha, vb); PVW(2 * NO);
#pragma unroll
    for (int d = 0; d < NO; ++d) o[d] = __builtin_amdgcn_mfma_f32_32x32x16_bf16(pa1, PK(lb[d], hb[d]), o[d], 0, 0, 0);
    lacc = __builtin_amdgcn_mfma_f32_32x32x16_bf16(pa1, ones, lacc, 0, 0, 0);
    SBAR(); pv_rd<DV, 3, 0>(lb, hb, vb); PVW(2 * NO);
#pragma unroll
    for (int d = 0; d < NO; ++d) o[d] = __builtin_amdgcn_mfma_f32_32x32x16_bf16(pa2, PK(la[d], ha[d]), o[d], 0, 0, 0);
    lacc = __builtin_amdgcn_mfma_f32_32x32x16_bf16(pa2, ones, lacc, 0, 0, 0);
    PVW(0);
#pragma unroll
    for (int d = 0; d < NO; ++d) o[d] = __builtin_amdgcn_mfma_f32_32x32x16_bf16(pa3, PK(lb[d], hb[d]), o[d], 0, 0, 0);
    lacc = __builtin_amdgcn_mfma_f32_32x32x16_bf16(pa3, ones, lacc, 0, 0, 0);
#undef PK
#undef PVW
}
__device__ __forceinline__ int rel_bucket(int n) {
    if (n < 16) return n;
    const int v = 16 + (int)(logf((float)n * (1.f / 16.f)) * (16.f / 2.0794415416798357f));
    return v < 31 ? v : 31;
}

template <int DQK, int DV, bool BIAS, int ABL = 0>
__device__ __forceinline__ void attn_core(const bf16_t* __restrict__ Qp, const bf16_t* __restrict__ K1, int ldk1, const bf16_t* __restrict__ K2, int ldk2,
                                          const bf16_t* __restrict__ Vp, int ldv, const int* __restrict__ posb, int posq, int qfirst, int qidx, int NT,
                                          const int* __restrict__ kmaxb, int qmin_w, float bias_far, LAS unsigned char* lds, int tid, int wid, int lane,
                                          f32x16 (&o)[DV / 32], f32x16& lacc) {
    constexpr int KB = 8 * DQK * 16, VB = 64 * DV * 2, ND = DQK / 16, NO = DV / 32, NVP = DV / 64;
    const int r32 = lane & 31, hi = lane >> 5, grp = wid >> 2;
    LAS unsigned char* Kl = lds; LAS unsigned char* Vl = lds + OFF_V;
    LAS float* wsc = (LAS float*)(lds + OFF_WS) + wid * 64; const LAS float* lut = (const LAS float*)(lds + OFF_LUT);
    bf16x8 qr[ND];
#pragma unroll
    for (int d0 = 0; d0 < ND; ++d0) qr[d0] = *(const bf16x8*)(Qp + d0 * 16 + hi * 8);
    float m_reg = 0.f; lacc = f32x16{};
    const u32x4 kxu = {hi == 0 ? 0xBF80BF80u : 0u, 0u, 0u, 0u}; const bf16x8 kx = __builtin_bit_cast(bf16x8, kxu);
#pragma unroll
    for (int d = 0; d < NO; ++d) o[d] = f32x16{};
    const bf16_t* ksrc = K1 + (size_t)lane * ldk1 + wid * 8;
    const bf16_t* ksrc2 = (DQK == 96) ? K2 + (size_t)lane * ldk2 + (wid & 3) * 8 : nullptr;
    const bf16_t* vsrc[NVP]; unsigned vdst[NVP];
#pragma unroll
    for (int q = 0; q < NVP; ++q) { const int p = wid * NVP + q, s = 2 * p + (lane >> 5), kk = 8 * (s / (DV / 32)) + ((lane & 31) >> 2), c = 32 * (s % (DV / 32)) + 8 * (lane & 3);
        const int k = (kk & ~0xC) | ((kk & 4) << 1) | ((kk & 8) >> 1);
        vsrc[q] = Vp + (size_t)k * ldv + c; vdst[q] = (unsigned)(uintptr_t)Vl + p * 1024; }
    const unsigned kdst = (unsigned)(uintptr_t)Kl + wid * 1024, kdst2 = (unsigned)(uintptr_t)Kl + (8 + (wid & 3)) * 1024;
    const int vb0 = (int)(unsigned)(uintptr_t)Vl + v_rd_base(lane);
#define RFL(x) ((unsigned)__builtin_amdgcn_readfirstlane((int)(x)))
#define DMA_K(t) do { if (ABL & 8) break; const int t_ = (t) < NT ? (t) : NT - 1; glds16(ksrc + (size_t)t_ * 64 * ldk1, RFL(kdst + ((t) & 3) * KB)); \
        if (DQK == 96) { if (grp == 0) glds16(ksrc2 + (size_t)t_ * 64 * ldk2, RFL(kdst2 + ((t) & 3) * KB)); } } while (0)
#define DMA_V(t) do { if (ABL & 8) break; const int t_ = (t) < NT ? (t) : NT - 1; _Pragma("unroll") for (int q = 0; q < NVP; ++q) glds16(vsrc[q] + (size_t)t_ * 64 * ldv, RFL(vdst[q] + ((t) & 3) * VB)); } while (0)
#define WAITBAR_G0() do { if (DQK == 96) asm volatile("s_waitcnt vmcnt(6) lgkmcnt(0)\n\ts_barrier" ::: "memory"); else if (NVP == 2) asm volatile("s_waitcnt vmcnt(6) lgkmcnt(0)\n\ts_barrier" ::: "memory"); \
        else asm volatile("s_waitcnt vmcnt(4) lgkmcnt(0)\n\ts_barrier" ::: "memory"); } while (0)
#define WAITBAR_G1() do { if (DQK == 96) asm volatile("s_waitcnt vmcnt(2) lgkmcnt(0)\n\ts_barrier" ::: "memory"); else if (NVP == 2) asm volatile("s_waitcnt vmcnt(3) lgkmcnt(0)\n\ts_barrier" ::: "memory"); \
        else asm volatile("s_waitcnt vmcnt(2) lgkmcnt(0)\n\ts_barrier" ::: "memory"); } while (0)
#define PBAR() asm volatile("s_waitcnt lgkmcnt(0)\n\ts_barrier" ::: "memory")
#define QKT(t) do { if (ABL & 4) { _Pragma("unroll") for (int r = 0; r < 16; ++r) { p0[r] = 0.f; p1[r] = 0.f; } break; } const LAS unsigned char* Kc = Kl + ((t) & 3) * KB + hi * 1024 + r32 * 16; \
        bool far_ = false; if (BIAS) far_ = (qmin_w - kmaxb[t]) >= 113; isfar = far_; \
          \
        { const float me = m_reg - ((BIAS && far_) ? bias_far : 0.f); const unsigned bh = cvt_pk_bf16(me, 0.f) & 0xffffu; const unsigned bl = cvt_pk_bf16(me - __uint_as_float(bh << 16), 0.f) & 0xffffu; \
          const u32x4 qx = {hi == 0 ? (bh | (bl << 16)) : 0u, 0u, 0u, 0u}; \
          p0 = __builtin_amdgcn_mfma_f32_32x32x16_bf16(kx, __builtin_bit_cast(bf16x8, qx), f32x16{}, 0, 0, 0); p1 = __builtin_amdgcn_mfma_f32_32x32x16_bf16(kx, __builtin_bit_cast(bf16x8, qx), f32x16{}, 0, 0, 0); } \
        _Pragma("unroll") for (int d0 = 0; d0 < ND; ++d0) { \
            const bf16x8 b0 = *(const LAS bf16x8*)(Kc + d0 * 2048), b1 = *(const LAS bf16x8*)(Kc + d0 * 2048 + 512); \
            p0 = __builtin_amdgcn_mfma_f32_32x32x16_bf16(b0, qr[d0], p0, 0, 0, 0); p1 = __builtin_amdgcn_mfma_f32_32x32x16_bf16(b1, qr[d0], p1, 0, 0, 0); } } while (0)
    f32x16 p0, p1; bool isfar = false; bf16x8 pa0, pa1, pa2, pa3;
    DMA_K(0); DMA_V(0); DMA_K(1); DMA_V(1); DMA_K(2);
    asm volatile("s_waitcnt vmcnt(0) lgkmcnt(0)\n\ts_barrier" ::: "memory");
    if (grp) PBAR();
    if (0 <= qfirst + 31) QKT(0);
    if (grp) WAITBAR_G1(); else PBAR();
    for (int i = 0; i < ((ABL & 16) ? 0 : NT); ++i) {
        const int kv0 = i * 64; const bool act = kv0 <= qfirst + 31;
        DMA_K(i + 3); DMA_V(i + 2);
        if (act && (ABL & 1)) { pa0 = __builtin_bit_cast(bf16x8, (f32x4){p0[0], p0[1], p0[2], p0[3]}); pa1 = __builtin_bit_cast(bf16x8, (f32x4){p0[4], p0[5], p0[6], p0[7]}); pa2 = __builtin_bit_cast(bf16x8, (f32x4){p1[0], p1[1], p1[2], p1[3]}); pa3 = __builtin_bit_cast(bf16x8, (f32x4){p1[4], p1[5], p1[6], p1[7]});
#pragma unroll
            for (int r = 0; r < 16; ++r) lacc[r] = 1.f; }
        if (act && !(ABL & 1)) {
            if (BIAS) { if (!isfar) {
                GAS const int* pb = (GAS const int*)(posb + kv0 + 4 * hi); asm volatile("" : "+v"(pb));
#pragma unroll
                for (int r = 0; r < 16; ++r) {
                    const int cr = (r & 3) + 8 * (r >> 2);
                    int d0_ = posq - pb[cr]; d0_ = d0_ < 0 ? 0 : (d0_ > 127 ? 127 : d0_);
                    int d1_ = posq - pb[cr + 32]; d1_ = d1_ < 0 ? 0 : (d1_ > 127 ? 127 : d1_);
                    p0[r] += lut[d0_]; p1[r] += lut[d1_]; } } }
            if (kv0 + 63 > qfirst) {
                int lim = qidx - kv0 - 4 * hi; asm volatile("" : "+v"(lim));
#pragma unroll
                for (int r = 0; r < 16; ++r) { const int cr = (r & 3) + 8 * (r >> 2); if (cr > lim) p0[r] = -INFINITY; if (cr + 32 > lim) p1[r] = -INFINITY; }
            }
            float pmax = p0[0];
#pragma unroll
            for (int r = 1; r < 16; ++r) pmax = fmaxf(pmax, p0[r]);
#pragma unroll
            for (int r = 0; r < 16; ++r) pmax = fmaxf(pmax, p1[r]);
            { auto rr = __builtin_amdgcn_permlane32_swap(__float_as_uint(pmax), __float_as_uint(pmax), false, false); pmax = fmaxf(__uint_as_float(rr[0]), __uint_as_float(rr[1])); }
            float alpha = 1.f;
            if (i == 0 || !__all(pmax <= THR)) { const float dl = (i == 0) ? pmax : fmaxf(pmax, 0.f); m_reg += dl; alpha = (i == 0) ? 1.f : __builtin_amdgcn_exp2f(-dl);
#pragma unroll
                for (int r = 0; r < 16; ++r) { p0[r] -= dl; p1[r] -= dl; } }
#pragma unroll
            for (int r = 0; r < 16; ++r) { p0[r] = __builtin_amdgcn_exp2f(p0[r]); p1[r] = __builtin_amdgcn_exp2f(p1[r]); }
            if (__any(alpha < 1.f)) { if (hi == 0) wsc[r32] = alpha; asm volatile("s_waitcnt lgkmcnt(0)" ::: "memory");
                const LAS float* wb = wsc + 4 * hi; asm volatile("" : "+v"(wb));
#pragma unroll
                for (int r = 0; r < 16; ++r) { const float a = wb[(r & 3) + 8 * (r >> 2)]; lacc[r] *= a;
#pragma unroll
                    for (int d = 0; d < NO; ++d) o[d][r] *= a; }
                asm volatile("s_waitcnt lgkmcnt(0)" ::: "memory"); }
#define PK4(P, BASE, OUT) do { unsigned a0 = cvt_pk_bf16(P[BASE + 0], P[BASE + 1]), a1 = cvt_pk_bf16(P[BASE + 2], P[BASE + 3]);   \
    unsigned b0 = cvt_pk_bf16(P[BASE + 4], P[BASE + 5]), b1 = cvt_pk_bf16(P[BASE + 6], P[BASE + 7]);                              \
    auto r0 = __builtin_amdgcn_permlane32_swap(a0, b0, false, false); auto r1 = __builtin_amdgcn_permlane32_swap(a1, b1, false, false); \
    u32x4 w = {r0[0], r1[0], r0[1], r1[1]}; OUT = __builtin_bit_cast(bf16x8, w); } while (0)
            PK4(p0, 0, pa0); PK4(p0, 8, pa1); PK4(p1, 0, pa2); PK4(p1, 8, pa3);
#undef PK4
        }
        if (grp) PBAR(); else WAITBAR_G0();
        if (act) {
            const int vb = vb0 + (i & 3) * VB;
            if (!(ABL & 2)) pv_all<DV>(o, lacc, vb, pa0, pa1, pa2, pa3);
        }
        if (i + 1 < NT && kv0 + 64 <= qfirst + 31) QKT(i + 1);
        if (grp) WAITBAR_G1(); else PBAR();
    }
    asm volatile("s_waitcnt vmcnt(0)" ::: "memory");
    if (!grp) PBAR();
    PBAR();
#undef RFL
#undef DMA_K
#undef DMA_V
#undef WAITBAR_G0
#undef WAITBAR_G1
#undef PBAR
#undef QKT
}

__device__ __forceinline__ bool decode_unit(int idx, int& type, int& qb, int& bh) {
    constexpr int NCLS = 16;
    constexpr int ctype[NCLS] = {0, 0, 0, 0, 0, 1, 0, 1, 1, 1, 0, 1, 1, 0, 1, 1};
    constexpr int cqb[NCLS]   = {7, 6, 5, 4, 3, 7, 2, 6, 5, 4, 1, 3, 2, 0, 1, 0};
    int start = 0; bool found = false;
#pragma unroll
    for (int c = 0; c < NCLS; ++c) { const int n = ctype[c] ? 64 : 32; if (!found && idx < start + n) { type = ctype[c]; qb = cqb[c]; bh = idx - start; found = true; } start += n; }
    return found;
}
constexpr int NUNITS = 768;

struct AttnArgs { const int* bkt; const bf16_t* proj; const bf16_t* qm; const bf16_t* kn; const bf16_t* vm; bf16_t* ao; float* stash; const int* pos; const int* kmax; const int* qmin;
                  const float* rel_bias; const float* subln_g; float lam, lam_init; };

template <int ABL = 0>
__device__ __forceinline__ void attn_phase(LAS unsigned char* lds, const AttnArgs& A, gu32* qctr, int wv) {
    const int wid = wv;
    LAS float* wsc = (LAS float*)(lds + OFF_WS) + wid * 64; LAS float* lut = (LAS float*)(lds + OFF_LUT); volatile LAS int* qw = (volatile LAS int*)(lds + OFF_Q);
    for (;;) {
        const int tid = otid(wv), lane = tid & 63, r32 = lane & 31, hi = lane >> 5;
        if (tid == 0) qw[0] = (int)__hip_atomic_fetch_add(qctr, 1u, RLX_AGENT);
        __syncthreads();
        const int idx = qw[0];
        __syncthreads();
        if (idx >= NUNITS) break;
        int type = 0, qb = 0, bh = 0; decode_unit(idx, type, qb, bh);
        const int q0 = qb * 256, NT = (q0 + 256) / 64, qfirst = q0 + wid * 32, qidx = qfirst + r32;
        if (type == 0) {
            const int b = bh >> 2, h = bh & 3; const size_t rowbase = (size_t)b * SEQ;
            const int* posb = A.pos + b * SEQ; const int posq = posb[qidx]; const int qmin_w = A.qmin[b * 64 + (qfirst >> 5)];
            if (tid < 128) { const float bv = A.rel_bias[A.bkt[tid] * 4 + h] * LOG2E; lut[otid(wv)] = bv; }
            const float bias_far = A.rel_bias[31 * 4 + h] * LOG2E;
            __syncthreads();
            float* st = A.stash + (size_t)blockIdx.x * 32768;
            for (int mp = 0; mp < 2; ++mp) {
                f32x16 o[4]; f32x16 l;
                attn_core<64, 128, true, ABL>(A.proj + (rowbase + qidx) * INP + C_DQ + h * 128 + mp * 64, A.proj + rowbase * INP + C_DK + h * 128 + mp * 64, INP, nullptr, 0,
                                         A.proj + rowbase * INP + C_DV + h * 128, INP, posb, posq, qfirst, qidx, NT, A.kmax + b * 32, qmin_w, bias_far, lds, tid, wid, lane, o, l);
                float rli[16];
#pragma unroll
                for (int r = 0; r < 16; ++r) rli[r] = __builtin_amdgcn_rcpf(l[r]);
                GAS float* stp = (GAS float*)(st + tid); asm volatile("" : "+v"(stp));
                if (mp == 0) {
#pragma unroll
                    for (int d = 0; d < 4; ++d)
#pragma unroll
                        for (int r = 0; r < 16; ++r) stp[(d * 16 + r) * 512] = o[d][r] * rli[r];
                } else {
                    const float lam = A.lam, post = 1.f - A.lam_init;
                    float gv[4];
#pragma unroll
                    for (int d = 0; d < 4; ++d) gv[d] = A.subln_g[d * 32 + r32] * post;
                    GAS bf16_t* aop = (GAS bf16_t*)(A.ao + (rowbase + qfirst + 4 * hi) * DM + h * 128 + r32); asm volatile("" : "+v"(aop));
#pragma unroll
                    for (int r = 0; r < 16; ++r) {
                        float v[4], ss = 0.f;
#pragma unroll
                        for (int d = 0; d < 4; ++d) { v[d] = stp[(d * 16 + r) * 512] - lam * (o[d][r] * rli[r]); ss += v[d] * v[d]; }
                        ss += sx<1>(ss); ss += sx<2>(ss); ss += sx<4>(ss); ss += sx<8>(ss); ss += sx<16>(ss);
                        const float rn = __builtin_amdgcn_rsqf(ss * (1.f / 128.f) + EPS);
                        GAS bf16_t* op = aop + (size_t)((r & 3) + 8 * (r >> 2)) * DM;
#pragma unroll
                        for (int d = 0; d < 4; ++d) op[d * 32] = (bf16_t)(cvt_pk_bf16(v[d] * rn * gv[d], 0.f) & 0xffffu);
                    }
                }
            }
        } else {
            const int b = bh >> 3, h = bh & 7; const size_t rowbase = (size_t)b * SEQ;
            f32x16 o[2]; f32x16 l;
            attn_core<96, 64, false, ABL>(A.qm + (rowbase + qidx) * NQ + h * 96, A.kn + rowbase * 512 + h * 64, 512, A.proj + rowbase * INP + C_KR, INP,
                                     A.vm + rowbase * 512 + h * 64, 512, nullptr, 0, qfirst, qidx, NT, nullptr, 0, 0.f, lds, tid, wid, lane, o, l);
            GAS bf16_t* aop = (GAS bf16_t*)(A.ao + (rowbase + qfirst + 4 * hi) * DM + 512 + h * 64 + r32); asm volatile("" : "+v"(aop));
#pragma unroll
            for (int r = 0; r < 16; ++r) { const float rl = __builtin_amdgcn_rcpf(l[r]);
                GAS bf16_t* op = aop + (size_t)((r & 3) + 8 * (r >> 2)) * DM;
#pragma unroll
                for (int d = 0; d < 2; ++d) op[d * 32] = (bf16_t)(cvt_pk_bf16(o[d][r] * rl, 0.f) & 0xffffu); }
            asm volatile("s_waitcnt lgkmcnt(0)" ::: "memory");
        }
    }
}
#undef SBAR
}

#define XB_TMO      128
#define XB_XCNT(j)  (256  + 64 * (j))
#define XB_XSUB(j)  (1280 + 64 * (j))
#define XB_XGEN(j)  (2304 + 64 * (j))
#define XB_TOP      3328
#define XB_TOPGEN   3392
#define XCD_BAR_WORDS 3456
#define XB_SPIN_CAP (1u << 18)
__device__ __forceinline__ unsigned xb_ld(unsigned* p)              { return __hip_atomic_load(p, __ATOMIC_RELAXED, __HIP_MEMORY_SCOPE_AGENT); }
__device__ __forceinline__ unsigned xb_add(unsigned* p, unsigned v) { return __hip_atomic_fetch_add(p, v, __ATOMIC_RELAXED, __HIP_MEMORY_SCOPE_AGENT); }
__device__ __forceinline__ unsigned xb_xcc_id() { return (unsigned)__builtin_amdgcn_s_getreg((3 << 11) | 20) & 0xFu; }
#define XB_SPIN(cond, bar) do { unsigned _sp = 0; while (cond) { __builtin_amdgcn_s_sleep(1); \
    if ((++_sp & 255u) == 0u) { if (xb_ld(&(bar)[XB_TMO])) break; if (_sp > XB_SPIN_CAP) { atomicAdd(&(bar)[XB_TMO], 1u); break; } } } } while (0)
struct XcdBarrier { unsigned* bar; unsigned x; volatile LAS unsigned* st; };
__device__ __forceinline__ XcdBarrier xcd_barrier_post(unsigned* bar, volatile LAS unsigned* st) {
    XcdBarrier b; b.bar = bar; b.x = xb_xcc_id(); b.st = st;
    if (threadIdx.x == 0) (void)xb_add(&bar[XB_XCNT(b.x)], 1u);
    return b;
}
__device__ __forceinline__ void xcd_barrier_complete(unsigned* bar, unsigned x, unsigned& nloc, unsigned& nx) {
    const unsigned G = gridDim.x * gridDim.y * gridDim.z;
    unsigned sum, cnt, mine, sp = 0u;
    for (;;) {
        sum = 0u; cnt = 0u; mine = 0u;
#pragma unroll
        for (unsigned j = 0; j < 16; ++j) { const unsigned c = xb_ld(&bar[XB_XCNT(j)]); sum += c; cnt += (c > 0u) ? 1u : 0u; mine = (j == x) ? c : mine; }
        if (sum == G) break;
        __builtin_amdgcn_s_sleep(1);
        if ((++sp & 255u) == 0u) { if (xb_ld(&bar[XB_TMO])) break; if (sp > XB_SPIN_CAP) { atomicAdd(&bar[XB_TMO], 1u); break; } }
    }
    nloc = mine > 0u ? mine : 1u; nx = cnt > 0u ? cnt : 1u;
}
__device__ __forceinline__ void xcd_barrier(const XcdBarrier& b) {
    asm volatile("s_waitcnt vmcnt(0)" ::: "memory");
    __syncthreads();
    if (threadIdx.x == 0) {
        GAS unsigned* gbar = (GAS unsigned*)b.bar; unsigned bx_ = b.x;
        asm volatile("" : "+s"(gbar), "+s"(bx_));
        unsigned* bar = (unsigned*)gbar;
        __builtin_amdgcn_s_waitcnt(0);
        unsigned nloc = b.st[0], nx = b.st[1];
        if (nloc == 0u) { xcd_barrier_complete(bar, bx_, nloc, nx); b.st[0] = nloc; b.st[1] = nx; }
        const unsigned old = xb_add(&bar[XB_XSUB(bx_)], 1u);
        const unsigned gen = old / nloc;
        if (old + 1u == (gen + 1u) * nloc) {
            __builtin_amdgcn_fence(__ATOMIC_RELEASE, "agent");
            asm volatile("s_waitcnt vmcnt(0)" ::: "memory");
            const unsigned og = xb_add(&bar[XB_TOP], 1u);
            const unsigned tg = og / nx;
            if (og + 1u == (tg + 1u) * nx) xb_add(&bar[XB_TOPGEN], 1u);
            else XB_SPIN(xb_ld(&bar[XB_TOPGEN]) == tg, bar);
            __builtin_amdgcn_fence(__ATOMIC_ACQUIRE, "agent");
            xb_add(&bar[XB_XGEN(bx_)], 1u);
            asm volatile("s_waitcnt vmcnt(0)" ::: "memory");
        } else {
            XB_SPIN(xb_ld(&bar[XB_XGEN(bx_)]) == gen, bar);
            __builtin_amdgcn_fence(__ATOMIC_ACQUIRE, "agent");
            asm volatile("s_waitcnt vmcnt(0)" ::: "memory");
        }
    }
    __syncthreads();
}

struct Args {
    const float* in[24]; float* out; unsigned char* ws; int ph_lo, ph_hi;
};
enum { I_X = 0, I_C, I_POS, I_WADA, I_BADA, I_GATTN, I_WIN, I_DLAM, I_SUBG, I_RELB, I_QNORM, I_WUQ, I_KVNORM, I_WUKV, I_WO, I_GFFN, I_W1, I_W3, I_W2, I_ROUTER, I_MW1, I_MW3, I_MW2, I_GFINAL };

__device__ __forceinline__ int rowmap(int kind, int n) {
    switch (kind) {
        case 1: { if (n < C_KR) return n; const int i = n - C_KR; return C_KR + (i < 16 ? 2 * i : 2 * (i - 16) + 1); }
        case 2: { const int h = n / 96, j = n % 96; if (j < 64) return n; return h * 96 + 64 + (j < 80 ? 2 * (j - 64) : 2 * (j - 80) + 1); }
        case 3: { const int h = n >> 7, j = n & 127; return j < 64 ? h * 64 + j : 512 + h * 64 + (j - 64); }
        case 4: return (n >> 7) * 256 + (n & 127);
        case 5: return (n >> 7) * 256 + 128 + (n & 127);
        default: return n;
    }
}
__device__ __forceinline__ void transpose_item(const float* W, int K, int N, bf16_t* WT, int kind, const float* gain, LAS float* scr, int item, int lane) {
    const int nblk = N / 32, kb = item / nblk, nb = item % nblk, k0 = 64 * kb, n0 = 32 * nb;
#pragma unroll 8
    for (int i = 0; i < 32; ++i) { const int kk = 2 * i + (lane >> 5); float v = __builtin_nontemporal_load(W + (size_t)(k0 + kk) * N + n0 + (lane & 31)); if (gain) v *= gain[k0 + kk]; scr[kk * 33 + (lane & 31)] = v; }
    LDS_WAIT(); asm volatile("" ::: "memory");
    const int c = lane & 7;
#pragma unroll
    for (int j = 0; j < 4; ++j) { const int n = (lane >> 3) + 8 * j; const LAS float* s = scr + (8 * c) * 33 + n;
        u32x4 o; o.x = cvt_pk_bf16(s[0 * 33], s[1 * 33]); o.y = cvt_pk_bf16(s[2 * 33], s[3 * 33]); o.z = cvt_pk_bf16(s[4 * 33], s[5 * 33]); o.w = cvt_pk_bf16(s[6 * 33], s[7 * 33]);
        *(u32x4*)(WT + (size_t)rowmap(kind, n0 + n) * K + k0 + 8 * c) = o; }
    LDS_WAIT(); asm volatile("" ::: "memory");
}

__device__ __forceinline__ void transpose_item_f8(const float* W, int K, int N, unsigned char* WT, int kind, LAS float* scr, int item, int lane) {
    const int nblk = N / 32, kb = item / nblk, nb = item % nblk, k0 = 64 * kb, n0 = 32 * nb;
#pragma unroll 8
    for (int i = 0; i < 32; ++i) { const int kk = 2 * i + (lane >> 5); scr[kk * 33 + (lane & 31)] = __builtin_nontemporal_load(W + (size_t)(k0 + kk) * N + n0 + (lane & 31)) * WSCALE; }
    LDS_WAIT(); asm volatile("" ::: "memory");
#pragma unroll
    for (int j = 0; j < 2; ++j) { const int idx = lane + 64 * j, n = idx >> 2, c = idx & 3; const LAS float* s = scr + (16 * c) * 33 + n;
        u32x4 o; o.x = pk_fp8x4(s[0 * 33], s[1 * 33], s[2 * 33], s[3 * 33]); o.y = pk_fp8x4(s[4 * 33], s[5 * 33], s[6 * 33], s[7 * 33]);
        o.z = pk_fp8x4(s[8 * 33], s[9 * 33], s[10 * 33], s[11 * 33]); o.w = pk_fp8x4(s[12 * 33], s[13 * 33], s[14 * 33], s[15 * 33]);
        *(u32x4*)(WT + (size_t)rowmap(kind, n0 + n) * K + k0 + 16 * c) = o; }
    LDS_WAIT(); asm volatile("" ::: "memory");
}

__device__ __forceinline__ void prologue(LAS unsigned char* lds, int vcu, int G, int wv) {
    const int tid = otid(wv), lane = tid & 63, wave = wv;
    unsigned char* ws = karg_ws(okarg());
    {
        LAS float* sl = (LAS float*)lds;
        LAS float* red = (LAS float*)(lds + 32768);
        const float* c = karg_in(okarg(), I_C);
        for (int i = tid; i < NB * DM; i += 512) { const int b = i >> 10, k = i & 1023; const float v = c[i]; sl[k * 8 + b] = v / (1.f + __expf(-v)); }
        __syncthreads();
        float* mod = (float*)(ws + WS_MOD);
        for (int it = vcu; it < DEPTH * 48; it += G) {
            const int l = it / 48, n0 = (it % 48) * 128, cl = tid & 31, ks = tid >> 5;
            const float* wp = karg_in(okarg(), I_WADA) + (size_t)l * DM * 6144 + (size_t)(ks * 64) * 6144 + n0 + 4 * cl;
            f32x4 acc[8];
#pragma unroll
            for (int b = 0; b < 8; ++b) acc[b] = (f32x4){0.f, 0.f, 0.f, 0.f};
#pragma unroll 4
            for (int k = 0; k < 64; ++k) { const f32x4 w = *(const f32x4*)(wp + (size_t)k * 6144);
                const f32x4 s0 = *(const LAS f32x4*)(sl + (ks * 64 + k) * 8), s1 = *(const LAS f32x4*)(sl + (ks * 64 + k) * 8 + 4);
                acc[0] += w * s0[0]; acc[1] += w * s0[1]; acc[2] += w * s0[2]; acc[3] += w * s0[3]; acc[4] += w * s1[0]; acc[5] += w * s1[1]; acc[6] += w * s1[2]; acc[7] += w * s1[3]; }
#pragma unroll
            for (int b = 0; b < 8; ++b) *(LAS f32x4*)(red + (ks * 8 + b) * 128 + 4 * cl) = acc[b];
            __syncthreads();
            for (int o = tid; o < 1024; o += 512) { const int b = o >> 7, n = o & 127; float s = 0.f;
#pragma unroll
                for (int k2 = 0; k2 < 16; ++k2) s += red[(k2 * 8 + b) * 128 + n];
                mod[((size_t)l * 8 + b) * 6144 + n0 + n] = s + karg_in(okarg(), I_BADA)[(size_t)l * 6144 + n0 + n]; }
            __syncthreads();
        }
    }
    {
        const int* pos = (const int*)karg_in(okarg(), I_POS);
        float* cs = (float*)(ws + WS_CS);
        for (int i = vcu * 512 + tid; i < M * 16; i += G * 512) {
            const int row = i >> 4, f = i & 15;
            const double base[4] = {1.0, 0.5623413251903491, 0.31622776601683794, 0.1778279410038923};
            double inv = base[f & 3]; for (int q = 0; q < (f >> 2); ++q) inv *= 0.1;
            const double rev = (double)pos[row] * inv * 0.15915494309189535;
            const float fr = (float)(rev - rint(rev));
            cs[2 * i] = __builtin_amdgcn_cosf(fr); cs[2 * i + 1] = __builtin_amdgcn_sinf(fr);
        }
        int* kmax = (int*)(ws + WS_MISC) + 64; int* qmin = kmax + 256; float* lamv = (float*)(ws + WS_MISC);
        if (vcu == 1 % G) {
            if (tid < 256) { int mx = pos[tid * 64]; for (int k = 1; k < 64; ++k) { const int p = pos[tid * 64 + k]; mx = p > mx ? p : mx; } kmax[tid] = mx; }
            { int mn = pos[tid * 32]; for (int k = 1; k < 32; ++k) { const int p = pos[tid * 32 + k]; mn = p < mn ? p : mn; } qmin[tid] = mn; }
        }
        if (vcu == 3 % G && tid < 128) ((int*)(ws + WS_MISC))[2048 + tid] = att::rel_bucket(tid);
        if (vcu == 2 % G && tid < DEPTH) {
            const float* lv = karg_in(okarg(), I_DLAM) + tid * 256; float s1 = 0.f, s2 = 0.f;
            for (int k = 0; k < 64; ++k) { s1 += lv[k] * lv[64 + k]; s2 += lv[128 + k] * lv[192 + k]; }
            lamv[tid] = expf(s1) - expf(s2) + (0.8f - 0.6f * expf(-0.3f * (float)tid));
        }
    }
    __syncthreads();
    if (F8_UP == 2 || IN_I8) {
        LAS float* scr = (LAS float*)lds; LAS float* red = (LAS float*)(lds + 133120); LAS float* cinv = (LAS float*)(lds + 133120 + 2048);
        constexpr int N_UP = (F8_UP == 2) ? 36 * 88 : 0, N_IN = IN_I8 ? 4 * 69 : 0;
        for (int it = vcu; it < N_UP + N_IN; it += G) {
            const float* W; unsigned char* WT; float* sc; int ldw, n0, kind;
            if (it < N_UP) { const int mat = it / 88, w3 = mat & 1, dm = mat >> 1;
                n0 = (it % 88) * 32; ldw = DFF; kind = 4 + w3;
                W = (dm < 2) ? karg_in(okarg(), w3 ? I_W3 : I_W1) + (size_t)dm * DM * DFF : karg_in(okarg(), w3 ? I_MW3 : I_MW1) + (size_t)(dm - 2) * DM * DFF;
                WT = (dm < 2) ? ws + WS_WD13 + (size_t)dm * 2 * DFF * DM : ws + WS_WM13 + (size_t)(dm - 2) * 2 * DFF * DM;
                sc = (float*)(ws + WS_WSC) + (size_t)dm * (2 * DFF);
            } else { const int r = it - N_UP, l = r / 69; n0 = (r % 69) * 32; ldw = INW; kind = 1;
                W = karg_in(okarg(), I_WIN) + (size_t)l * DM * INW; WT = ws + WS_WIN + (size_t)l * INP * DM; sc = (float*)(ws + WS_WSC2) + (size_t)l * INP; }
#pragma unroll 16
            for (int i = 0; i < 64; ++i) { const int k = 128 * wave + 2 * i + (lane >> 5), n = lane & 31; scr[k * 32 + ((n + (k >> 4)) & 31)] = __builtin_nontemporal_load(W + (size_t)k * ldw + n0 + n); }
            __syncthreads();
            { const int n = tid & 31, ks = tid >> 5; float m = 0.f;
#pragma unroll 16
              for (int k = 64 * ks; k < 64 * ks + 64; ++k) m = fmaxf(m, fabsf(scr[k * 32 + ((n + (k >> 4)) & 31)]));
              red[ks * 32 + n] = m; }
            __syncthreads();
            if (tid < 32) { float m = 0.f;
#pragma unroll
                for (int s = 0; s < 16; ++s) m = fmaxf(m, red[s * 32 + tid]);
                cinv[tid] = m > 0.f ? 127.f / m : 0.f; sc[rowmap(kind, n0 + tid)] = m > 0.f ? m * (1.f / 127.f) : 1.f; }
            __syncthreads();
#pragma unroll
            for (int j = 0; j < 4; ++j) { const int nl = 4 * wave + j, c = lane; const float iv = cinv[nl];
                const LAS float* s = scr + (16 * c) * 32 + ((nl + c) & 31);
                u32x4 o; o.x = pk_i8x4(s[0] * iv, s[32] * iv, s[64] * iv, s[96] * iv); o.y = pk_i8x4(s[128] * iv, s[160] * iv, s[192] * iv, s[224] * iv);
                o.z = pk_i8x4(s[256] * iv, s[288] * iv, s[320] * iv, s[352] * iv); o.w = pk_i8x4(s[384] * iv, s[416] * iv, s[448] * iv, s[480] * iv);
                *(u32x4*)(WT + (size_t)rowmap(kind, n0 + nl) * DM + 16 * c) = o; }
            __syncthreads();
        }
    }
    {
        LAS float* scr = (LAS float*)(lds + wave * 16384);
        const int gw = vcu * 8 + wave, NGW = G * 8;
        constexpr int IA = 16 * 69, IB = 6 * 24, IC = 4 * 32, ID = 16 * 32, IE = 16 * 88, IF = 44 * 32;
        constexpr int NA = IN_I8 ? 0 : 4 * IA, NBq = 4 * IB, NC = 4 * IC, ND = 4 * ID, NE = (F8_UP == 2) ? 0 : 4 * IE, NF = 2 * IF, NG = (F8_UP == 2) ? 0 : 32 * IE, NH = 16 * IF;
        constexpr int NITEMS = NA + NBq + NC + ND + NE + NF + NG + NH;
        for (int it = gw; it < NITEMS; it += NGW) {
            int r = it;
            if (r < NA) { const int l = r / IA; transpose_item(karg_in(okarg(), I_WIN) + (size_t)l * DM * INW, DM, INW, (bf16_t*)(ws + WS_WIN) + (size_t)l * INP * DM, 1, nullptr, scr, r % IA, lane); continue; } r -= NA;
            if (r < NBq) { const int l = r / IB; transpose_item(karg_in(okarg(), I_WUQ) + (size_t)l * QR * NQ, QR, NQ, (bf16_t*)(ws + WS_WUQ) + (size_t)l * NQ * QR, 2, karg_in(okarg(), I_QNORM) + l * QR, scr, r % IB, lane); continue; } r -= NBq;
            if (r < NC) { const int l = r / IC; transpose_item(karg_in(okarg(), I_WUKV) + (size_t)l * KVR * NKV, KVR, NKV, (bf16_t*)(ws + WS_WUKV) + (size_t)l * NKV * KVR, 3, karg_in(okarg(), I_KVNORM) + l * KVR, scr, r % IC, lane); continue; } r -= NC;
            if (r < ND) { const int l = r / ID; transpose_item(karg_in(okarg(), I_WO) + (size_t)l * DM * DM, DM, DM, (bf16_t*)(ws + WS_WO) + (size_t)l * DM * DM, 0, nullptr, scr, r % ID, lane); continue; } r -= ND;
            if (r < NE) { const int j = r / IE, d = j >> 1, w3 = j & 1; if (F8_UP) transpose_item_f8(karg_in(okarg(), w3 ? I_W3 : I_W1) + (size_t)d * DM * DFF, DM, DFF, ws + WS_WD13 + (size_t)d * 2 * DFF * DM, 4 + w3, scr, r % IE, lane);
                else transpose_item(karg_in(okarg(), w3 ? I_W3 : I_W1) + (size_t)d * DM * DFF, DM, DFF, (bf16_t*)(ws + WS_WD13) + (size_t)d * 2 * DFF * DM, 4 + w3, nullptr, scr, r % IE, lane); continue; } r -= NE;
            if (r < NF) { const int d = r / IF; transpose_item_f8(karg_in(okarg(), I_W2) + (size_t)d * DFF * DM, DFF, DM, ws + WS_WD2 + (size_t)d * DM * DFF, 0, scr, r % IF, lane); continue; } r -= NF;
            if (r < NG) { const int j = r / IE, me = j >> 1, w3 = j & 1; if (F8_UP) transpose_item_f8(karg_in(okarg(), w3 ? I_MW3 : I_MW1) + (size_t)me * DM * DFF, DM, DFF, ws + WS_WM13 + (size_t)me * 2 * DFF * DM, 4 + w3, scr, r % IE, lane);
                else transpose_item(karg_in(okarg(), w3 ? I_MW3 : I_MW1) + (size_t)me * DM * DFF, DM, DFF, (bf16_t*)(ws + WS_WM13) + (size_t)me * 2 * DFF * DM, 4 + w3, nullptr, scr, r % IE, lane); continue; } r -= NG;
            { const int me = r / IF; transpose_item_f8(karg_in(okarg(), I_MW2) + (size_t)me * DFF * DM, DFF, DM, ws + WS_WM2 + (size_t)me * DM * DFF, 0, scr, r % IF, lane); }
        }
    }    __syncthreads();
}

template <int MODE, int F8O = 0, bool XF32 = false>
__device__ __forceinline__ void norm_phase(const void* xin_, void* xout_, float* asc, const bf16_t* yp, const int* slot0, const int* slot1, const float* gate_prev  ,
                                           const float* gvec, const float* modl, int ch_sh, int ch_sc, bf16_t* H,
                                           const float* wrouter, unsigned* cnt, int* re0, int* re1, int* rr0, int* rr1, float* rg0, float* rg1,
                                           LAS unsigned char* lds, int vcu, int G, int wv) {
    const int tid = otid(wv), lane = tid & 63, wave = wv;
    const int gw = vcu * 8 + wave;
    LAS float* wr_l = (LAS float*)lds;
    LAS int* rsel = (LAS int*)(lds + 32768); LAS float* rgate = (LAS float*)(lds + 32768 + 512); LAS int* rrank = (LAS int*)(lds + 32768 + 1024); LAS int* rbase = (LAS int*)(lds + 32768 + 1536);
    if (MODE == 1) { for (int i = tid; i < DM * NEXP / 4; i += 512) ((LAS f32x4*)wr_l)[i] = ((const f32x4*)wrouter)[i]; __syncthreads(); }
    const int mbase = gw * 8, b = mbase >> 11;
    f32x4 gs[4], sh4[4], gp[4];
#pragma unroll
    for (int j = 0; j < 4; ++j) { const int col = 4 * lane + 256 * j;
        if (MODE == 2) gs[j] = *(const f32x4*)(gvec + col);
        else { gs[j] = *(const f32x4*)(gvec + col) * (*(const f32x4*)(modl + (size_t)b * 6144 + ch_sc * DM + col) + 1.0f); sh4[j] = *(const f32x4*)(modl + (size_t)b * 6144 + ch_sh * DM + col); }
        if (yp) gp[j] = *(const f32x4*)(gate_prev + (size_t)b * 6144 + col) + 1.0f; }
#pragma unroll 1
    for (int grp = 0; grp < 2; ++grp) {
        const int m0 = mbase + grp * 4;
        f32x4 v[4][4]; u32x2 y0[4][4], y1[4][4]; int s1v[4];
        if (yp) {
#pragma unroll
            for (int r = 0; r < 4; ++r) { const int m = m0 + r;
                const int s0 = slot0 ? __builtin_amdgcn_readfirstlane(slot0[m]) : m; s1v[r] = slot1 ? __builtin_amdgcn_readfirstlane(slot1[m]) : -1;
#pragma unroll
                for (int j = 0; j < 4; ++j) { const int col = 4 * lane + 256 * j; y0[r][j] = *(const u32x2*)(yp + (size_t)s0 * DM + col); if (s1v[r] >= 0) y1[r][j] = *(const u32x2*)(yp + (size_t)s1v[r] * DM + col); } }
        }
#pragma unroll
        for (int r = 0; r < 4; ++r)
#pragma unroll
            for (int j = 0; j < 4; ++j) { const size_t off = (size_t)(m0 + r) * DM + 4 * lane + 256 * j;
                if (XF32) v[r][j] = *(const f32x4*)((const float*)xin_ + off);
                else { const u32x2 w = *(const u32x2*)((const bf16_t*)xin_ + off); v[r][j] = (f32x4){bf_lo(w.x), bf_hi(w.x), bf_lo(w.y), bf_hi(w.y)}; } }
#pragma unroll
        for (int r = 0; r < 4; ++r) {
            const int m = m0 + r;
            if (yp) {
#pragma unroll
                for (int j = 0; j < 4; ++j) { const int col = 4 * lane + 256 * j;
                    f32x4 y = (f32x4){bf_lo(y0[r][j].x), bf_hi(y0[r][j].x), bf_lo(y0[r][j].y), bf_hi(y0[r][j].y)};
                    if (s1v[r] >= 0) y += (f32x4){bf_lo(y1[r][j].x), bf_hi(y1[r][j].x), bf_lo(y1[r][j].y), bf_hi(y1[r][j].y)};
                    v[r][j] += gp[j] * y;
                    if (MODE != 2) { u32x2 w; w.x = cvt_pk_bf16(v[r][j][0], v[r][j][1]); w.y = cvt_pk_bf16(v[r][j][2], v[r][j][3]); *(u32x2*)((bf16_t*)xout_ + (size_t)m * DM + col) = w; } }
            }
            float ss = 0.f;
#pragma unroll
            for (int j = 0; j < 4; ++j) ss += (v[r][j][0] * v[r][j][0] + v[r][j][1] * v[r][j][1]) + (v[r][j][2] * v[r][j][2] + v[r][j][3] * v[r][j][3]);
            const float rs = 1.0f / sqrtf(wave_sum(ss) * (1.f / DM) + EPS);
            if (MODE == 2) {
#pragma unroll
                for (int j = 0; j < 4; ++j) *(f32x4*)((float*)xout_ + (size_t)m * DM + 4 * lane + 256 * j) = v[r][j] * rs * gs[j];
            } else {
                float lg[NEXP];
#pragma unroll
                for (int e = 0; e < NEXP; ++e) lg[e] = 0.f;
                float qinv = 0.f;
                if (F8O == 2) {
                    float am = 0.f;
#pragma unroll
                    for (int j = 0; j < 4; ++j) { const f32x4 h = v[r][j] * rs * gs[j] + sh4[j]; am = fmaxf(am, fmaxf(fmaxf(fabsf(h[0]), fabsf(h[1])), fmaxf(fabsf(h[2]), fabsf(h[3])))); }
                    am = wave_max(am); qinv = am > 0.f ? 127.f / am : 0.f; if (lane == 0) asc[m] = am > 0.f ? am * (1.f / 127.f) : 1.f;
                }
#pragma unroll
                for (int j = 0; j < 4; ++j) {
                    const int col = 4 * lane + 256 * j;
                    const f32x4 h = v[r][j] * rs * gs[j] + sh4[j];
                    if (F8O == 2) *(unsigned*)((unsigned char*)H + (size_t)m * DM + col) = pk_i8x4(h[0] * qinv, h[1] * qinv, h[2] * qinv, h[3] * qinv);
                    else if (F8O == 1) *(unsigned*)((unsigned char*)H + (size_t)m * DM + col) = pk_fp8x4(h[0] * HSCALE, h[1] * HSCALE, h[2] * HSCALE, h[3] * HSCALE);
                    else { u32x2 w; w.x = cvt_pk_bf16(h[0], h[1]); w.y = cvt_pk_bf16(h[2], h[3]); *(u32x2*)(H + (size_t)m * DM + col) = w; }
                    if (MODE == 1) {
#pragma unroll
                        for (int k = 0; k < 4; ++k) { const f32x4 w0 = *(const LAS f32x4*)(wr_l + (col + k) * 8), w1 = *(const LAS f32x4*)(wr_l + (col + k) * 8 + 4);
                            lg[0] += h[k] * w0[0]; lg[1] += h[k] * w0[1]; lg[2] += h[k] * w0[2]; lg[3] += h[k] * w0[3]; lg[4] += h[k] * w1[0]; lg[5] += h[k] * w1[1]; lg[6] += h[k] * w1[2]; lg[7] += h[k] * w1[3]; }
                    }
                }
                if (MODE == 1) {
#pragma unroll
                    for (int e = 0; e < NEXP; ++e) lg[e] = wave_sum(lg[e]);
                    int e0 = 0; float v0 = lg[0];
#pragma unroll
                    for (int e = 1; e < NEXP; ++e) if (lg[e] > v0) { v0 = lg[e]; e0 = e; }
                    int e1 = -1; float v1 = -INFINITY;
#pragma unroll
                    for (int e = 0; e < NEXP; ++e) if (e != e0 && lg[e] > v1) { v1 = lg[e]; e1 = e; }
                    const float g0 = 1.f / (1.f + __expf(v1 - v0)), g1 = 1.f - g0;
                    if (lane == 0) { const int rl = m - vcu * 64; rsel[rl * 2] = e0; rsel[rl * 2 + 1] = e1; rgate[rl * 2] = g0; rgate[rl * 2 + 1] = g1; }
                }
            }
        }
    }
    if (MODE == 1) {
        __syncthreads();
        if (tid < NEXP) { int c = 0; for (int p = 0; p < 128; ++p) if (rsel[p] == tid) { rrank[p] = c; ++c; }
            rbase[tid] = c ? (int)__hip_atomic_fetch_add(cnt + tid, (unsigned)c, RLX_AGENT) : 0; }
        __syncthreads();
        if (tid < 64) { const int m = vcu * 64 + tid; const int e0 = rsel[2 * tid], e1 = rsel[2 * tid + 1];
            re0[m] = e0; re1[m] = e1; rr0[m] = rbase[e0] + rrank[2 * tid]; rr1[m] = rbase[e1] + rrank[2 * tid + 1]; rg0[m] = rgate[2 * tid]; rg1[m] = rgate[2 * tid + 1]; }
    }
}

__device__ __forceinline__ void gather_phase(const bf16_t* H, bf16_t* HP, unsigned* cnt, const int* re0, const int* re1, const int* rr0, const int* rr1, const float* rg0, const float* rg1,
                                             int* slot0, int* slot1, float* gslot, int* pexp, const float* asc, float* asl, int vcu, int G, int wv) {
    const int tid = otid(wv), lane = tid & 63, wave = wv;
    const int gw = vcu * 8 + wave, NGW = G * 8;
    int off[NEXP]; int tot;
    { int s = 0;
#pragma unroll
        for (int e = 0; e < NEXP; ++e) { off[e] = s; s += (((int)__hip_atomic_load(cnt + e, RLX_AGENT) + 255) >> 8) << 8; }
        tot = s; }
    if (vcu == 0 && tid < 160) {
        int e = 0;
#pragma unroll
        for (int k = 1; k < NEXP; ++k) e += (tid * 256 >= off[k]) ? 1 : 0;
        pexp[tid] = e; if (tid == 0) pexp[160] = tot >> 8;
    }
    for (int m = gw; m < M; m += NGW) {
        const int e0 = re0[m], e1 = re1[m]; int o0 = 0, o1 = 0;
#pragma unroll
        for (int e = 0; e < NEXP; ++e) { o0 = (e == e0) ? off[e] : o0; o1 = (e == e1) ? off[e] : o1; }
        const int s0 = o0 + rr0[m], s1 = o1 + rr1[m];
        if (F8_UP) { const u32x4 x0 = ((const u32x4*)((const unsigned char*)H + (size_t)m * DM))[lane];
            ((u32x4*)((unsigned char*)HP + (size_t)s0 * DM))[lane] = x0; ((u32x4*)((unsigned char*)HP + (size_t)s1 * DM))[lane] = x0; }
        else { const u32x4* srcp = (const u32x4*)(H + (size_t)m * DM); const u32x4 x0 = srcp[lane], x1 = srcp[64 + lane];
            u32x4* d0 = (u32x4*)(HP + (size_t)s0 * DM); u32x4* d1 = (u32x4*)(HP + (size_t)s1 * DM); d0[lane] = x0; d0[64 + lane] = x1; d1[lane] = x0; d1[64 + lane] = x1; }
        if (lane == 0) { slot0[m] = s0; slot1[m] = s1; gslot[s0] = rg0[m]; gslot[s1] = rg1[m]; if (F8_UP == 2) { const float a = asc[m]; asl[s0] = a; asl[s1] = a; } }
    }
}

__global__ void __launch_bounds__(512, 2) mk_fwd(Args args) {
    extern __shared__ __attribute__((aligned(16))) unsigned char lds_raw[];
    LAS unsigned char* lds = (LAS unsigned char*)lds_raw;
    volatile LAS unsigned* MISC = (volatile LAS unsigned*)(lds + MISC_OFF);
    const int tid = threadIdx.x; const int wv = __builtin_amdgcn_readfirstlane(tid >> 6);
    constexpr int G = 256;
    const int bx = blockIdx.x; const int vcu = (bx % 8) * (G / 8) + bx / 8;
    gu32* ctl = (gu32*)(karg_ws(okarg()) + WS_CTL);
    for (int u = tid; u < (LDS_BYTES - LDSCTL_OFF) / 4; u += 512) ((LAS unsigned*)(lds + LDSCTL_OFF))[u] = 0u;
    __syncthreads();
    XcdBarrier bar = xcd_barrier_post((unsigned*)ctl + CW_BAR, MISC + 8);
    const int lo = karg_lo(okarg()), hi = karg_hi(okarg());
#define IN(k) (lo <= (k) && (k) < hi)
#define SEAM(k) do { if (IN(k) && IN((k) + 1)) { xcd_barrier(bar); if (PREPS(9) == 2) xcd_barrier(bar); } } while (0)

#define WSP(T, off) ((T*)(w + (off)))
    if (IN(0)) { for (int rp = 0; rp < PREPS(0); ++rp) prologue(lds, vcu, G, wv); }
    SEAM(0);

    for (int l = 0; l < DEPTH; ++l) {
        const int pb = 1 + l * NPH_L; const bool moe = (l & 1) != 0; const int li = l >> 1;
        if (IN(pb + 0)) {
            kptr_t ka = okarg(); const int bxo = osi(bx), vco = osi(vcu); (void)bxo; (void)vco; unsigned char* w = karg_ws(ka); const float* modl = WSP(float, WS_MOD) + (size_t)l * 8 * 6144; int* RT = WSP(int, WS_ROUTE);
            if (l == 0) norm_phase<0, IN_I8 ? 2 : 0, true>(karg_in(ka, I_X), nullptr, WSP(float, WS_ROUTE) + 8 * M, nullptr, nullptr, nullptr, nullptr, karg_in(ka, I_GATTN), modl, 0, 1, WSP(bf16_t, WS_H), nullptr, nullptr, nullptr, nullptr, nullptr, nullptr, nullptr, nullptr, lds, vco, G, wv);
            else { const bool pm = ((l - 1) & 1) != 0;
                norm_phase<0, IN_I8 ? 2 : 0>(WSP(bf16_t, WS_XB), WSP(bf16_t, WS_XB), WSP(float, WS_ROUTE) + 8 * M, WSP(bf16_t, WS_YP), pm ? RT + 6 * M : nullptr, pm ? RT + 7 * M : nullptr, WSP(float, WS_MOD) + (size_t)(l - 1) * 8 * 6144 + 5 * DM, karg_in(ka, I_GATTN) + l * DM, modl, 0, 1, WSP(bf16_t, WS_H), nullptr, nullptr, nullptr, nullptr, nullptr, nullptr, nullptr, nullptr, lds, vco, G, wv); }
        }
        SEAM(pb + 0);
        if (IN(pb + 1)) {
            kptr_t ka = okarg(); const int bxo = osi(bx), vco = osi(vcu); (void)bxo; (void)vco; unsigned char* w = karg_ws(ka);
            constexpr int KI = IN_I8 ? DM / 2 : DM;
            pg8::Gemm g{WSP(bf16_t, WS_H), (const bf16_t*)(w + WS_WIN + (size_t)l * INP * DM * (IN_I8 ? 1 : 2)), KI, KI, KI, 0};
            pg8::GroupOrder S; S.init(M / 256, INP / 256, G, bxo, nullptr);
            pg8::EpiProj<IN_I8 != 0> E{WSP(bf16_t, WS_PROJ), WSP(float, WS_ROWSS), WSP(float, WS_CS), WSP(float, WS_ROUTE) + 8 * M, WSP(float, WS_WSC2) + (size_t)l * INP};
            for (int rp = 0; rp < PREPS(4); ++rp) pg8::gemm_phase<pg8::EpiProj<IN_I8 != 0>, true, IN_I8 ? 2 : 0>(lds, g, S, E, wv);
        }
        SEAM(pb + 1);
        if (IN(pb + 2)) { for (int rp = 0; rp < PREPS(5); ++rp) {
            { kptr_t ka = okarg(); const int bxo = osi(bx), vco = osi(vcu); (void)bxo; (void)vco; unsigned char* w = karg_ws(ka);
              pg8::Gemm g{WSP(bf16_t, WS_PROJ) + C_MQ, WSP(bf16_t, WS_WUQ) + (size_t)l * NQ * QR, INP, QR, QR, 0};
              pg8::GroupOrder S; S.init(M / 256, NQ / 256, G, bxo, nullptr);
              pg8::EpiQ E{WSP(bf16_t, WS_QM), WSP(float, WS_ROWSS), WSP(float, WS_CS)};
              pg8::gemm_phase<pg8::EpiQ, true>(lds, g, S, E, wv); }
            { kptr_t ka = okarg(); const int bxo = osi(bx), vco = osi(vcu); (void)bxo; (void)vco; unsigned char* w = karg_ws(ka);
              pg8::Gemm g{WSP(bf16_t, WS_PROJ) + C_MKV, WSP(bf16_t, WS_WUKV) + (size_t)l * NKV * KVR, INP, KVR, KVR, 0};
              pg8::GroupOrder S; S.init(M / 256, NKV / 256, G, G - 1 - bxo, nullptr);
              pg8::EpiKV E{WSP(bf16_t, WS_KN), WSP(bf16_t, WS_VM), WSP(float, WS_ROWSS)};
              pg8::gemm_phase<pg8::EpiKV, true>(lds, g, S, E, wv); }
        } }
        SEAM(pb + 2);
        if (IN(pb + 3)) {
            kptr_t ka = okarg(); const int bxo = osi(bx), vco = osi(vcu); (void)bxo; (void)vco; unsigned char* w = karg_ws(ka);
            att::AttnArgs A{WSP(int, WS_MISC) + 2048, WSP(bf16_t, WS_PROJ), WSP(bf16_t, WS_QM), WSP(bf16_t, WS_KN), WSP(bf16_t, WS_VM), WSP(bf16_t, WS_AO), WSP(float, WS_STASH), (const int*)karg_in(ka, I_POS),
                            WSP(int, WS_MISC) + 64, WSP(int, WS_MISC) + 64 + 256, karg_in(ka, I_RELB), karg_in(ka, I_SUBG) + l * 128,
                            WSP(float, WS_MISC)[l], 0.8f - 0.6f * __expf(-0.3f * (float)l)};
            for (int rp = 0; rp < PREPS(1); ++rp) att::attn_phase<0>(lds, A, ctl + CW_QCTR + 64 * l + 32 * rp, wv);
            if (PROBE_ABL >= 0) { att::AttnArgs A2 = A; A2.ao = WSP(bf16_t, WS_YP); att::attn_phase<(PROBE_ABL >= 0 ? PROBE_ABL : 0)>(lds, A2, ctl + CW_QCTR + 64 * l + 48, wv); }
        }
        SEAM(pb + 3);
        if (IN(pb + 4)) {
            kptr_t ka = okarg(); const int bxo = osi(bx), vco = osi(vcu); (void)bxo; (void)vco; unsigned char* w = karg_ws(ka);
            pg8::Gemm g{WSP(bf16_t, WS_AO), WSP(bf16_t, WS_WO) + (size_t)l * DM * DM, DM, DM, DM, 0};
            pg8::GroupOrder S; S.init(M / 256, DM / 256, G, bxo, nullptr);
            pg8::EpiRes E{l == 0 ? karg_in(ka, I_X) : nullptr, WSP(bf16_t, WS_XB), WSP(bf16_t, WS_XB), WSP(float, WS_MOD) + (size_t)l * 8 * 6144 + 2 * DM};
            pg8::gemm_phase<pg8::EpiRes, false>(lds, g, S, E, wv);
        }
        SEAM(pb + 4);
        if (IN(pb + 5)) {
            kptr_t ka = okarg(); const int bxo = osi(bx), vco = osi(vcu); (void)bxo; (void)vco; unsigned char* w = karg_ws(ka); const float* modl = WSP(float, WS_MOD) + (size_t)l * 8 * 6144; int* RT = WSP(int, WS_ROUTE);
            if (moe) norm_phase<1, F8_UP>(WSP(bf16_t, WS_XB), nullptr, WSP(float, WS_ROUTE) + 8 * M, nullptr, nullptr, nullptr, nullptr, karg_in(ka, I_GFFN) + l * DM, modl, 3, 4, WSP(bf16_t, WS_H), karg_in(ka, I_ROUTER) + (size_t)li * DM * NEXP, (unsigned*)ctl + CW_CNT + 64 * li,
                                   RT, RT + M, RT + 2 * M, RT + 3 * M, (float*)(RT + 4 * M), (float*)(RT + 5 * M), lds, vco, G, wv);
            else norm_phase<0, F8_UP>(WSP(bf16_t, WS_XB), nullptr, WSP(float, WS_ROUTE) + 8 * M, nullptr, nullptr, nullptr, nullptr, karg_in(ka, I_GFFN) + l * DM, modl, 3, 4, WSP(bf16_t, WS_H), nullptr, nullptr, nullptr, nullptr, nullptr, nullptr, nullptr, nullptr, lds, vco, G, wv);
        }
        SEAM(pb + 5);
        if (IN(pb + 6)) { if (moe) { kptr_t ka = okarg(); const int bxo = osi(bx), vco = osi(vcu); (void)bxo; (void)vco; unsigned char* w = karg_ws(ka); int* RT = WSP(int, WS_ROUTE);
            for (int rp = 0; rp < PREPS(8); ++rp) gather_phase(WSP(bf16_t, WS_H), WSP(bf16_t, WS_HPERM), (unsigned*)ctl + CW_CNT + 64 * li, RT, RT + M, RT + 2 * M, RT + 3 * M, (float*)(RT + 4 * M), (float*)(RT + 5 * M), RT + 6 * M, RT + 7 * M,
                         WSP(float, WS_GSLOT), WSP(int, WS_MISC) + 1024, WSP(float, WS_ROUTE) + 8 * M, WSP(float, WS_ASL), vco, G, wv); } }
        if (moe) SEAM(pb + 6);
        if (IN(pb + 7)) {
            kptr_t ka = okarg(); const int bxo = osi(bx), vco = osi(vcu); (void)bxo; (void)vco; unsigned char* w = karg_ws(ka); const int* pexp = moe ? WSP(int, WS_MISC) + 1024 : nullptr;
            constexpr int KU = F8_UP ? DM / 2 : DM;
            pg8::Gemm g{moe ? WSP(bf16_t, WS_HPERM) : WSP(bf16_t, WS_H), (const bf16_t*)((moe ? w + WS_WM13 : w + WS_WD13) + (moe ? (size_t)li * 8 * 2 * DFF * DM : (size_t)li * 2 * DFF * DM) * (F8_UP ? 1 : 2)), KU, KU, KU, (size_t)2 * DFF * KU};
            pg8::GroupOrder S; S.init(moe ? __builtin_amdgcn_readfirstlane(pexp[160]) : M / 256, 2 * DFF / 256, G, bxo, pexp);
            pg8::EpiSwiGLU<F8_UP == 2> E{w + WS_U, 0, moe ? WSP(float, WS_ASL) : WSP(float, WS_ROUTE) + 8 * M, WSP(float, WS_WSC) + (size_t)(moe ? 2 + li * 8 : li) * (2 * DFF)};
            for (int rp = 0; rp < PREPS(2); ++rp) pg8::gemm_phase<pg8::EpiSwiGLU<F8_UP == 2>, true, F8_UP, 127 - F8_H_LOG2, 127 - F8_W_LOG2>(lds, g, S, E, wv);
        }
        SEAM(pb + 7);
        if (IN(pb + 8)) {
            kptr_t ka = okarg(); const int bxo = osi(bx), vco = osi(vcu); (void)bxo; (void)vco; unsigned char* w = karg_ws(ka); const int* pexp = moe ? WSP(int, WS_MISC) + 1024 : nullptr;
            pg8::Gemm g{WSP(bf16_t, WS_U), (const bf16_t*)(moe ? w + WS_WM2 + (size_t)li * 8 * DM * DFF : w + WS_WD2 + (size_t)li * DM * DFF), DFF / 2, DFF / 2, DFF / 2, (size_t)DM * DFF / 2};
            pg8::GroupOrder S; S.init(moe ? __builtin_amdgcn_readfirstlane(pexp[160]) : M / 256, DM / 256, G, bxo, pexp);
            pg8::EpiDown E{WSP(bf16_t, WS_YP), moe ? WSP(float, WS_GSLOT) : nullptr};
            for (int rp = 0; rp < PREPS(3); ++rp) pg8::gemm_phase<pg8::EpiDown, true, true, 127 - F8_U_LOG2, 127 - F8_W_LOG2>(lds, g, S, E, wv);
        }
        SEAM(pb + 8);
    }
    if (IN(NPHASE - 1)) {
        kptr_t ka = okarg(); const int bxo = osi(bx), vco = osi(vcu); (void)bxo; (void)vco; unsigned char* w = karg_ws(ka); int* RT = WSP(int, WS_ROUTE);
        norm_phase<2>(WSP(bf16_t, WS_XB), karg_out(ka), nullptr, WSP(bf16_t, WS_YP), RT + 6 * M, RT + 7 * M, WSP(float, WS_MOD) + (size_t)3 * 8 * 6144 + 5 * DM, karg_in(ka, I_GFINAL), nullptr, 0, 0, nullptr, nullptr, nullptr, nullptr, nullptr, nullptr, nullptr, nullptr, nullptr, lds, vco, G, wv);
    }
#undef WSP
#undef IN
#undef SEAM
}

extern "C" void kernel_launch(void* const* d_in, const int* in_sizes, int n_in, void* d_out, int out_size, void* d_ws, size_t ws_size, hipStream_t stream) {
    static int grid = 0;
    if (grid == 0) {
        if (n_in != 24 || out_size != M * DM || ws_size < WS_END) { fprintf(stderr, "kernel_launch: built for 24 inputs, out %d floats, >= %zu bytes of workspace; got n_in %d out %d ws %zu\n", M * DM, (size_t)WS_END, n_in, out_size, ws_size); grid = -1; return; }
        int dev = 0, cus = 0, per_cu = 0;
        if (hipGetDevice(&dev) != hipSuccess || hipDeviceGetAttribute(&cus, hipDeviceAttributeMultiprocessorCount, dev) != hipSuccess) { grid = -1; return; }
        if (hipFuncSetAttribute((const void*)mk_fwd, hipFuncAttributeMaxDynamicSharedMemorySize, LDS_BYTES) != hipSuccess) { fprintf(stderr, "kernel_launch: hipFuncSetAttribute failed\n"); grid = -1; return; }
        if (hipOccupancyMaxActiveBlocksPerMultiprocessor(&per_cu, (const void*)mk_fwd, 512, LDS_BYTES) != hipSuccess || per_cu < 1) fprintf(stderr, "kernel_launch: occupancy query reports %d\n", per_cu);
        (void)hipGetLastError();
        if (cus < 256) { fprintf(stderr, "kernel_launch: %d CUs; this kernel needs 256 co-resident workgroups (one per CU)\n", cus); grid = -1; return; }
        grid = 256;
    }
    if (grid < 0) return;
    if (hipMemsetAsync((char*)d_ws + WS_CTL, 0, CTL_ZERO_BYTES, stream) != hipSuccess) return;
    Args a{};
    for (int i = 0; i < 24; ++i) a.in[i] = (const float*)d_in[i];
    a.out = (float*)d_out; a.ws = (unsigned char*)d_ws;
#if MK_SPLIT
    for (int p = 0; p < NPHASE; ++p) {
        if (p >= 1 && p < NPHASE - 1) { const int l = (p - 1) / NPH_L, k = (p - 1) % NPH_L; if (k == 6 && !(l & 1)) continue; }
        a.ph_lo = p; a.ph_hi = p + 1;
        hipLaunchKernelGGL(mk_fwd, dim3(grid), dim3(512), LDS_BYTES, stream, a);
    }
#else
    a.ph_lo = 0; a.ph_hi = NPHASE;
    hipLaunchKernelGGL(mk_fwd, dim3(grid), dim3(512), LDS_BYTES, stream, a);
#endif
    const hipError_t le = hipPeekAtLastError();
    if (le != hipSuccess) fprintf(stderr, "kernel_launch: launch failed: %s\n", hipGetErrorName(le));
}
```

```cpp
#include <hip/hip_runtime.h>
#include <cstdio>
#include <cstdint>

#ifndef PROBE_DUP
#define PROBE_DUP 0
#endif
#ifndef PROBE_ABL
#define PROBE_ABL -1
#endif
#define PREPS(bit) (((PROBE_DUP >> (bit)) & 1) ? 2 : 1)
#ifndef F8_UP
#define F8_UP 2
#endif
#ifndef IN_I8
#define IN_I8 1
#endif
#ifndef PROBE_PMASK
#define PROBE_PMASK 0
#endif
#ifndef MK_SPLIT
#define MK_SPLIT 0
#endif

constexpr int DM = 1024, NB = 8, SEQ = 2048, DEPTH = 4, M = NB * SEQ;
constexpr int INW = 2208, INP = 2304;
constexpr int C_DQ = 0, C_DK = 512, C_DV = 1024, C_MQ = 1536, C_MKV = 1920, C_KR = 2176;
constexpr int QR = 384, KVR = 256, NQ = 768, NKV = 1024;
constexpr int DFF = 2816, NEXP = 8;
constexpr int SLOTS = 34816;
constexpr float EPS = 1e-6f, LOG2E = 1.4426950408889634f;
constexpr float C2D = 0.125f * LOG2E;
constexpr float C2M = 0.10206207261596577f * LOG2E;
constexpr int F8_W_LOG2 = 7, F8_H_LOG2 = 4, F8_U_LOG2 = 2;
constexpr float WSCALE = 128.f, HSCALE = 16.f, USCALE = 4.f;
constexpr int NPH_L = 9, NPHASE = 2 + NPH_L * DEPTH;

constexpr size_t MiB = 1u << 20;
constexpr size_t WS_CTL = 0, CTL_ZERO_BYTES = 1 * MiB;
constexpr size_t WS_MOD = 1 * MiB;
constexpr size_t WS_CS = 2 * MiB;
constexpr size_t WS_ROWSS = 4 * MiB;
constexpr size_t WS_ROUTE = 6 * MiB;
constexpr size_t WS_GSLOT = 7 * MiB;
constexpr size_t WS_MISC = 7 * MiB + 512 * 1024;
constexpr size_t WS_WSC = WS_MISC + 65536;
constexpr size_t WS_WSC2 = WS_GSLOT + 400 * 1024;
constexpr size_t WS_ASL = WS_GSLOT + 256 * 1024;
constexpr size_t WS_WIN = 8 * MiB;
constexpr size_t WS_WUQ = 26 * MiB;
constexpr size_t WS_WUKV = 29 * MiB;
constexpr size_t WS_WO = 31 * MiB;
constexpr size_t WS_WD13 = 39 * MiB;
constexpr size_t WS_WD2 = 61 * MiB;
constexpr size_t WS_WM13 = 72 * MiB;
constexpr size_t WS_WM2 = 248 * MiB;
constexpr size_t WS_H = 336 * MiB;
constexpr size_t WS_ACT = 368 * MiB;
constexpr size_t WS_PROJ = WS_ACT;
constexpr size_t WS_QM = WS_ACT + 72 * MiB;
constexpr size_t WS_KN = WS_ACT + 96 * MiB;
constexpr size_t WS_VM = WS_ACT + 112 * MiB;
constexpr size_t WS_AO = WS_ACT + 128 * MiB;
constexpr size_t WS_STASH = WS_ACT + 160 * MiB;
constexpr size_t WS_U = WS_ACT;
constexpr size_t WS_HPERM = WS_ACT + 188 * MiB;
constexpr size_t WS_YP = WS_ACT + 256 * MiB;
constexpr size_t WS_XB = WS_ACT + 324 * MiB;
constexpr size_t WS_END = WS_XB + 32 * MiB;
constexpr int CW_TMO = 0, CW_CODE = 1;
constexpr int CW_BAR = 4096;
constexpr int CW_QCTR = 8192;
constexpr int CW_CNT = 8704;

constexpr int RING_BYTES = 131072, LDSCTL_OFF = RING_BYTES, MISC_OFF = LDSCTL_OFF + 320, LDS_BYTES = 147456;

#define GAS __attribute__((address_space(1)))
#define LAS __attribute__((address_space(3)))
typedef unsigned short bf16_t;
typedef short bf16x8 __attribute__((ext_vector_type(8)));
typedef short s16x4 __attribute__((ext_vector_type(4)));
typedef float f32x4 __attribute__((ext_vector_type(4)));
typedef float f32x2 __attribute__((ext_vector_type(2)));
typedef float f32x16 __attribute__((ext_vector_type(16)));
typedef unsigned u32x4 __attribute__((ext_vector_type(4)));
typedef unsigned u32x8 __attribute__((ext_vector_type(8)));
typedef unsigned u32x2 __attribute__((ext_vector_type(2)));
typedef GAS unsigned gu32;
#define RLX_AGENT __ATOMIC_RELAXED, __HIP_MEMORY_SCOPE_AGENT
#define LDS_WAIT() asm volatile("s_waitcnt lgkmcnt(0)" ::: "memory")
#define VM_WAIT() asm volatile("s_waitcnt vmcnt(0)" ::: "memory")

__device__ __forceinline__ unsigned cvt_pk_bf16(float lo, float hi) { unsigned r; asm volatile("v_cvt_pk_bf16_f32 %0, %1, %2" : "=v"(r) : "v"(lo), "v"(hi)); return r; }
__device__ __forceinline__ unsigned pk_fp8x4(float a, float b, float c, float d) {
    a = __builtin_amdgcn_fmed3f(a, -448.f, 448.f); b = __builtin_amdgcn_fmed3f(b, -448.f, 448.f); c = __builtin_amdgcn_fmed3f(c, -448.f, 448.f); d = __builtin_amdgcn_fmed3f(d, -448.f, 448.f);
    int w = 0; w = __builtin_amdgcn_cvt_pk_fp8_f32(a, b, w, false); w = __builtin_amdgcn_cvt_pk_fp8_f32(c, d, w, true); return (unsigned)w; }
__device__ __forceinline__ float bf_lo(unsigned w) { return __uint_as_float(w << 16); }
__device__ __forceinline__ float bf_hi(unsigned w) { return __uint_as_float(w & 0xffff0000u); }
template <int K> __device__ __forceinline__ float sx(float v) { return __int_as_float(__builtin_amdgcn_ds_swizzle(__float_as_int(v), (K << 10) | 0x1f)); }
__device__ __forceinline__ float x32_sum(float v) { auto rr = __builtin_amdgcn_permlane32_swap(__float_as_uint(v), __float_as_uint(v), false, false); return __uint_as_float(rr[0]) + __uint_as_float(rr[1]); }
__device__ __forceinline__ float wave_max(float v) { v = fmaxf(v, sx<1>(v)); v = fmaxf(v, sx<2>(v)); v = fmaxf(v, sx<4>(v)); v = fmaxf(v, sx<8>(v)); v = fmaxf(v, sx<16>(v));
    auto rr = __builtin_amdgcn_permlane32_swap(__float_as_uint(v), __float_as_uint(v), false, false); return fmaxf(__uint_as_float(rr[0]), __uint_as_float(rr[1])); }
__device__ __forceinline__ unsigned pk_i8x4(float a, float b, float c, float d) {
    const int ia = (int)__builtin_rintf(a), ib = (int)__builtin_rintf(b), ic = (int)__builtin_rintf(c), id = (int)__builtin_rintf(d);
    return (unsigned)(ia & 0xff) | ((unsigned)(ib & 0xff) << 8) | ((unsigned)(ic & 0xff) << 16) | ((unsigned)id << 24); }
__device__ __forceinline__ float wave_sum(float v) { v += sx<1>(v); v += sx<2>(v); v += sx<4>(v); v += sx<8>(v); v += sx<16>(v); return x32_sum(v); }


__device__ __forceinline__ int otid(int wv) { int l; asm volatile("v_mbcnt_lo_u32_b32 %0, -1, 0\n\tv_mbcnt_hi_u32_b32 %0, -1, %0" : "=v"(l)); return (wv << 6) | l; }
template <class T> __device__ __forceinline__ T* optr(T* p) { asm volatile("" : "+s"(p)); return p; }
__device__ __forceinline__ int osi(int v) { asm volatile("" : "+s"(v)); return v; }
typedef __attribute__((address_space(4))) const unsigned char* kptr_t;
__device__ __forceinline__ kptr_t okarg() { kptr_t p = (kptr_t)__builtin_amdgcn_kernarg_segment_ptr(); asm volatile("" : "+s"(p)); return p; }
typedef const float* cfp_t; typedef float* fp_t; typedef unsigned char* ucp_t;
typedef __attribute__((address_space(4))) const cfp_t* k_cfp; typedef __attribute__((address_space(4))) const fp_t* k_fp; typedef __attribute__((address_space(4))) const ucp_t* k_ucp; typedef __attribute__((address_space(4))) const int* k_int;
__device__ __forceinline__ const float* karg_in(kptr_t k, int i) { return (const float*)(GAS const float*)(*(k_cfp)(k + 8 * i)); }
__device__ __forceinline__ float* karg_out(kptr_t k) { return (float*)(GAS float*)(*(k_fp)(k + 192)); }
__device__ __forceinline__ unsigned char* karg_ws(kptr_t k) { return (unsigned char*)(GAS unsigned char*)(*(k_ucp)(k + 200)); }
__device__ __forceinline__ int karg_lo(kptr_t k) { return *(k_int)(k + 208); }
__device__ __forceinline__ int karg_hi(kptr_t k) { return *(k_int)(k + 212); }
namespace pg8 {
constexpr int BM = 256, BK = 64, HALF = 128, HTB = HALF * BK * 2, STAGE_BYTES = 8 * HTB, NXCD = 8, WGM = 8;
__host__ __device__ __forceinline__ int lds_byte(int r, int c) { const int st = (r >> 4) * 2 + (c >> 5), rr = r & 15, cc = c & 31, ob = rr * 64 + cc * 2; return st * 1024 + (ob ^ (((ob >> 9) & 1) << 5)); }
__host__ __device__ __forceinline__ void stage_rc(int b, int& R, int& C) { const int st = b / 1024, sb = b % 1024, swz = sb ^ (((sb >> 9) & 1) << 5); R = (st >> 1) * 16 + swz / 64; C = (st & 1) * 32 + (swz % 64) / 2; }
__host__ __device__ __forceinline__ int perm32(int rho) { const int n = rho >> 4, i = rho & 15; return 8 * (i >> 2) + 4 * n + (i & 3); }

struct Unit { int pm, pn, e; };
struct Gemm { const bf16_t* A; const bf16_t* Bt; int lda, ldb, K; size_t estride; };

struct GroupOrder {
    int nM, nN, nwg, G, c; const int* pexp;
    __device__ __forceinline__ void init(int nM_, int nN_, int G_, int c_, const int* pexp_) { nM = nM_; nN = nN_; nwg = nM * nN; G = G_; c = c_; pexp = pexp_; }
    __device__ __forceinline__ bool next(int i, Unit& u) const {
        const long L = (long)i * G + c; if (L >= nwg) return false;
        int wgid = (int)L; { const int q = nwg / NXCD, r = nwg % NXCD, xcd = wgid % NXCD, off = wgid / NXCD; wgid = (xcd < r ? xcd * (q + 1) : r * (q + 1) + (xcd - r) * q) + off; }
        const int nig = WGM * nN, gid = wgid / nig, fm = gid * WGM, gsz = (nM - fm) < WGM ? (nM - fm) : WGM;
        u.pm = fm + ((wgid % nig) % gsz); u.pn = (wgid % nig) / gsz;
        u.e = pexp ? __builtin_amdgcn_readfirstlane(pexp[u.pm]) : 0; return true;
    }
};

typedef int v8i32 __attribute__((ext_vector_type(8)));
typedef int i32x4 __attribute__((ext_vector_type(4)));
template <class Epi, bool ALIGN_EPI, int F8 = 0  , int SCA = 127, int SCB = 127>
__device__ __forceinline__ void gemm_phase(LAS unsigned char* lds, const Gemm g, const GroupOrder& S, const Epi& E, int wv) {
    const int tid = otid(wv), wid = wv, lane = tid & 63, wr = wid >> 2, wc = wid & 3, fr = lane & 15, fq = lane >> 4;
    const int nt = g.K / BK;
    unsigned voffA[2], voffB[2];
#pragma unroll
    for (int i = 0; i < 2; ++i) { int R, C; stage_rc(tid * 16 + i * 8192, R, C); const int Rb = Epi::PERM ? ((R & ~31) + perm32(R & 31)) : R;
        voffA[i] = (unsigned)(R * g.lda + C) * 2u; voffB[i] = (unsigned)(Rb * g.ldb + C) * 2u; }
    const size_t kstep = (size_t)(BK * 2);
    const size_t hstepA = (size_t)HALF * g.lda * 2, hstepB = (size_t)HALF * g.ldb * 2;
    const size_t tstepA = 2 * hstepA, tstepB = 2 * hstepB;
    const unsigned ldsw = (unsigned)wid * 1024u;
    const int aoff = lds_byte(wr * 64 + fr, fq * 8), boff = lds_byte(wc * 32 + fr, fq * 8);
#define PG8_SA(b, h) (((b) * 2 + (h)) * HTB)
#define PG8_SB(b, h) ((4 + (b) * 2 + (h)) * HTB)
#define PG8_STAGE(bufoff, gbase, voff) do { _Pragma("unroll") for (int _i = 0; _i < 2; ++_i) { unsigned _vo = (voff)[_i]; asm volatile("" : "+v"(_vo)); \
        __builtin_amdgcn_global_load_lds((const unsigned*)((const char*)(gbase) + _vo), (LAS unsigned*)(lds + (bufoff) + ldsw + _i * 8192), 16, 0, 0); } } while (0)
#define PG8_LD2(p) __builtin_shufflevector(*(const LAS u32x4*)(p), *(const LAS u32x4*)((p) + 1024), 0, 1, 2, 3, 4, 5, 6, 7)
#define PG8_LDA(dst, b, h) do { _Pragma("unroll") for (int m = 0; m < 4; ++m) dst[m] = PG8_LD2(lds + PG8_SA(b, h) + aoff + m * 2048); } while (0)
#define PG8_LDB(dst, b, h) do { _Pragma("unroll") for (int n = 0; n < 2; ++n) dst[n] = PG8_LD2(lds + PG8_SB(b, h) + boff + n * 2048); } while (0)
#define PG8_LO(x) __builtin_bit_cast(bf16x8, __builtin_shufflevector(x, x, 0, 1, 2, 3))
#define PG8_HI(x) __builtin_bit_cast(bf16x8, __builtin_shufflevector(x, x, 4, 5, 6, 7))
#define PG8_MMA(ai, bj, At, Bt) do { __builtin_amdgcn_s_setprio(1); _Pragma("unroll") for (int m = 0; m < 4; ++m) _Pragma("unroll") for (int n = 0; n < 2; ++n) { \
        if constexpr (F8 == 1) acc[ai][bj][m][n] = __builtin_amdgcn_mfma_scale_f32_16x16x128_f8f6f4(__builtin_bit_cast(v8i32, Bt[n]), __builtin_bit_cast(v8i32, At[m]), acc[ai][bj][m][n], 0, 0, 0, SCB, 0, SCA); \
        else if constexpr (F8 == 2) { i32x4 c_ = __builtin_bit_cast(i32x4, acc[ai][bj][m][n]); \
               c_ = __builtin_amdgcn_mfma_i32_16x16x64_i8(__builtin_bit_cast(i32x4, PG8_LO(Bt[n])), __builtin_bit_cast(i32x4, PG8_LO(At[m])), c_, 0, 0, 0); \
               c_ = __builtin_amdgcn_mfma_i32_16x16x64_i8(__builtin_bit_cast(i32x4, PG8_HI(Bt[n])), __builtin_bit_cast(i32x4, PG8_HI(At[m])), c_, 0, 0, 0); acc[ai][bj][m][n] = __builtin_bit_cast(f32x4, c_); } \
        else { acc[ai][bj][m][n] = __builtin_amdgcn_mfma_f32_16x16x32_bf16(PG8_LO(Bt[n]), PG8_LO(At[m]), acc[ai][bj][m][n], 0, 0, 0); \
               acc[ai][bj][m][n] = __builtin_amdgcn_mfma_f32_16x16x32_bf16(PG8_HI(Bt[n]), PG8_HI(At[m]), acc[ai][bj][m][n], 0, 0, 0); } } \
        __builtin_amdgcn_s_setprio(0); } while (0)
#define PG8_WAIT_V(n) asm volatile("s_waitcnt vmcnt(" #n ")" ::: "memory")
#define PG8_WAIT_L(n) asm volatile("s_waitcnt lgkmcnt(" #n ")" ::: "memory")
#define PG8_BAR __builtin_amdgcn_s_barrier()
#define PG8_SCHED __builtin_amdgcn_sched_barrier(0)
    Unit cur, nxt; int ui = 0;
    if (!S.next(0, cur)) return;
    f32x4 acc[2][2][4][2];
#pragma unroll
    for (int a = 0; a < 2; ++a)
#pragma unroll
        for (int b = 0; b < 2; ++b)
#pragma unroll
            for (int m = 0; m < 4; ++m)
#pragma unroll
                for (int n = 0; n < 2; ++n) acc[a][b][m][n] = (f32x4){0.f, 0.f, 0.f, 0.f};
    u32x8 At[4], B0[2], B1[2];
    const char* cA = (const char*)g.A + (size_t)cur.pm * tstepA; const char* cB = (const char*)g.Bt + ((size_t)cur.e * g.estride) * 2 + (size_t)cur.pn * tstepB;
    PG8_STAGE(PG8_SB(0, 0), cB, voffB); PG8_STAGE(PG8_SB(0, 1), cB + hstepB, voffB); PG8_STAGE(PG8_SA(0, 0), cA, voffA); PG8_STAGE(PG8_SA(0, 1), cA + hstepA, voffA);
    if (wr == 1) PG8_BAR;
    PG8_WAIT_V(2); PG8_BAR;
    PG8_STAGE(PG8_SB(1, 0), cB + kstep, voffB); PG8_STAGE(PG8_SA(1, 0), cA + kstep, voffA); PG8_STAGE(PG8_SB(1, 1), cB + hstepB + kstep, voffB);
    PG8_WAIT_V(6); PG8_BAR;
    for (;;) {
        const bool has_next = S.next(ui + 1, nxt);
        const char* nA = has_next ? (const char*)g.A + (size_t)nxt.pm * tstepA : cA;
        const char* nB = has_next ? (const char*)g.Bt + ((size_t)nxt.e * g.estride) * 2 + (size_t)nxt.pn * tstepB : cB;
#pragma clang loop unroll(disable)
        for (int t = 0; t < nt; t += 2) {
            const bool last = (t == nt - 2);
            const char* a1 = cA + (size_t)(t + 1) * kstep;
            const char* a2 = last ? nA : cA + (size_t)(t + 2) * kstep; const char* b2 = last ? nB : cB + (size_t)(t + 2) * kstep;
            const char* a3 = a2 + kstep; const char* b3 = b2 + kstep;
            PG8_LDB(B0, 0, 0); PG8_LDB(B1, 0, 1); PG8_SCHED; PG8_LDA(At, 0, 0); PG8_STAGE(PG8_SA(1, 1), a1 + hstepA, voffA);
            PG8_WAIT_V(8); PG8_WAIT_L(0); PG8_BAR; PG8_MMA(0, 0, At, B0); PG8_MMA(0, 1, At, B1); PG8_BAR; PG8_SCHED;
            PG8_LDA(At, 0, 1); PG8_STAGE(PG8_SB(0, 0), b2, voffB); PG8_STAGE(PG8_SB(0, 1), b2 + hstepB, voffB); PG8_STAGE(PG8_SA(0, 0), a2, voffA);
            PG8_WAIT_V(8); PG8_WAIT_L(0); PG8_BAR; PG8_MMA(1, 0, At, B0); PG8_MMA(1, 1, At, B1); PG8_BAR; PG8_SCHED;
            PG8_LDB(B0, 1, 0); PG8_LDB(B1, 1, 1); PG8_SCHED; PG8_LDA(At, 1, 0); PG8_STAGE(PG8_SA(0, 1), a2 + hstepA, voffA);
            PG8_WAIT_V(8); PG8_WAIT_L(0); PG8_BAR; PG8_MMA(0, 0, At, B0); PG8_MMA(0, 1, At, B1); PG8_BAR; PG8_SCHED;
            PG8_LDA(At, 1, 1); PG8_STAGE(PG8_SB(1, 0), b3, voffB); PG8_STAGE(PG8_SB(1, 1), b3 + hstepB, voffB); PG8_STAGE(PG8_SA(1, 0), a3, voffA);
            PG8_WAIT_V(8); PG8_WAIT_L(0); PG8_BAR; PG8_MMA(1, 0, At, B0); PG8_MMA(1, 1, At, B1); PG8_BAR; PG8_SCHED;
        }
        if constexpr (ALIGN_EPI) { if (wr == 0) PG8_BAR; }
        { const int l2 = otid(wv) & 63; E(acc, cur, wr, wc, l2 & 15, l2 >> 4); }
        if (!has_next) break;
#pragma unroll
        for (int a = 0; a < 2; ++a)
#pragma unroll
            for (int b = 0; b < 2; ++b)
#pragma unroll
                for (int m = 0; m < 4; ++m)
#pragma unroll
                    for (int n = 0; n < 2; ++n) acc[a][b][m][n] = (f32x4){0.f, 0.f, 0.f, 0.f};
        cur = nxt; cA = nA; cB = nB; ++ui;
        if constexpr (ALIGN_EPI) { if (wr == 1) PG8_BAR; }
    }
    PG8_WAIT_V(0);
    if constexpr (!ALIGN_EPI) { if (wr == 0) PG8_BAR; }
    PG8_BAR;
#undef PG8_SA
#undef PG8_SB
#undef PG8_STAGE
#undef PG8_LDA
#undef PG8_LDB
#undef PG8_MMA
#undef PG8_LO
#undef PG8_HI
#undef PG8_LD2
#undef PG8_WAIT_V
#undef PG8_WAIT_L
#undef PG8_BAR
#undef PG8_SCHED
}

__device__ __forceinline__ void st8(bf16_t* p, f32x4 v0, f32x4 v1) {
    u32x4 w; w.x = cvt_pk_bf16(v0[0], v0[1]); w.y = cvt_pk_bf16(v0[2], v0[3]); w.z = cvt_pk_bf16(v1[0], v1[1]); w.w = cvt_pk_bf16(v1[2], v1[3]); *(u32x4*)p = w; }
__device__ __forceinline__ void rope8(f32x4& v0, f32x4& v1, const float* cs8) {
    const f32x4 c0 = *(const f32x4*)cs8, c1 = *(const f32x4*)(cs8 + 4);
    const float a0 = v0[0] * c0[0] - v0[1] * c0[1], a1 = v0[1] * c0[0] + v0[0] * c0[1];
    const float a2 = v0[2] * c0[2] - v0[3] * c0[3], a3 = v0[3] * c0[2] + v0[2] * c0[3];
    const float b0 = v1[0] * c1[0] - v1[1] * c1[1], b1 = v1[1] * c1[0] + v1[0] * c1[1];
    const float b2 = v1[2] * c1[2] - v1[3] * c1[3], b3 = v1[3] * c1[2] + v1[2] * c1[3];
    v0 = (f32x4){a0, a1, a2, a3}; v1 = (f32x4){b0, b1, b2, b3};
}

template <bool I8>
struct EpiProj {
    static constexpr bool PERM = true;
    bf16_t* P; float* rowss; const float* cs; const float* asc; const float* wsc;
    __device__ __forceinline__ void operator()(const f32x4 (&acc)[2][2][4][2], const Unit& u, int wr, int wc, int fr, int fq) const {
        const int row0 = u.pm * BM + wr * 64 + fr;
        float sa[2][4];
        if (I8) {
#pragma unroll
            for (int ai = 0; ai < 2; ++ai)
#pragma unroll
                for (int m = 0; m < 4; ++m) sa[ai][m] = asc[row0 + ai * HALF + m * 16]; }
#pragma unroll
        for (int bj = 0; bj < 2; ++bj) {
            const int cg = u.pn * BM + bj * HALF + wc * 32, col0 = cg + 8 * fq;
            const float sc = (cg < C_DK) ? C2D : 1.f;
            f32x4 sw0, sw1; if (I8) { sw0 = *(const f32x4*)(wsc + col0) * sc; sw1 = *(const f32x4*)(wsc + col0 + 4) * sc; }
            const bool do_ss = (cg >= C_MQ && cg < C_KR), do_rope = (cg == C_KR);
#pragma unroll
            for (int ai = 0; ai < 2; ++ai)
#pragma unroll
                for (int m = 0; m < 4; ++m) {
                    const int row = row0 + ai * HALF + m * 16;
                    f32x4 v0, v1;
                    if (I8) { const i32x4 i0 = __builtin_bit_cast(i32x4, acc[ai][bj][m][0]), i1 = __builtin_bit_cast(i32x4, acc[ai][bj][m][1]);
                        v0 = (f32x4){(float)i0[0], (float)i0[1], (float)i0[2], (float)i0[3]} * sw0 * sa[ai][m]; v1 = (f32x4){(float)i1[0], (float)i1[1], (float)i1[2], (float)i1[3]} * sw1 * sa[ai][m]; }
                    else { v0 = acc[ai][bj][m][0] * sc; v1 = acc[ai][bj][m][1] * sc; }
                    if (do_ss) { float s = (v0[0] * v0[0] + v0[1] * v0[1]) + (v0[2] * v0[2] + v0[3] * v0[3]) + (v1[0] * v1[0] + v1[1] * v1[1]) + (v1[2] * v1[2] + v1[3] * v1[3]);
                        s += sx<16>(s); s = x32_sum(s); if (fq == 0) rowss[(size_t)row * 20 + ((cg - C_MQ) >> 5)] = s; }
                    if (do_rope) rope8(v0, v1, cs + (size_t)row * 32 + 8 * fq);
                    st8(P + (size_t)row * INP + col0, v0, v1);
                }
        }
    }
};
struct EpiQ {
    static constexpr bool PERM = true;
    bf16_t* Q; const float* rowss; const float* cs;
    __device__ __forceinline__ void operator()(const f32x4 (&acc)[2][2][4][2], const Unit& u, int wr, int wc, int fr, int fq) const {
        const int row0 = u.pm * BM + wr * 64 + fr;
#pragma unroll
        for (int ai = 0; ai < 2; ++ai)
#pragma unroll
            for (int m = 0; m < 4; ++m) {
                const int row = row0 + ai * HALF + m * 16;
                const f32x4* rp = (const f32x4*)(rowss + (size_t)row * 20);
                const f32x4 s0 = rp[0], s1 = rp[1], s2 = rp[2];
                const float ss = ((s0[0] + s0[1]) + (s0[2] + s0[3])) + ((s1[0] + s1[1]) + (s1[2] + s1[3])) + ((s2[0] + s2[1]) + (s2[2] + s2[3]));
                const float rs = __builtin_amdgcn_rsqf(ss * (1.f / QR) + EPS) * C2M;
#pragma unroll
                for (int bj = 0; bj < 2; ++bj) {
                    const int cg = u.pn * BM + bj * HALF + wc * 32, col0 = cg + 8 * fq;
                    f32x4 v0 = acc[ai][bj][m][0] * rs, v1 = acc[ai][bj][m][1] * rs;
                    if ((cg % 96) == 64) rope8(v0, v1, cs + (size_t)row * 32 + 8 * fq);
                    st8(Q + (size_t)row * NQ + col0, v0, v1);
                }
            }
    }
};
struct EpiKV {
    static constexpr bool PERM = true;
    bf16_t* Kn; bf16_t* Vm; const float* rowss;
    __device__ __forceinline__ void operator()(const f32x4 (&acc)[2][2][4][2], const Unit& u, int wr, int wc, int fr, int fq) const {
        const int row0 = u.pm * BM + wr * 64 + fr;
        bf16_t* base = (u.pn < 2) ? Kn : Vm; const int colt = (u.pn & 1) * BM;
#pragma unroll
        for (int ai = 0; ai < 2; ++ai)
#pragma unroll
            for (int m = 0; m < 4; ++m) {
                const int row = row0 + ai * HALF + m * 16;
                const f32x4* rp = (const f32x4*)(rowss + (size_t)row * 20 + 12);
                const f32x4 s0 = rp[0], s1 = rp[1];
                const float ss = ((s0[0] + s0[1]) + (s0[2] + s0[3])) + ((s1[0] + s1[1]) + (s1[2] + s1[3]));
                const float rs = __builtin_amdgcn_rsqf(ss * (1.f / KVR) + EPS);
#pragma unroll
                for (int bj = 0; bj < 2; ++bj) {
                    const int col0 = colt + bj * HALF + wc * 32 + 8 * fq;
                    st8(base + (size_t)row * 512 + col0, acc[ai][bj][m][0] * rs, acc[ai][bj][m][1] * rs);
                }
            }
    }
};
struct EpiRes {
    static constexpr bool PERM = true;
    const float* base32; const bf16_t* base16; bf16_t* out; const float* gate;
    __device__ __forceinline__ void operator()(const f32x4 (&acc)[2][2][4][2], const Unit& u, int wr, int wc, int fr, int fq) const {
        const int row0 = u.pm * BM + wr * 64 + fr; const float* gp = gate + (size_t)(u.pm >> 3) * 6144;
#pragma unroll
        for (int bj = 0; bj < 2; ++bj) {
            const int col = u.pn * BM + bj * HALF + wc * 32 + 8 * fq;
            const f32x4 g0 = *(const f32x4*)(gp + col) + 1.0f, g1 = *(const f32x4*)(gp + col + 4) + 1.0f;
#pragma unroll
            for (int ai = 0; ai < 2; ++ai)
#pragma unroll
                for (int m = 0; m < 4; ++m) { const size_t off = (size_t)(row0 + ai * HALF + m * 16) * DM + col;
                    f32x4 b0, b1;
                    if (base32) { b0 = *(const f32x4*)(base32 + off); b1 = *(const f32x4*)(base32 + off + 4); }
                    else { const u32x4 w = *(const u32x4*)(base16 + off); b0 = (f32x4){bf_lo(w.x), bf_hi(w.x), bf_lo(w.y), bf_hi(w.y)}; b1 = (f32x4){bf_lo(w.z), bf_hi(w.z), bf_lo(w.w), bf_hi(w.w)}; }
                    st8(out + off, b0 + g0 * acc[ai][bj][m][0], b1 + g1 * acc[ai][bj][m][1]); }
        }
    }
};
template <bool I8>
struct EpiSwiGLU {
    static constexpr bool PERM = true;
    unsigned char* U;
    int dummy;
    const float* asc; const float* wsc;
    __device__ __forceinline__ void operator()(const f32x4 (&acc)[2][2][4][2], const Unit& u, int wr, int wc, int fr, int fq) const {
        if (dummy) return;
        const int row0 = u.pm * BM + wr * 64 + fr, col0 = u.pn * HALF + wc * 32 + 8 * fq;
        f32x4 sw[2][2];
        if (I8) { const float* wp = wsc + (size_t)u.e * (2 * DFF) + u.pn * BM + wc * 32 + 8 * fq;
#pragma unroll
            for (int bj = 0; bj < 2; ++bj) { sw[bj][0] = *(const f32x4*)(wp + bj * HALF); sw[bj][1] = *(const f32x4*)(wp + bj * HALF + 4); } }
#pragma unroll
        for (int ai = 0; ai < 2; ++ai)
#pragma unroll
            for (int m = 0; m < 4; ++m) {
                const int row = row0 + ai * HALF + m * 16;
                float sa = 1.f; if (I8) sa = asc[row];
                f32x4 r[2];
#pragma unroll
                for (int n = 0; n < 2; ++n) { f32x4 a = acc[ai][0][m][n], b = acc[ai][1][m][n];
                    if (I8) { const i32x4 ia = __builtin_bit_cast(i32x4, a), ib = __builtin_bit_cast(i32x4, b);
                        a = (f32x4){(float)ia[0], (float)ia[1], (float)ia[2], (float)ia[3]} * sw[0][n] * sa; b = (f32x4){(float)ib[0], (float)ib[1], (float)ib[2], (float)ib[3]} * sw[1][n] * sa; }
#pragma unroll
                    for (int k = 0; k < 4; ++k) { const float e = __builtin_amdgcn_exp2f(-a[k] * LOG2E); r[n][k] = a[k] * __builtin_amdgcn_rcpf(1.f + e) * b[k] * USCALE; } }
                u32x2 w; w.x = pk_fp8x4(r[0][0], r[0][1], r[0][2], r[0][3]); w.y = pk_fp8x4(r[1][0], r[1][1], r[1][2], r[1][3]);
                *(u32x2*)(U + (size_t)row * DFF + col0) = w;
            }
    }
};
struct EpiDown {
    static constexpr bool PERM = true;
    bf16_t* Y; const float* gslot;
    __device__ __forceinline__ void operator()(const f32x4 (&acc)[2][2][4][2], const Unit& u, int wr, int wc, int fr, int fq) const {
        const int row0 = u.pm * BM + wr * 64 + fr;
#pragma unroll
        for (int ai = 0; ai < 2; ++ai)
#pragma unroll
            for (int m = 0; m < 4; ++m) {
                const int row = row0 + ai * HALF + m * 16; const float gv = gslot ? gslot[row] : 1.f;
#pragma unroll
                for (int bj = 0; bj < 2; ++bj) st8(Y + (size_t)row * DM + u.pn * BM + bj * HALF + wc * 32 + 8 * fq, acc[ai][bj][m][0] * gv, acc[ai][bj][m][1] * gv);
            }
    }
};
}

namespace att {
constexpr int NSLOT = 4, KBMAX = 12288, VBMAX = 16384;
constexpr int OFF_V = NSLOT * KBMAX, OFF_WS = OFF_V + NSLOT * VBMAX, OFF_LUT = OFF_WS + 8 * 256, OFF_Q = OFF_LUT + 512;
static_assert(OFF_Q + 16 <= RING_BYTES, "attention LDS map");
__device__ __forceinline__ void glds16(const void* gsrc, unsigned lds_dst) { unsigned keep;
    asm volatile("s_mov_b32 %0, m0\n\ts_mov_b32 m0, %2\n\ts_nop 0\n\tglobal_load_lds_dwordx4 %1, off\n\ts_mov_b32 m0, %0" : "=&s"(keep) : "v"(gsrc), "s"(lds_dst) : "memory"); }
constexpr float THR = 8.f;
#define SBAR() __builtin_amdgcn_sched_barrier(0)
__device__ __forceinline__ int crow(int r, int hi) { return (r & 3) + 8 * (r >> 2) + 4 * hi; }
template <int DV> __device__ __forceinline__ int v_st(int k, int c) { const int kk = (k & ~0xC) | ((k & 4) << 1) | ((k & 8) >> 1); return ((kk >> 3) * (DV / 32) + (c >> 5)) * 512 + ((kk & 7) * 32 + (c & 31)) * 2; }
__device__ __forceinline__ int v_rd_base(int lane) { return ((lane & 3) << 3) | (((lane >> 2) & 3) << 6) | (((lane >> 4) & 1) << 5) | (((lane >> 5) & 1) << 8); }
template <int DV> constexpr int v_rd_off(int d0, int ks, int half) { return ((2 * ks + half) * (DV / 32) + d0) * 512; }
template <int OFF> __device__ __forceinline__ s16x4 tr_read(int vb) { s16x4 r; asm volatile("ds_read_b64_tr_b16 %0, %1 offset:%2" : "=&v"(r) : "v"(vb), "i"(OFF) : "memory"); return r; }
template <int DV, int D0> __device__ __forceinline__ void pv_one(f32x16& od, int vb, bf16x8 pa0, bf16x8 pa1, bf16x8 pa2, bf16x8 pa3) {
    const s16x4 l0 = tr_read<v_rd_off<DV>(D0, 0, 0)>(vb), h0 = tr_read<v_rd_off<DV>(D0, 0, 1)>(vb), l1 = tr_read<v_rd_off<DV>(D0, 1, 0)>(vb), h1 = tr_read<v_rd_off<DV>(D0, 1, 1)>(vb);
    const s16x4 l2 = tr_read<v_rd_off<DV>(D0, 2, 0)>(vb), h2 = tr_read<v_rd_off<DV>(D0, 2, 1)>(vb), l3 = tr_read<v_rd_off<DV>(D0, 3, 0)>(vb), h3 = tr_read<v_rd_off<DV>(D0, 3, 1)>(vb);
    asm volatile("s_waitcnt lgkmcnt(0)" ::: "memory"); SBAR();
#define PK(L, H) (bf16x8){L[0], L[1], L[2], L[3], H[0], H[1], H[2], H[3]}
    od = __builtin_amdgcn_mfma_f32_32x32x16_bf16(pa0, PK(l0, h0), od, 0, 0, 0);
    od = __builtin_amdgcn_mfma_f32_32x32x16_bf16(pa1, PK(l1, h1), od, 0, 0, 0);
    od = __builtin_amdgcn_mfma_f32_32x32x16_bf16(pa2, PK(l2, h2), od, 0, 0, 0);
    od = __builtin_amdgcn_mfma_f32_32x32x16_bf16(pa3, PK(l3, h3), od, 0, 0, 0);
#undef PK
}
template <int DV, int KS_, int D0> __device__ __forceinline__ void pv_rd(s16x4 (&lo)[DV / 32], s16x4 (&hi)[DV / 32], int vb) {
    lo[D0] = tr_read<v_rd_off<DV>(D0, KS_, 0)>(vb); hi[D0] = tr_read<v_rd_off<DV>(D0, KS_, 1)>(vb);
    if constexpr (D0 + 1 < DV / 32) pv_rd<DV, KS_, D0 + 1>(lo, hi, vb);
}
template <int DV> __device__ __forceinline__ void pv_all(f32x16 (&o)[DV / 32], f32x16& lacc, int vb, bf16x8 pa0, bf16x8 pa1, bf16x8 pa2, bf16x8 pa3) {
    constexpr int NO = DV / 32;
    const bf16x8 ones = {0x3F80, 0x3F80, 0x3F80, 0x3F80, 0x3F80, 0x3F80, 0x3F80, 0x3F80};
    s16x4 la[NO], ha[NO], lb[NO], hb[NO];
#define PK(L, H) (bf16x8){L[0], L[1], L[2], L[3], H[0], H[1], H[2], H[3]}
#define PVW(n) do { if (n == 8) asm volatile("s_waitcnt lgkmcnt(8)" ::: "memory"); else if (n == 4) asm volatile("s_waitcnt lgkmcnt(4)" ::: "memory"); else asm volatile("s_waitcnt lgkmcnt(0)" ::: "memory"); SBAR(); } while (0)
    pv_rd<DV, 0, 0>(la, ha, vb); pv_rd<DV, 1, 0>(lb, hb, vb); PVW(2 * NO);
#pragma unroll
    for (int d = 0; d < NO; ++d) o[d] = __builtin_amdgcn_mfma_f32_32x32x16_bf16(pa0, PK(la[d], ha[d]), o[d], 0, 0, 0);
    lacc = __builtin_amdgcn_mfma_f32_32x32x16_bf16(pa0, ones, lacc, 0, 0, 0);
    SBAR(); pv_rd<DV, 2, 0>(la, ha, vb); PVW(2 * NO);
#pragma unroll
    for (int d = 0; d < NO; ++d) o[d] = __builtin_amdgcn_mfma_f32_32x32x16_bf16(pa1, PK(lb[d], hb[d]), o[d], 0, 0, 0);
    lacc = __builtin_amdgcn_mfma_f32_32x32x16_bf16(pa1, ones, lacc, 0, 0, 0);
    SBAR(); pv_rd<DV, 3, 0>(lb, hb, vb); PVW(2 * NO);
#pragma unroll
    for (int d = 0; d < NO; ++d) o[d] = __builtin_amdgcn_mfma_f32_32x32x16_bf16(pa2, PK(la[d], ha[d]), o[d], 0, 0, 0);
    lacc = __builtin_amdgcn_mfma_f32_32x32x16_bf16(pa2, ones, lacc, 0, 0, 0);
    PVW(0);
#pragma unroll
    for (int d = 0; d < NO; ++d) o[d] = __builtin_amdgcn_mfma_f32_32x32x16_bf16(pa3, PK(lb[d], hb[d]), o[d], 0, 0, 0);
    lacc = __builtin_amdgcn_mfma_f32_32x32x16_bf16(pa3, ones, lacc, 0, 0, 0);
#undef PK
#undef PVW
}
__device__ __forceinline__ int rel_bucket(int n) {
    if (n < 16) return n;
    const int v = 16 + (int)(logf((float)n * (1.f / 16.f)) * (16.f / 2.0794415416798357f));
    return v < 31 ? v : 31;
}

template <int DQK, int DV, bool BIAS, int ABL = 0>
__device__ __forceinline__ void attn_core(const bf16_t* __restrict__ Qp, const bf16_t* __restrict__ K1, int ldk1, const bf16_t* __restrict__ K2, int ldk2,
                                          const bf16_t* __restrict__ Vp, int ldv, const int* __restrict__ posb, int posq, int qfirst, int qidx, int NT,
                                          const int* __restrict__ kmaxb, int qmin_w, float bias_far, LAS unsigned char* lds, int tid, int wid, int lane,
                                          f32x16 (&o)[DV / 32], f32x16& lacc) {
    constexpr int KB = 8 * DQK * 16, VB = 64 * DV * 2, ND = DQK / 16, NO = DV / 32, NVP = DV / 64;
    const int r32 = lane & 31, hi = lane >> 5, grp = wid >> 2;
    LAS unsigned char* Kl = lds; LAS unsigned char* Vl = lds + OFF_V;
    LAS float* wsc = (LAS float*)(lds + OFF_WS) + wid * 64; const LAS float* lut = (const LAS float*)(lds + OFF_LUT);
    bf16x8 qr[ND];
#pragma unroll
    for (int d0 = 0; d0 < ND; ++d0) qr[d0] = *(const bf16x8*)(Qp + d0 * 16 + hi * 8);
    float m_reg = 0.f; lacc = f32x16{};
    const u32x4 kxu = {hi == 0 ? 0xBF80BF80u : 0u, 0u, 0u, 0u}; const bf16x8 kx = __builtin_bit_cast(bf16x8, kxu);
#pragma unroll
    for (int d = 0; d < NO; ++d) o[d] = f32x16{};
    const bf16_t* ksrc = K1 + (size_t)lane * ldk1 + wid * 8;
    const bf16_t* ksrc2 = (DQK == 96) ? K2 + (size_t)lane * ldk2 + (wid & 3) * 8 : nullptr;
    const bf16_t* vsrc[NVP]; unsigned vdst[NVP];
#pragma unroll
    for (int q = 0; q < NVP; ++q) { const int p = wid * NVP + q, s = 2 * p + (lane >> 5), kk = 8 * (s / (DV / 32)) + ((lane & 31) >> 2), c = 32 * (s % (DV / 32)) + 8 * (lane & 3);
        const int k = (kk & ~0xC) | ((kk & 4) << 1) | ((kk & 8) >> 1);
        vsrc[q] = Vp + (size_t)k * ldv + c; vdst[q] = (unsigned)(uintptr_t)Vl + p * 1024; }
    const unsigned kdst = (unsigned)(uintptr_t)Kl + wid * 1024, kdst2 = (unsigned)(uintptr_t)Kl + (8 + (wid & 3)) * 1024;
    const int vb0 = (int)(unsigned)(uintptr_t)Vl + v_rd_base(lane);
#define RFL(x) ((unsigned)__builtin_amdgcn_readfirstlane((int)(x)))
#define DMA_K(t) do { if (ABL & 8) break; const int t_ = (t) < NT ? (t) : NT - 1; glds16(ksrc + (size_t)t_ * 64 * ldk1, RFL(kdst + ((t) & 3) * KB)); \
        if (DQK == 96) { if (grp == 0) glds16(ksrc2 + (size_t)t_ * 64 * ldk2, RFL(kdst2 + ((t) & 3) * KB)); } } while (0)
#define DMA_V(t) do { if (ABL & 8) break; const int t_ = (t) < NT ? (t) : NT - 1; _Pragma("unroll") for (int q = 0; q < NVP; ++q) glds16(vsrc[q] + (size_t)t_ * 64 * ldv, RFL(vdst[q] + ((t) & 3) * VB)); } while (0)
#define WAITBAR_G0() do { if (DQK == 96) asm volatile("s_waitcnt vmcnt(6) lgkmcnt(0)\n\ts_barrier" ::: "memory"); else if (NVP == 2) asm volatile("s_waitcnt vmcnt(6) lgkmcnt(0)\n\ts_barrier" ::: "memory"); \
        else asm volatile("s_waitcnt vmcnt(4) lgkmcnt(0)\n\ts_barrier" ::: "memory"); } while (0)
#define WAITBAR_G1() do { if (DQK == 96) asm volatile("s_waitcnt vmcnt(2) lgkmcnt(0)\n\ts_barrier" ::: "memory"); else if (NVP == 2) asm volatile("s_waitcnt vmcnt(3) lgkmcnt(0)\n\ts_barrier" ::: "memory"); \
        else asm volatile("s_waitcnt vmcnt(2) lgkmcnt(0)\n\ts_barrier" ::: "memory"); } while (0)
#define PBAR() asm volatile("s_waitcnt lgkmcnt(0)\n\ts_barrier" ::: "memory")
#define QKT(t) do { if (ABL & 4) { _Pragma("unroll") for (int r = 0; r < 16; ++r) { p0[r] = 0.f; p1[r] = 0.f; } break; } const LAS unsigned char* Kc = Kl + ((t) & 3) * KB + hi * 1024 + r32 * 16; \
        bool far_ = false; if (BIAS) far_ = (qmin_w - kmaxb[t]) >= 113; isfar = far_; \
          \
        { const float me = m_reg - ((BIAS && far_) ? bias_far : 0.f); const unsigned bh = cvt_pk_bf16(me, 0.f) & 0xffffu; const unsigned bl = cvt_pk_bf16(me - __uint_as_float(bh << 16), 0.f) & 0xffffu; \
          const u32x4 qx = {hi == 0 ? (bh | (bl << 16)) : 0u, 0u, 0u, 0u}; \
          p0 = __builtin_amdgcn_mfma_f32_32x32x16_bf16(kx, __builtin_bit_cast(bf16x8, qx), f32x16{}, 0, 0, 0); p1 = __builtin_amdgcn_mfma_f32_32x32x16_bf16(kx, __builtin_bit_cast(bf16x8, qx), f32x16{}, 0, 0, 0); } \
        _Pragma("unroll") for (int d0 = 0; d0 < ND; ++d0) { \
            const bf16x8 b0 = *(const LAS bf16x8*)(Kc + d0 * 2048), b1 = *(const LAS bf16x8*)(Kc + d0 * 2048 + 512); \
            p0 = __builtin_amdgcn_mfma_f32_32x32x16_bf16(b0, qr[d0], p0, 0, 0, 0); p1 = __builtin_amdgcn_mfma_f32_32x32x16_bf16(b1, qr[d0], p1, 0, 0, 0); } } while (0)
    f32x16 p0, p1; bool isfar = false; bf16x8 pa0, pa1, pa2, pa3;
    DMA_K(0); DMA_V(0); DMA_K(1); DMA_V(1); DMA_K(2);
    asm volatile("s_waitcnt vmcnt(0) lgkmcnt(0)\n\ts_barrier" ::: "memory");
    if (grp) PBAR();
    if (0 <= qfirst + 31) QKT(0);
    if (grp) WAITBAR_G1(); else PBAR();
    for (int i = 0; i < ((ABL & 16) ? 0 : NT); ++i) {
        const int kv0 = i * 64; const bool act = kv0 <= qfirst + 31;
        DMA_K(i + 3); DMA_V(i + 2);
        if (act && (ABL & 1)) { pa0 = __builtin_bit_cast(bf16x8, (f32x4){p0[0], p0[1], p0[2], p0[3]}); pa1 = __builtin_bit_cast(bf16x8, (f32x4){p0[4], p0[5], p0[6], p0[7]}); pa2 = __builtin_bit_cast(bf16x8, (f32x4){p1[0], p1[1], p1[2], p1[3]}); pa3 = __builtin_bit_cast(bf16x8, (f32x4){p1[4], p1[5], p1[6], p1[7]});
#pragma unroll
            for (int r = 0; r < 16; ++r) lacc[r] = 1.f; }
        if (act && !(ABL & 1)) {
            if (BIAS) { if (!isfar) {
                GAS const int* pb = (GAS const int*)(posb + kv0 + 4 * hi); asm volatile("" : "+v"(pb));
#pragma unroll
                for (int r = 0; r < 16; ++r) {
                    const int cr = (r & 3) + 8 * (r >> 2);
                    int d0_ = posq - pb[cr]; d0_ = d0_ < 0 ? 0 : (d0_ > 127 ? 127 : d0_);
                    int d1_ = posq - pb[cr + 32]; d1_ = d1_ < 0 ? 0 : (d1_ > 127 ? 127 : d1_);
                    p0[r] += lut[d0_]; p1[r] += lut[d1_]; } } }
            if (kv0 + 63 > qfirst) {
                int lim = qidx - kv0 - 4 * hi; asm volatile("" : "+v"(lim));
#pragma unroll
                for (int r = 0; r < 16; ++r) { const int cr = (r & 3) + 8 * (r >> 2); if (cr > lim) p0[r] = -INFINITY; if (cr + 32 > lim) p1[r] = -INFINITY; }
            }
            float pmax = p0[0];
#pragma unroll
            for (int r = 1; r < 16; ++r) pmax = fmaxf(pmax, p0[r]);
#pragma unroll
            for (int r = 0; r < 16; ++r) pmax = fmaxf(pmax, p1[r]);
            { auto rr = __builtin_amdgcn_permlane32_swap(__float_as_uint(pmax), __float_as_uint(pmax), false, false); pmax = fmaxf(__uint_as_float(rr[0]), __uint_as_float(rr[1])); }
            float alpha = 1.f;
            if (i == 0 || !__all(pmax <= THR)) { const float dl = (i == 0) ? pmax : fmaxf(pmax, 0.f); m_reg += dl; alpha = (i == 0) ? 1.f : __builtin_amdgcn_exp2f(-dl);
#pragma unroll
                for (int r = 0; r < 16; ++r) { p0[r] -= dl; p1[r] -= dl; } }
#pragma unroll
            for (int r = 0; r < 16; ++r) { p0[r] = __builtin_amdgcn_exp2f(p0[r]); p1[r] = __builtin_amdgcn_exp2f(p1[r]); }
            if (__any(alpha < 1.f)) { if (hi == 0) wsc[r32] = alpha; asm volatile("s_waitcnt lgkmcnt(0)" ::: "memory");
                const LAS float* wb = wsc + 4 * hi; asm volatile("" : "+v"(wb));
#pragma unroll
                for (int r = 0; r < 16; ++r) { const float a = wb[(r & 3) + 8 * (r >> 2)]; lacc[r] *= a;
#pragma unroll
                    for (int d = 0; d < NO; ++d) o[d][r] *= a; }
                asm volatile("s_waitcnt lgkmcnt(0)" ::: "memory"); }
#define PK4(P, BASE, OUT) do { unsigned a0 = cvt_pk_bf16(P[BASE + 0], P[BASE + 1]), a1 = cvt_pk_bf16(P[BASE + 2], P[BASE + 3]);   \
    unsigned b0 = cvt_pk_bf16(P[BASE + 4], P[BASE + 5]), b1 = cvt_pk_bf16(P[BASE + 6], P[BASE + 7]);                              \
    auto r0 = __builtin_amdgcn_permlane32_swap(a0, b0, false, false); auto r1 = __builtin_amdgcn_permlane32_swap(a1, b1, false, false); \
    u32x4 w = {r0[0], r1[0], r0[1], r1[1]}; OUT = __builtin_bit_cast(bf16x8, w); } while (0)
            PK4(p0, 0, pa0); PK4(p0, 8, pa1); PK4(p1, 0, pa2); PK4(p1, 8, pa3);
#undef PK4
        }
        if (grp) PBAR(); else WAITBAR_G0();
        if (act) {
            const int vb = vb0 + (i & 3) * VB;
            if (!(ABL & 2)) pv_all<DV>(o, lacc, vb, pa0, pa1, pa2, pa3);
        }
        if (i + 1 < NT && kv0 + 64 <= qfirst + 31) QKT(i + 1);
        if (grp) WAITBAR_G1(); else PBAR();
    }
    asm volatile("s_waitcnt vmcnt(0)" ::: "memory");
    if (!grp) PBAR();
    PBAR();
#undef RFL
#undef DMA_K
#undef DMA_V
#undef WAITBAR_G0
#undef WAITBAR_G1
#undef PBAR
#undef QKT
}

__device__ __forceinline__ bool decode_unit(int idx, int& type, int& qb, int& bh) {
    constexpr int NCLS = 16;
    constexpr int ctype[NCLS] = {0, 0, 0, 0, 0, 1, 0, 1, 1, 1, 0, 1, 1, 0, 1, 1};
    constexpr int cqb[NCLS]   = {7, 6, 5, 4, 3, 7, 2, 6, 5, 4, 1, 3, 2, 0, 1, 0};
    int start = 0; bool found = false;
#pragma unroll
    for (int c = 0; c < NCLS; ++c) { const int n = ctype[c] ? 64 : 32; if (!found && idx < start + n) { type = ctype[c]; qb = cqb[c]; bh = idx - start; found = true; } start += n; }
    return found;
}
constexpr int NUNITS = 768;

struct AttnArgs { const int* bkt; const bf16_t* proj; const bf16_t* qm; const bf16_t* kn; const bf16_t* vm; bf16_t* ao; float* stash; const int* pos; const int* kmax; const int* qmin;
                  const float* rel_bias; const float* subln_g; float lam, lam_init; };

template <int ABL = 0>
__device__ __forceinline__ void attn_phase(LAS unsigned char* lds, const AttnArgs& A, gu32* qctr, int wv) {
    const int wid = wv;
    LAS float* wsc = (LAS float*)(lds + OFF_WS) + wid * 64; LAS float* lut = (LAS float*)(lds + OFF_LUT); volatile LAS int* qw = (volatile LAS int*)(lds + OFF_Q);
    if (wid >= 4) __builtin_amdgcn_s_setprio(1);
    for (;;) {
        const int tid = otid(wv), lane = tid & 63, r32 = lane & 31, hi = lane >> 5;
        if (tid == 0) qw[0] = (int)__hip_atomic_fetch_add(qctr, 1u, RLX_AGENT);
        __syncthreads();
        const int idx = qw[0];
        __syncthreads();
        if (idx >= NUNITS) break;
        int type = 0, qb = 0, bh = 0; decode_unit(idx, type, qb, bh);
        const int q0 = qb * 256, NT = (q0 + 256) / 64, qfirst = q0 + wid * 32, qidx = qfirst + r32;
        if (type == 0) {
            const int b = bh >> 2, h = bh & 3; const size_t rowbase = (size_t)b * SEQ;
            const int* posb = A.pos + b * SEQ; const int posq = posb[qidx]; const int qmin_w = A.qmin[b * 64 + (qfirst >> 5)];
            if (tid < 128) { const float bv = A.rel_bias[A.bkt[tid] * 4 + h] * LOG2E; lut[otid(wv)] = bv; }
            const float bias_far = A.rel_bias[31 * 4 + h] * LOG2E;
            __syncthreads();
            float* st = A.stash + (size_t)blockIdx.x * 32768;
            for (int mp = 0; mp < 2; ++mp) {
                f32x16 o[4]; f32x16 l;
                attn_core<64, 128, true, ABL>(A.proj + (rowbase + qidx) * INP + C_DQ + h * 128 + mp * 64, A.proj + rowbase * INP + C_DK + h * 128 + mp * 64, INP, nullptr, 0,
                                         A.proj + rowbase * INP + C_DV + h * 128, INP, posb, posq, qfirst, qidx, NT, A.kmax + b * 32, qmin_w, bias_far, lds, tid, wid, lane, o, l);
                float rli[16];
#pragma unroll
                for (int r = 0; r < 16; ++r) rli[r] = __builtin_amdgcn_rcpf(l[r]);
                GAS float* stp = (GAS float*)(st + tid); asm volatile("" : "+v"(stp));
                if (mp == 0) {
#pragma unroll
                    for (int d = 0; d < 4; ++d)
#pragma unroll
                        for (int r = 0; r < 16; ++r) stp[(d * 16 + r) * 512] = o[d][r] * rli[r];
                } else {
                    const float lam = A.lam, post = 1.f - A.lam_init;
                    float gv[4];
#pragma unroll
                    for (int d = 0; d < 4; ++d) gv[d] = A.subln_g[d * 32 + r32] * post;
                    GAS bf16_t* aop = (GAS bf16_t*)(A.ao + (rowbase + qfirst + 4 * hi) * DM + h * 128 + r32); asm volatile("" : "+v"(aop));
#pragma unroll
                    for (int r = 0; r < 16; ++r) {
                        float v[4], ss = 0.f;
#pragma unroll
                        for (int d = 0; d < 4; ++d) { v[d] = stp[(d * 16 + r) * 512] - lam * (o[d][r] * rli[r]); ss += v[d] * v[d]; }
                        ss += sx<1>(ss); ss += sx<2>(ss); ss += sx<4>(ss); ss += sx<8>(ss); ss += sx<16>(ss);
                        const float rn = __builtin_amdgcn_rsqf(ss * (1.f / 128.f) + EPS);
                        GAS bf16_t* op = aop + (size_t)((r & 3) + 8 * (r >> 2)) * DM;
#pragma unroll
                        for (int d = 0; d < 4; ++d) op[d * 32] = (bf16_t)(cvt_pk_bf16(v[d] * rn * gv[d], 0.f) & 0xffffu);
                    }
                }
            }
        } else {
            const int b = bh >> 3, h = bh & 7; const size_t rowbase = (size_t)b * SEQ;
            f32x16 o[2]; f32x16 l;
            attn_core<96, 64, false, ABL>(A.qm + (rowbase + qidx) * NQ + h * 96, A.kn + rowbase * 512 + h * 64, 512, A.proj + rowbase * INP + C_KR, INP,
                                     A.vm + rowbase * 512 + h * 64, 512, nullptr, 0, qfirst, qidx, NT, nullptr, 0, 0.f, lds, tid, wid, lane, o, l);
            GAS bf16_t* aop = (GAS bf16_t*)(A.ao + (rowbase + qfirst + 4 * hi) * DM + 512 + h * 64 + r32); asm volatile("" : "+v"(aop));
#pragma unroll
            for (int r = 0; r < 16; ++r) { const float rl = __builtin_amdgcn_rcpf(l[r]);
                GAS bf16_t* op = aop + (size_t)((r & 3) + 8 * (r >> 2)) * DM;
#pragma unroll
                for (int d = 0; d < 2; ++d) op[d * 32] = (bf16_t)(cvt_pk_bf16(o[d][r] * rl, 0.f) & 0xffffu); }
            asm volatile("s_waitcnt lgkmcnt(0)" ::: "memory");
        }
    }
    __builtin_amdgcn_s_setprio(0);
}
#undef SBAR
}

#define XB_TMO      128
#define XB_XCNT(j)  (256  + 64 * (j))
#define XB_XSUB(j)  (1280 + 64 * (j))
#define XB_XGEN(j)  (2304 + 64 * (j))
#define XB_TOP      3328
#define XB_TOPGEN   3392
#define XCD_BAR_WORDS 3456
#define XB_SPIN_CAP (1u << 18)
__device__ __forceinline__ unsigned xb_ld(unsigned* p)              { return __hip_atomic_load(p, __ATOMIC_RELAXED, __HIP_MEMORY_SCOPE_AGENT); }
__device__ __forceinline__ unsigned xb_add(unsigned* p, unsigned v) { return __hip_atomic_fetch_add(p, v, __ATOMIC_RELAXED, __HIP_MEMORY_SCOPE_AGENT); }
__device__ __forceinline__ unsigned xb_xcc_id() { return (unsigned)__builtin_amdgcn_s_getreg((3 << 11) | 20) & 0xFu; }
#define XB_SPIN(cond, bar) do { unsigned _sp = 0; while (cond) { __builtin_amdgcn_s_sleep(1); \
    if ((++_sp & 255u) == 0u) { if (xb_ld(&(bar)[XB_TMO])) break; if (_sp > XB_SPIN_CAP) { atomicAdd(&(bar)[XB_TMO], 1u); break; } } } } while (0)
struct XcdBarrier { unsigned* bar; unsigned x; volatile LAS unsigned* st; };
__device__ __forceinline__ XcdBarrier xcd_barrier_post(unsigned* bar, volatile LAS unsigned* st) {
    XcdBarrier b; b.bar = bar; b.x = xb_xcc_id(); b.st = st;
    if (threadIdx.x == 0) (void)xb_add(&bar[XB_XCNT(b.x)], 1u);
    return b;
}
__device__ __forceinline__ void xcd_barrier_complete(unsigned* bar, unsigned x, unsigned& nloc, unsigned& nx) {
    const unsigned G = gridDim.x * gridDim.y * gridDim.z;
    unsigned sum, cnt, mine, sp = 0u;
    for (;;) {
        sum = 0u; cnt = 0u; mine = 0u;
#pragma unroll
        for (unsigned j = 0; j < 16; ++j) { const unsigned c = xb_ld(&bar[XB_XCNT(j)]); sum += c; cnt += (c > 0u) ? 1u : 0u; mine = (j == x) ? c : mine; }
        if (sum == G) break;
        __builtin_amdgcn_s_sleep(1);
        if ((++sp & 255u) == 0u) { if (xb_ld(&bar[XB_TMO])) break; if (sp > XB_SPIN_CAP) { atomicAdd(&bar[XB_TMO], 1u); break; } }
    }
    nloc = mine > 0u ? mine : 1u; nx = cnt > 0u ? cnt : 1u;
}
__device__ __forceinline__ void xcd_barrier(const XcdBarrier& b) {
    asm volatile("s_waitcnt vmcnt(0)" ::: "memory");
    __syncthreads();
    if (threadIdx.x == 0) {
        GAS unsigned* gbar = (GAS unsigned*)b.bar; unsigned bx_ = b.x;
        asm volatile("" : "+s"(gbar), "+s"(bx_));
        unsigned* bar = (unsigned*)gbar;
        __builtin_amdgcn_s_waitcnt(0);
        unsigned nloc = b.st[0], nx = b.st[1];
        if (nloc == 0u) { xcd_barrier_complete(bar, bx_, nloc, nx); b.st[0] = nloc; b.st[1] = nx; }
        const unsigned old = xb_add(&bar[XB_XSUB(bx_)], 1u);
        const unsigned gen = old / nloc;
        if (old + 1u == (gen + 1u) * nloc) {
            __builtin_amdgcn_fence(__ATOMIC_RELEASE, "agent");
            asm volatile("s_waitcnt vmcnt(0)" ::: "memory");
            const unsigned og = xb_add(&bar[XB_TOP], 1u);
            const unsigned tg = og / nx;
            if (og + 1u == (tg + 1u) * nx) xb_add(&bar[XB_TOPGEN], 1u);
            else XB_SPIN(xb_ld(&bar[XB_TOPGEN]) == tg, bar);
            __builtin_amdgcn_fence(__ATOMIC_ACQUIRE, "agent");
            xb_add(&bar[XB_XGEN(bx_)], 1u);
            asm volatile("s_waitcnt vmcnt(0)" ::: "memory");
        } else {
            XB_SPIN(xb_ld(&bar[XB_XGEN(bx_)]) == gen, bar);
            __builtin_amdgcn_fence(__ATOMIC_ACQUIRE, "agent");
            asm volatile("s_waitcnt vmcnt(0)" ::: "memory");
        }
    }
    __syncthreads();
}

struct Args {
    const float* in[24]; float* out; unsigned char* ws; int ph_lo, ph_hi;
};
enum { I_X = 0, I_C, I_POS, I_WADA, I_BADA, I_GATTN, I_WIN, I_DLAM, I_SUBG, I_RELB, I_QNORM, I_WUQ, I_KVNORM, I_WUKV, I_WO, I_GFFN, I_W1, I_W3, I_W2, I_ROUTER, I_MW1, I_MW3, I_MW2, I_GFINAL };

__device__ __forceinline__ int rowmap(int kind, int n) {
    switch (kind) {
        case 1: { if (n < C_KR) return n; const int i = n - C_KR; return C_KR + (i < 16 ? 2 * i : 2 * (i - 16) + 1); }
        case 2: { const int h = n / 96, j = n % 96; if (j < 64) return n; return h * 96 + 64 + (j < 80 ? 2 * (j - 64) : 2 * (j - 80) + 1); }
        case 3: { const int h = n >> 7, j = n & 127; return j < 64 ? h * 64 + j : 512 + h * 64 + (j - 64); }
        case 4: return (n >> 7) * 256 + (n & 127);
        case 5: return (n >> 7) * 256 + 128 + (n & 127);
        default: return n;
    }
}
__device__ __forceinline__ void transpose_item(const float* W, int K, int N, bf16_t* WT, int kind, const float* gain, LAS float* scr, int item, int lane) {
    const int nblk = N / 32, kb = item / nblk, nb = item % nblk, k0 = 64 * kb, n0 = 32 * nb;
#pragma unroll 8
    for (int i = 0; i < 32; ++i) { const int kk = 2 * i + (lane >> 5); float v = __builtin_nontemporal_load(W + (size_t)(k0 + kk) * N + n0 + (lane & 31)); if (gain) v *= gain[k0 + kk]; scr[kk * 33 + (lane & 31)] = v; }
    LDS_WAIT(); asm volatile("" ::: "memory");
    const int c = lane & 7;
#pragma unroll
    for (int j = 0; j < 4; ++j) { const int n = (lane >> 3) + 8 * j; const LAS float* s = scr + (8 * c) * 33 + n;
        u32x4 o; o.x = cvt_pk_bf16(s[0 * 33], s[1 * 33]); o.y = cvt_pk_bf16(s[2 * 33], s[3 * 33]); o.z = cvt_pk_bf16(s[4 * 33], s[5 * 33]); o.w = cvt_pk_bf16(s[6 * 33], s[7 * 33]);
        *(u32x4*)(WT + (size_t)rowmap(kind, n0 + n) * K + k0 + 8 * c) = o; }
    LDS_WAIT(); asm volatile("" ::: "memory");
}

__device__ __forceinline__ void transpose_item_f8(const float* W, int K, int N, unsigned char* WT, int kind, LAS float* scr, int item, int lane) {
    const int nblk = N / 32, kb = item / nblk, nb = item % nblk, k0 = 64 * kb, n0 = 32 * nb;
#pragma unroll 8
    for (int i = 0; i < 32; ++i) { const int kk = 2 * i + (lane >> 5); scr[kk * 33 + (lane & 31)] = __builtin_nontemporal_load(W + (size_t)(k0 + kk) * N + n0 + (lane & 31)) * WSCALE; }
    LDS_WAIT(); asm volatile("" ::: "memory");
#pragma unroll
    for (int j = 0; j < 2; ++j) { const int idx = lane + 64 * j, n = idx >> 2, c = idx & 3; const LAS float* s = scr + (16 * c) * 33 + n;
        u32x4 o; o.x = pk_fp8x4(s[0 * 33], s[1 * 33], s[2 * 33], s[3 * 33]); o.y = pk_fp8x4(s[4 * 33], s[5 * 33], s[6 * 33], s[7 * 33]);
        o.z = pk_fp8x4(s[8 * 33], s[9 * 33], s[10 * 33], s[11 * 33]); o.w = pk_fp8x4(s[12 * 33], s[13 * 33], s[14 * 33], s[15 * 33]);
        *(u32x4*)(WT + (size_t)rowmap(kind, n0 + n) * K + k0 + 16 * c) = o; }
    LDS_WAIT(); asm volatile("" ::: "memory");
}

template <int PM = 7  >
__device__ __forceinline__ void prologue(LAS unsigned char* lds, int vcu, int G, int wv) {
    const int tid = otid(wv), lane = tid & 63, wave = wv;
    unsigned char* ws = karg_ws(okarg());
    if (PM & 1) {
        LAS float* sl = (LAS float*)lds;
        LAS float* red = (LAS float*)(lds + 32768);
        const float* c = karg_in(okarg(), I_C);
        for (int i = tid; i < NB * DM; i += 512) { const int b = i >> 10, k = i & 1023; const float v = c[i]; sl[k * 8 + b] = v / (1.f + __expf(-v)); }
        __syncthreads();
        float* mod = (float*)(ws + WS_MOD);
        for (int it = vcu; it < DEPTH * 48; it += G) {
            const int l = it / 48, n0 = (it % 48) * 128, cl = tid & 31, ks = tid >> 5;
            const float* wp = karg_in(okarg(), I_WADA) + (size_t)l * DM * 6144 + (size_t)(ks * 64) * 6144 + n0 + 4 * cl;
            f32x4 acc[8];
#pragma unroll
            for (int b = 0; b < 8; ++b) acc[b] = (f32x4){0.f, 0.f, 0.f, 0.f};
#pragma unroll 8
            for (int k = 0; k < 64; ++k) { const f32x4 w = __builtin_nontemporal_load((const f32x4*)(wp + (size_t)k * 6144));
                const f32x4 s0 = *(const LAS f32x4*)(sl + (ks * 64 + k) * 8), s1 = *(const LAS f32x4*)(sl + (ks * 64 + k) * 8 + 4);
                acc[0] += w * s0[0]; acc[1] += w * s0[1]; acc[2] += w * s0[2]; acc[3] += w * s0[3]; acc[4] += w * s1[0]; acc[5] += w * s1[1]; acc[6] += w * s1[2]; acc[7] += w * s1[3]; }
#pragma unroll
            for (int b = 0; b < 8; ++b) *(LAS f32x4*)(red + (ks * 8 + b) * 128 + 4 * cl) = acc[b];
            __syncthreads();
            for (int o = tid; o < 1024; o += 512) { const int b = o >> 7, n = o & 127; float s = 0.f;
#pragma unroll
                for (int k2 = 0; k2 < 16; ++k2) s += red[(k2 * 8 + b) * 128 + n];
                mod[((size_t)l * 8 + b) * 6144 + n0 + n] = s + karg_in(okarg(), I_BADA)[(size_t)l * 6144 + n0 + n]; }
            __syncthreads();
        }
    }
    {
        const int* pos = (const int*)karg_in(okarg(), I_POS);
        float* cs = (float*)(ws + WS_CS);
        for (int i = vcu * 512 + tid; i < M * 16; i += G * 512) {
            const int row = i >> 4, f = i & 15;
            const double base[4] = {1.0, 0.5623413251903491, 0.31622776601683794, 0.1778279410038923};
            double inv = base[f & 3]; for (int q = 0; q < (f >> 2); ++q) inv *= 0.1;
            const double rev = (double)pos[row] * inv * 0.15915494309189535;
            const float fr = (float)(rev - rint(rev));
            cs[2 * i] = __builtin_amdgcn_cosf(fr); cs[2 * i + 1] = __builtin_amdgcn_sinf(fr);
        }
        int* kmax = (int*)(ws + WS_MISC) + 64; int* qmin = kmax + 256; float* lamv = (float*)(ws + WS_MISC);
        if (vcu == 1 % G) {
            if (tid < 256) { int mx = pos[tid * 64]; for (int k = 1; k < 64; ++k) { const int p = pos[tid * 64 + k]; mx = p > mx ? p : mx; } kmax[tid] = mx; }
            { int mn = pos[tid * 32]; for (int k = 1; k < 32; ++k) { const int p = pos[tid * 32 + k]; mn = p < mn ? p : mn; } qmin[tid] = mn; }
        }
        if (vcu == 3 % G && tid < 128) ((int*)(ws + WS_MISC))[2048 + tid] = att::rel_bucket(tid);
        if (vcu == 2 % G && tid < DEPTH) {
            const float* lv = karg_in(okarg(), I_DLAM) + tid * 256; float s1 = 0.f, s2 = 0.f;
            for (int k = 0; k < 64; ++k) { s1 += lv[k] * lv[64 + k]; s2 += lv[128 + k] * lv[192 + k]; }
            lamv[tid] = expf(s1) - expf(s2) + (0.8f - 0.6f * expf(-0.3f * (float)tid));
        }
    }
    __syncthreads();
    if ((F8_UP == 2 || IN_I8) && (PM & 2)) {
        LAS float* scr = (LAS float*)lds; LAS float* red = (LAS float*)(lds + 133120); LAS float* cinv = (LAS float*)(lds + 133120 + 2048);
        constexpr int N_UP = (F8_UP == 2) ? 36 * 88 : 0, N_IN = IN_I8 ? 4 * 69 : 0;
#define LBAR() asm volatile("s_waitcnt lgkmcnt(0)\n\ts_barrier" ::: "memory")
#define STRIP_SRC(it_, W_, ldw_, n0_) do { if ((it_) < N_UP) { const int mat_ = (it_) / 88, w3_ = mat_ & 1, dm_ = mat_ >> 1; n0_ = ((it_) % 88) * 32; ldw_ = DFF; \
                W_ = (dm_ < 2) ? karg_in(okarg(), w3_ ? I_W3 : I_W1) + (size_t)dm_ * DM * DFF : karg_in(okarg(), w3_ ? I_MW3 : I_MW1) + (size_t)(dm_ - 2) * DM * DFF; } \
            else { const int r_ = (it_) - N_UP; n0_ = (r_ % 69) * 32; ldw_ = INW; W_ = karg_in(okarg(), I_WIN) + (size_t)(r_ / 69) * DM * INW; } } while (0)
#define STRIP_LOAD(it_) do { const float* W_; int ldw_, n0_; STRIP_SRC(it_, W_, ldw_, n0_); const float* wp_ = W_ + (size_t)(128 * wave + (lane >> 5)) * ldw_ + n0_ + (lane & 31); \
            _Pragma("unroll") for (int i = 0; i < 64; ++i) rv[i] = __builtin_nontemporal_load(wp_ + (size_t)(2 * i) * ldw_); } while (0)
        float rv[64];
        if (vcu < N_UP + N_IN) STRIP_LOAD(vcu);
        for (int it = vcu; it < N_UP + N_IN; it += G) {
            unsigned char* WT; float* sc; int n0, kind;
            if (it < N_UP) { const int mat = it / 88, w3 = mat & 1, dm = mat >> 1;
                n0 = (it % 88) * 32; kind = 4 + w3;
                WT = (dm < 2) ? ws + WS_WD13 + (size_t)dm * 2 * DFF * DM : ws + WS_WM13 + (size_t)(dm - 2) * 2 * DFF * DM;
                sc = (float*)(ws + WS_WSC) + (size_t)dm * (2 * DFF);
            } else { const int r = it - N_UP, l = r / 69; n0 = (r % 69) * 32; kind = 1;
                WT = ws + WS_WIN + (size_t)l * INP * DM; sc = (float*)(ws + WS_WSC2) + (size_t)l * INP; }
#pragma unroll
            for (int i = 0; i < 64; ++i) { const int k = 128 * wave + 2 * i + (lane >> 5), n = lane & 31; scr[k * 32 + ((n + (k >> 4)) & 31)] = rv[i]; }
            if (it + G < N_UP + N_IN) STRIP_LOAD(it + G);
            LBAR();
            { const int n = tid & 31, ks = tid >> 5; float m = 0.f;
#pragma unroll 16
              for (int k = 64 * ks; k < 64 * ks + 64; ++k) m = fmaxf(m, fabsf(scr[k * 32 + ((n + (k >> 4)) & 31)]));
              red[ks * 32 + n] = m; }
            LBAR();
            if (tid < 32) { float m = 0.f;
#pragma unroll
                for (int s = 0; s < 16; ++s) m = fmaxf(m, red[s * 32 + tid]);
                cinv[tid] = m > 0.f ? 127.f / m : 0.f; sc[rowmap(kind, n0 + tid)] = m > 0.f ? m * (1.f / 127.f) : 1.f; }
            LBAR();
#pragma unroll
            for (int j = 0; j < 4; ++j) { const int nl = 4 * wave + j, c = lane; const float iv = cinv[nl];
                const LAS float* s = scr + (16 * c) * 32 + ((nl + c) & 31);
                u32x4 o; o.x = pk_i8x4(s[0] * iv, s[32] * iv, s[64] * iv, s[96] * iv); o.y = pk_i8x4(s[128] * iv, s[160] * iv, s[192] * iv, s[224] * iv);
                o.z = pk_i8x4(s[256] * iv, s[288] * iv, s[320] * iv, s[352] * iv); o.w = pk_i8x4(s[384] * iv, s[416] * iv, s[448] * iv, s[480] * iv);
                *(u32x4*)(WT + (size_t)rowmap(kind, n0 + nl) * DM + 16 * c) = o; }
            LBAR();
        }
#undef LBAR
#undef STRIP_SRC
#undef STRIP_LOAD
    }
    if (PM & 4) {
        LAS float* scr = (LAS float*)(lds + wave * 16384);
        const int gw = vcu * 8 + wave, NGW = G * 8;
        constexpr int IA = 16 * 69, IB = 6 * 24, IC = 4 * 32, ID = 16 * 32, IE = 16 * 88, IF = 44 * 32;
        constexpr int NA = IN_I8 ? 0 : 4 * IA, NBq = 4 * IB, NC = 4 * IC, ND = 4 * ID, NE = (F8_UP == 2) ? 0 : 4 * IE, NF = 2 * IF, NG = (F8_UP == 2) ? 0 : 32 * IE, NH = 16 * IF;
        constexpr int NITEMS = NA + NBq + NC + ND + NE + NF + NG + NH;
        struct TD { const float* W; const float* gain; unsigned char* WT; int K, N, kind, f8, item; };
#define TDEC(it_, d) do { int r = (it_); \
            if (r < NA) { const int l = r / IA; d = TD{karg_in(okarg(), I_WIN) + (size_t)l * DM * INW, nullptr, ws + WS_WIN + (size_t)l * INP * DM * 2, DM, INW, 1, 0, r % IA}; break; } r -= NA; \
            if (r < NBq) { const int l = r / IB; d = TD{karg_in(okarg(), I_WUQ) + (size_t)l * QR * NQ, karg_in(okarg(), I_QNORM) + l * QR, ws + WS_WUQ + (size_t)l * NQ * QR * 2, QR, NQ, 2, 0, r % IB}; break; } r -= NBq; \
            if (r < NC) { const int l = r / IC; d = TD{karg_in(okarg(), I_WUKV) + (size_t)l * KVR * NKV, karg_in(okarg(), I_KVNORM) + l * KVR, ws + WS_WUKV + (size_t)l * NKV * KVR * 2, KVR, NKV, 3, 0, r % IC}; break; } r -= NC; \
            if (r < ND) { const int l = r / ID; d = TD{karg_in(okarg(), I_WO) + (size_t)l * DM * DM, nullptr, ws + WS_WO + (size_t)l * DM * DM * 2, DM, DM, 0, 0, r % ID}; break; } r -= ND; \
            if (r < NE) { const int j = r / IE, dl = j >> 1, w3 = j & 1; d = TD{karg_in(okarg(), w3 ? I_W3 : I_W1) + (size_t)dl * DM * DFF, nullptr, ws + WS_WD13 + (size_t)dl * 2 * DFF * DM * (F8_UP ? 1 : 2), DM, DFF, 4 + w3, F8_UP ? 1 : 0, r % IE}; break; } r -= NE; \
            if (r < NF) { const int dl = r / IF; d = TD{karg_in(okarg(), I_W2) + (size_t)dl * DFF * DM, nullptr, ws + WS_WD2 + (size_t)dl * DM * DFF, DFF, DM, 0, 1, r % IF}; break; } r -= NF; \
            if (r < NG) { const int j = r / IE, me = j >> 1, w3 = j & 1; d = TD{karg_in(okarg(), w3 ? I_MW3 : I_MW1) + (size_t)me * DM * DFF, nullptr, ws + WS_WM13 + (size_t)me * 2 * DFF * DM * (F8_UP ? 1 : 2), DM, DFF, 4 + w3, F8_UP ? 1 : 0, r % IE}; break; } r -= NG; \
            { const int me = r / IF; d = TD{karg_in(okarg(), I_MW2) + (size_t)me * DFF * DM, nullptr, ws + WS_WM2 + (size_t)me * DM * DFF, DFF, DM, 0, 1, r % IF}; } } while (0)
#define TLOAD(d) do { const int nblk_ = d.N / 32, k0_ = 64 * (d.item / nblk_), n0_ = 32 * (d.item % nblk_); const float* wp_ = d.W + (size_t)(k0_ + (lane >> 5)) * d.N + n0_ + (lane & 31); \
            _Pragma("unroll") for (int i = 0; i < 32; ++i) tv[i] = __builtin_nontemporal_load(wp_ + (size_t)(2 * i) * d.N); } while (0)
        float tv[32]; TD cur{}, nxt{};
        if (gw < NITEMS) { TDEC(gw, cur); TLOAD(cur); }
        for (int it = gw; it < NITEMS; it += NGW) {
            const int nblk = cur.N / 32, k0 = 64 * (cur.item / nblk), n0 = 32 * (cur.item % nblk);
#pragma unroll
            for (int i = 0; i < 32; ++i) { const int kk = 2 * i + (lane >> 5); float v = tv[i]; if (cur.gain) v *= cur.gain[k0 + kk]; if (cur.f8) v *= WSCALE; scr[kk * 33 + (lane & 31)] = v; }
            const bool hn = it + NGW < NITEMS;
            if (hn) { TDEC(it + NGW, nxt); TLOAD(nxt); }
            LDS_WAIT(); asm volatile("" ::: "memory");
            if (cur.f8) {
#pragma unroll
                for (int j = 0; j < 2; ++j) { const int idx = lane + 64 * j, n = idx >> 2, c = idx & 3; const LAS float* s = scr + (16 * c) * 33 + n;
                    u32x4 o; o.x = pk_fp8x4(s[0 * 33], s[1 * 33], s[2 * 33], s[3 * 33]); o.y = pk_fp8x4(s[4 * 33], s[5 * 33], s[6 * 33], s[7 * 33]);
                    o.z = pk_fp8x4(s[8 * 33], s[9 * 33], s[10 * 33], s[11 * 33]); o.w = pk_fp8x4(s[12 * 33], s[13 * 33], s[14 * 33], s[15 * 33]);
                    *(u32x4*)(cur.WT + (size_t)rowmap(cur.kind, n0 + n) * cur.K + k0 + 16 * c) = o; }
            } else { const int c = lane & 7;
#pragma unroll
                for (int j = 0; j < 4; ++j) { const int n = (lane >> 3) + 8 * j; const LAS float* s = scr + (8 * c) * 33 + n;
                    u32x4 o; o.x = cvt_pk_bf16(s[0 * 33], s[1 * 33]); o.y = cvt_pk_bf16(s[2 * 33], s[3 * 33]); o.z = cvt_pk_bf16(s[4 * 33], s[5 * 33]); o.w = cvt_pk_bf16(s[6 * 33], s[7 * 33]);
                    *(u32x4*)((bf16_t*)cur.WT + (size_t)rowmap(cur.kind, n0 + n) * cur.K + k0 + 8 * c) = o; }
            }
            LDS_WAIT(); asm volatile("" ::: "memory");
            cur = nxt;
        }
#undef TDEC
#undef TLOAD
    }    __syncthreads();
}

template <int MODE, int F8O = 0, bool XF32 = false>
__device__ __forceinline__ void norm_phase(const void* xin_, void* xout_, float* asc, const bf16_t* yp, const int* slot0, const int* slot1, const float* gate_prev  ,
                                           const float* gvec, const float* modl, int ch_sh, int ch_sc, bf16_t* H,
                                           const float* wrouter, unsigned* cnt, int* re0, int* re1, int* rr0, int* rr1, float* rg0, float* rg1,
                                           LAS unsigned char* lds, int vcu, int G, int wv) {
    const int tid = otid(wv), lane = tid & 63, wave = wv;
    const int gw = vcu * 8 + wave;
    LAS float* wr_l = (LAS float*)lds;
    LAS int* rsel = (LAS int*)(lds + 32768); LAS float* rgate = (LAS float*)(lds + 32768 + 512); LAS int* rrank = (LAS int*)(lds + 32768 + 1024); LAS int* rbase = (LAS int*)(lds + 32768 + 1536);
    if (MODE == 1) { for (int i = tid; i < DM * NEXP / 4; i += 512) ((LAS f32x4*)wr_l)[i] = ((const f32x4*)wrouter)[i]; __syncthreads(); }
    const int mbase = gw * 8, b = mbase >> 11;
    f32x4 gs[4], sh4[4], gp[4];
#pragma unroll
    for (int j = 0; j < 4; ++j) { const int col = 4 * lane + 256 * j;
        if (MODE == 2) gs[j] = *(const f32x4*)(gvec + col);
        else { gs[j] = *(const f32x4*)(gvec + col) * (*(const f32x4*)(modl + (size_t)b * 6144 + ch_sc * DM + col) + 1.0f); sh4[j] = *(const f32x4*)(modl + (size_t)b * 6144 + ch_sh * DM + col); }
        if (yp) gp[j] = *(const f32x4*)(gate_prev + (size_t)b * 6144 + col) + 1.0f; }
#pragma unroll 1
    for (int grp = 0; grp < 2; ++grp) {
        const int m0 = mbase + grp * 4;
        f32x4 v[4][4]; u32x2 y0[4][4], y1[4][4]; int s1v[4];
        if (yp) {
#pragma unroll
            for (int r = 0; r < 4; ++r) { const int m = m0 + r;
                const int s0 = slot0 ? __builtin_amdgcn_readfirstlane(slot0[m]) : m; s1v[r] = slot1 ? __builtin_amdgcn_readfirstlane(slot1[m]) : -1;
#pragma unroll
                for (int j = 0; j < 4; ++j) { const int col = 4 * lane + 256 * j; y0[r][j] = *(const u32x2*)(yp + (size_t)s0 * DM + col); if (s1v[r] >= 0) y1[r][j] = *(const u32x2*)(yp + (size_t)s1v[r] * DM + col); } }
        }
#pragma unroll
        for (int r = 0; r < 4; ++r)
#pragma unroll
            for (int j = 0; j < 4; ++j) { const size_t off = (size_t)(m0 + r) * DM + 4 * lane + 256 * j;
                if (XF32) v[r][j] = *(const f32x4*)((const float*)xin_ + off);
                else { const u32x2 w = *(const u32x2*)((const bf16_t*)xin_ + off); v[r][j] = (f32x4){bf_lo(w.x), bf_hi(w.x), bf_lo(w.y), bf_hi(w.y)}; } }
#pragma unroll
        for (int r = 0; r < 4; ++r) {
            const int m = m0 + r;
            if (yp) {
#pragma unroll
                for (int j = 0; j < 4; ++j) { const int col = 4 * lane + 256 * j;
                    f32x4 y = (f32x4){bf_lo(y0[r][j].x), bf_hi(y0[r][j].x), bf_lo(y0[r][j].y), bf_hi(y0[r][j].y)};
                    if (s1v[r] >= 0) y += (f32x4){bf_lo(y1[r][j].x), bf_hi(y1[r][j].x), bf_lo(y1[r][j].y), bf_hi(y1[r][j].y)};
                    v[r][j] += gp[j] * y;
                    if (MODE != 2) { u32x2 w; w.x = cvt_pk_bf16(v[r][j][0], v[r][j][1]); w.y = cvt_pk_bf16(v[r][j][2], v[r][j][3]); *(u32x2*)((bf16_t*)xout_ + (size_t)m * DM + col) = w; } }
            }
            float ss = 0.f;
#pragma unroll
            for (int j = 0; j < 4; ++j) ss += (v[r][j][0] * v[r][j][0] + v[r][j][1] * v[r][j][1]) + (v[r][j][2] * v[r][j][2] + v[r][j][3] * v[r][j][3]);
            const float rs = 1.0f / sqrtf(wave_sum(ss) * (1.f / DM) + EPS);
            if (MODE == 2) {
#pragma unroll
                for (int j = 0; j < 4; ++j) *(f32x4*)((float*)xout_ + (size_t)m * DM + 4 * lane + 256 * j) = v[r][j] * rs * gs[j];
            } else {
                float lg[NEXP];
#pragma unroll
                for (int e = 0; e < NEXP; ++e) lg[e] = 0.f;
                float qinv = 0.f;
                if (F8O == 2) {
                    float am = 0.f;
#pragma unroll
                    for (int j = 0; j < 4; ++j) { const f32x4 h = v[r][j] * rs * gs[j] + sh4[j]; am = fmaxf(am, fmaxf(fmaxf(fabsf(h[0]), fabsf(h[1])), fmaxf(fabsf(h[2]), fabsf(h[3])))); }
                    am = wave_max(am); qinv = am > 0.f ? 127.f / am : 0.f; if (lane == 0) asc[m] = am > 0.f ? am * (1.f / 127.f) : 1.f;
                }
#pragma unroll
                for (int j = 0; j < 4; ++j) {
                    const int col = 4 * lane + 256 * j;
                    const f32x4 h = v[r][j] * rs * gs[j] + sh4[j];
                    if (F8O == 2) *(unsigned*)((unsigned char*)H + (size_t)m * DM + col) = pk_i8x4(h[0] * qinv, h[1] * qinv, h[2] * qinv, h[3] * qinv);
                    else if (F8O == 1) *(unsigned*)((unsigned char*)H + (size_t)m * DM + col) = pk_fp8x4(h[0] * HSCALE, h[1] * HSCALE, h[2] * HSCALE, h[3] * HSCALE);
                    else { u32x2 w; w.x = cvt_pk_bf16(h[0], h[1]); w.y = cvt_pk_bf16(h[2], h[3]); *(u32x2*)(H + (size_t)m * DM + col) = w; }
                    if (MODE == 1) {
#pragma unroll
                        for (int k = 0; k < 4; ++k) { const f32x4 w0 = *(const LAS f32x4*)(wr_l + (col + k) * 8), w1 = *(const LAS f32x4*)(wr_l + (col + k) * 8 + 4);
                            lg[0] += h[k] * w0[0]; lg[1] += h[k] * w0[1]; lg[2] += h[k] * w0[2]; lg[3] += h[k] * w0[3]; lg[4] += h[k] * w1[0]; lg[5] += h[k] * w1[1]; lg[6] += h[k] * w1[2]; lg[7] += h[k] * w1[3]; }
                    }
                }
                if (MODE == 1) {
#pragma unroll
                    for (int e = 0; e < NEXP; ++e) lg[e] = wave_sum(lg[e]);
                    int e0 = 0; float v0 = lg[0];
#pragma unroll
                    for (int e = 1; e < NEXP; ++e) if (lg[e] > v0) { v0 = lg[e]; e0 = e; }
                    int e1 = -1; float v1 = -INFINITY;
#pragma unroll
                    for (int e = 0; e < NEXP; ++e) if (e != e0 && lg[e] > v1) { v1 = lg[e]; e1 = e; }
                    const float g0 = 1.f / (1.f + __expf(v1 - v0)), g1 = 1.f - g0;
                    if (lane == 0) { const int rl = m - vcu * 64; rsel[rl * 2] = e0; rsel[rl * 2 + 1] = e1; rgate[rl * 2] = g0; rgate[rl * 2 + 1] = g1; }
                }
            }
        }
    }
    if (MODE == 1) {
        __syncthreads();
        if (tid < NEXP) { int c = 0; for (int p = 0; p < 128; ++p) if (rsel[p] == tid) { rrank[p] = c; ++c; }
            rbase[tid] = c ? (int)__hip_atomic_fetch_add(cnt + tid, (unsigned)c, RLX_AGENT) : 0; }
        __syncthreads();
        if (tid < 64) { const int m = vcu * 64 + tid; const int e0 = rsel[2 * tid], e1 = rsel[2 * tid + 1];
            re0[m] = e0; re1[m] = e1; rr0[m] = rbase[e0] + rrank[2 * tid]; rr1[m] = rbase[e1] + rrank[2 * tid + 1]; rg0[m] = rgate[2 * tid]; rg1[m] = rgate[2 * tid + 1]; }
    }
}

__device__ __forceinline__ void gather_phase(const bf16_t* H, bf16_t* HP, unsigned* cnt, const int* re0, const int* re1, const int* rr0, const int* rr1, const float* rg0, const float* rg1,
                                             int* slot0, int* slot1, float* gslot, int* pexp, const float* asc, float* asl, int vcu, int G, int wv) {
    const int tid = otid(wv), lane = tid & 63, wave = wv;
    const int gw = vcu * 8 + wave, NGW = G * 8;
    int off[NEXP]; int tot;
    { int s = 0;
#pragma unroll
        for (int e = 0; e < NEXP; ++e) { off[e] = s; s += (((int)__hip_atomic_load(cnt + e, RLX_AGENT) + 255) >> 8) << 8; }
        tot = s; }
    if (vcu == 0 && tid < 160) {
        int e = 0;
#pragma unroll
        for (int k = 1; k < NEXP; ++k) e += (tid * 256 >= off[k]) ? 1 : 0;
        pexp[tid] = e; if (tid == 0) pexp[160] = tot >> 8;
    }
    for (int m = gw; m < M; m += NGW) {
        const int e0 = re0[m], e1 = re1[m]; int o0 = 0, o1 = 0;
#pragma unroll
        for (int e = 0; e < NEXP; ++e) { o0 = (e == e0) ? off[e] : o0; o1 = (e == e1) ? off[e] : o1; }
        const int s0 = o0 + rr0[m], s1 = o1 + rr1[m];
        if (F8_UP) { const u32x4 x0 = ((const u32x4*)((const unsigned char*)H + (size_t)m * DM))[lane];
            ((u32x4*)((unsigned char*)HP + (size_t)s0 * DM))[lane] = x0; ((u32x4*)((unsigned char*)HP + (size_t)s1 * DM))[lane] = x0; }
        else { const u32x4* srcp = (const u32x4*)(H + (size_t)m * DM); const u32x4 x0 = srcp[lane], x1 = srcp[64 + lane];
            u32x4* d0 = (u32x4*)(HP + (size_t)s0 * DM); u32x4* d1 = (u32x4*)(HP + (size_t)s1 * DM); d0[lane] = x0; d0[64 + lane] = x1; d1[lane] = x0; d1[64 + lane] = x1; }
        if (lane == 0) { slot0[m] = s0; slot1[m] = s1; gslot[s0] = rg0[m]; gslot[s1] = rg1[m]; if (F8_UP == 2) { const float a = asc[m]; asl[s0] = a; asl[s1] = a; } }
    }
}

__global__ void __launch_bounds__(512, 2) mk_fwd(Args args) {
    extern __shared__ __attribute__((aligned(16))) unsigned char lds_raw[];
    LAS unsigned char* lds = (LAS unsigned char*)lds_raw;
    volatile LAS unsigned* MISC = (volatile LAS unsigned*)(lds + MISC_OFF);
    const int tid = threadIdx.x; const int wv = __builtin_amdgcn_readfirstlane(tid >> 6);
    constexpr int G = 256;
    const int bx = blockIdx.x; const int vcu = (bx % 8) * (G / 8) + bx / 8;
    gu32* ctl = (gu32*)(karg_ws(okarg()) + WS_CTL);
    for (int u = tid; u < (LDS_BYTES - LDSCTL_OFF) / 4; u += 512) ((LAS unsigned*)(lds + LDSCTL_OFF))[u] = 0u;
    __syncthreads();
    XcdBarrier bar = xcd_barrier_post((unsigned*)ctl + CW_BAR, MISC + 8);
    const int lo = karg_lo(okarg()), hi = karg_hi(okarg());
#define IN(k) (lo <= (k) && (k) < hi)
#define SEAM(k) do { if (IN(k) && IN((k) + 1)) { xcd_barrier(bar); if (PREPS(9) == 2) xcd_barrier(bar); } } while (0)

#define WSP(T, off) ((T*)(w + (off)))
    if (IN(0)) { prologue<7>(lds, vcu, G, wv); if (PROBE_PMASK) prologue<PROBE_PMASK>(lds, vcu, G, wv); }
    SEAM(0);

    for (int l = 0; l < DEPTH; ++l) {
        const int pb = 1 + l * NPH_L; const bool moe = (l & 1) != 0; const int li = l >> 1;
        if (IN(pb + 0)) {
            kptr_t ka = okarg(); const int bxo = osi(bx), vco = osi(vcu); (void)bxo; (void)vco; unsigned char* w = karg_ws(ka); const float* modl = WSP(float, WS_MOD) + (size_t)l * 8 * 6144; int* RT = WSP(int, WS_ROUTE);
            if (l == 0) norm_phase<0, IN_I8 ? 2 : 0, true>(karg_in(ka, I_X), nullptr, WSP(float, WS_ROUTE) + 8 * M, nullptr, nullptr, nullptr, nullptr, karg_in(ka, I_GATTN), modl, 0, 1, WSP(bf16_t, WS_H), nullptr, nullptr, nullptr, nullptr, nullptr, nullptr, nullptr, nullptr, lds, vco, G, wv);
            else { const bool pm = ((l - 1) & 1) != 0;
                norm_phase<0, IN_I8 ? 2 : 0>(WSP(bf16_t, WS_XB), WSP(bf16_t, WS_XB), WSP(float, WS_ROUTE) + 8 * M, WSP(bf16_t, WS_YP), pm ? RT + 6 * M : nullptr, pm ? RT + 7 * M : nullptr, WSP(float, WS_MOD) + (size_t)(l - 1) * 8 * 6144 + 5 * DM, karg_in(ka, I_GATTN) + l * DM, modl, 0, 1, WSP(bf16_t, WS_H), nullptr, nullptr, nullptr, nullptr, nullptr, nullptr, nullptr, nullptr, lds, vco, G, wv); }
        }
        SEAM(pb + 0);
        if (IN(pb + 1)) {
            kptr_t ka = okarg(); const int bxo = osi(bx), vco = osi(vcu); (void)bxo; (void)vco; unsigned char* w = karg_ws(ka);
            constexpr int KI = IN_I8 ? DM / 2 : DM;
            pg8::Gemm g{WSP(bf16_t, WS_H), (const bf16_t*)(w + WS_WIN + (size_t)l * INP * DM * (IN_I8 ? 1 : 2)), KI, KI, KI, 0};
            pg8::GroupOrder S; S.init(M / 256, INP / 256, G, bxo, nullptr);
            pg8::EpiProj<IN_I8 != 0> E{WSP(bf16_t, WS_PROJ), WSP(float, WS_ROWSS), WSP(float, WS_CS), WSP(float, WS_ROUTE) + 8 * M, WSP(float, WS_WSC2) + (size_t)l * INP};
            for (int rp = 0; rp < PREPS(4); ++rp) pg8::gemm_phase<pg8::EpiProj<IN_I8 != 0>, true, IN_I8 ? 2 : 0>(lds, g, S, E, wv);
        }
        SEAM(pb + 1);
        if (IN(pb + 2)) { for (int rp = 0; rp < PREPS(5); ++rp) {
            { kptr_t ka = okarg(); const int bxo = osi(bx), vco = osi(vcu); (void)bxo; (void)vco; unsigned char* w = karg_ws(ka);
              pg8::Gemm g{WSP(bf16_t, WS_PROJ) + C_MQ, WSP(bf16_t, WS_WUQ) + (size_t)l * NQ * QR, INP, QR, QR, 0};
              pg8::GroupOrder S; S.init(M / 256, NQ / 256, G, bxo, nullptr);
              pg8::EpiQ E{WSP(bf16_t, WS_QM), WSP(float, WS_ROWSS), WSP(float, WS_CS)};
              pg8::gemm_phase<pg8::EpiQ, true>(lds, g, S, E, wv); }
            { kptr_t ka = okarg(); const int bxo = osi(bx), vco = osi(vcu); (void)bxo; (void)vco; unsigned char* w = karg_ws(ka);
              pg8::Gemm g{WSP(bf16_t, WS_PROJ) + C_MKV, WSP(bf16_t, WS_WUKV) + (size_t)l * NKV * KVR, INP, KVR, KVR, 0};
              pg8::GroupOrder S; S.init(M / 256, NKV / 256, G, G - 1 - bxo, nullptr);
              pg8::EpiKV E{WSP(bf16_t, WS_KN), WSP(bf16_t, WS_VM), WSP(float, WS_ROWSS)};
              pg8::gemm_phase<pg8::EpiKV, true>(lds, g, S, E, wv); }
        } }
        SEAM(pb + 2);
        if (IN(pb + 3)) {
            kptr_t ka = okarg(); const int bxo = osi(bx), vco = osi(vcu); (void)bxo; (void)vco; unsigned char* w = karg_ws(ka);
            att::AttnArgs A{WSP(int, WS_MISC) + 2048, WSP(bf16_t, WS_PROJ), WSP(bf16_t, WS_QM), WSP(bf16_t, WS_KN), WSP(bf16_t, WS_VM), WSP(bf16_t, WS_AO), WSP(float, WS_STASH), (const int*)karg_in(ka, I_POS),
                            WSP(int, WS_MISC) + 64, WSP(int, WS_MISC) + 64 + 256, karg_in(ka, I_RELB), karg_in(ka, I_SUBG) + l * 128,
                            WSP(float, WS_MISC)[l], 0.8f - 0.6f * __expf(-0.3f * (float)l)};
            for (int rp = 0; rp < PREPS(1); ++rp) att::attn_phase<0>(lds, A, ctl + CW_QCTR + 64 * l + 32 * rp, wv);
            if (PROBE_ABL >= 0) { att::AttnArgs A2 = A; A2.ao = WSP(bf16_t, WS_YP); att::attn_phase<(PROBE_ABL >= 0 ? PROBE_ABL : 0)>(lds, A2, ctl + CW_QCTR + 64 * l + 48, wv); }
        }
        SEAM(pb + 3);
        if (IN(pb + 4)) {
            kptr_t ka = okarg(); const int bxo = osi(bx), vco = osi(vcu); (void)bxo; (void)vco; unsigned char* w = karg_ws(ka);
            pg8::Gemm g{WSP(bf16_t, WS_AO), WSP(bf16_t, WS_WO) + (size_t)l * DM * DM, DM, DM, DM, 0};
            pg8::GroupOrder S; S.init(M / 256, DM / 256, G, bxo, nullptr);
            pg8::EpiRes E{l == 0 ? karg_in(ka, I_X) : nullptr, WSP(bf16_t, WS_XB), WSP(bf16_t, WS_XB), WSP(float, WS_MOD) + (size_t)l * 8 * 6144 + 2 * DM};
            pg8::gemm_phase<pg8::EpiRes, false>(lds, g, S, E, wv);
        }
        SEAM(pb + 4);
        if (IN(pb + 5)) {
            kptr_t ka = okarg(); const int bxo = osi(bx), vco = osi(vcu); (void)bxo; (void)vco; unsigned char* w = karg_ws(ka); const float* modl = WSP(float, WS_MOD) + (size_t)l * 8 * 6144; int* RT = WSP(int, WS_ROUTE);
            if (moe) norm_phase<1, F8_UP>(WSP(bf16_t, WS_XB), nullptr, WSP(float, WS_ROUTE) + 8 * M, nullptr, nullptr, nullptr, nullptr, karg_in(ka, I_GFFN) + l * DM, modl, 3, 4, WSP(bf16_t, WS_H), karg_in(ka, I_ROUTER) + (size_t)li * DM * NEXP, (unsigned*)ctl + CW_CNT + 64 * li,
                                   RT, RT + M, RT + 2 * M, RT + 3 * M, (float*)(RT + 4 * M), (float*)(RT + 5 * M), lds, vco, G, wv);
            else norm_phase<0, F8_UP>(WSP(bf16_t, WS_XB), nullptr, WSP(float, WS_ROUTE) + 8 * M, nullptr, nullptr, nullptr, nullptr, karg_in(ka, I_GFFN) + l * DM, modl, 3, 4, WSP(bf16_t, WS_H), nullptr, nullptr, nullptr, nullptr, nullptr, nullptr, nullptr, nullptr, lds, vco, G, wv);
        }
        SEAM(pb + 5);
        if (IN(pb + 6)) { if (moe) { kptr_t ka = okarg(); const int bxo = osi(bx), vco = osi(vcu); (void)bxo; (void)vco; unsigned char* w = karg_ws(ka); int* RT = WSP(int, WS_ROUTE);
            for (int rp = 0; rp < PREPS(8); ++rp) gather_phase(WSP(bf16_t, WS_H), WSP(bf16_t, WS_HPERM), (unsigned*)ctl + CW_CNT + 64 * li, RT, RT + M, RT + 2 * M, RT + 3 * M, (float*)(RT + 4 * M), (float*)(RT + 5 * M), RT + 6 * M, RT + 7 * M,
                         WSP(float, WS_GSLOT), WSP(int, WS_MISC) + 1024, WSP(float, WS_ROUTE) + 8 * M, WSP(float, WS_ASL), vco, G, wv); } }
        if (moe) SEAM(pb + 6);
        if (IN(pb + 7)) {
            kptr_t ka = okarg(); const int bxo = osi(bx), vco = osi(vcu); (void)bxo; (void)vco; unsigned char* w = karg_ws(ka); const int* pexp = moe ? WSP(int, WS_MISC) + 1024 : nullptr;
            constexpr int KU = F8_UP ? DM / 2 : DM;
            pg8::Gemm g{moe ? WSP(bf16_t, WS_HPERM) : WSP(bf16_t, WS_H), (const bf16_t*)((moe ? w + WS_WM13 : w + WS_WD13) + (moe ? (size_t)li * 8 * 2 * DFF * DM : (size_t)li * 2 * DFF * DM) * (F8_UP ? 1 : 2)), KU, KU, KU, (size_t)2 * DFF * KU};
            pg8::GroupOrder S; S.init(moe ? __builtin_amdgcn_readfirstlane(pexp[160]) : M / 256, 2 * DFF / 256, G, bxo, pexp);
            pg8::EpiSwiGLU<F8_UP == 2> E{w + WS_U, 0, moe ? WSP(float, WS_ASL) : WSP(float, WS_ROUTE) + 8 * M, WSP(float, WS_WSC) + (size_t)(moe ? 2 + li * 8 : li) * (2 * DFF)};
            for (int rp = 0; rp < PREPS(2); ++rp) pg8::gemm_phase<pg8::EpiSwiGLU<F8_UP == 2>, true, F8_UP, 127 - F8_H_LOG2, 127 - F8_W_LOG2>(lds, g, S, E, wv);
        }
        SEAM(pb + 7);
        if (IN(pb + 8)) {
            kptr_t ka = okarg(); const int bxo = osi(bx), vco = osi(vcu); (void)bxo; (void)vco; unsigned char* w = karg_ws(ka); const int* pexp = moe ? WSP(int, WS_MISC) + 1024 : nullptr;
            pg8::Gemm g{WSP(bf16_t, WS_U), (const bf16_t*)(moe ? w + WS_WM2 + (size_t)li * 8 * DM * DFF : w + WS_WD2 + (size_t)li * DM * DFF), DFF / 2, DFF / 2, DFF / 2, (size_t)DM * DFF / 2};
            pg8::GroupOrder S; S.init(moe ? __builtin_amdgcn_readfirstlane(pexp[160]) : M / 256, DM / 256, G, bxo, pexp);
            pg8::EpiDown E{WSP(bf16_t, WS_YP), moe ? WSP(float, WS_GSLOT) : nullptr};
            for (int rp = 0; rp < PREPS(3); ++rp) pg8::gemm_phase<pg8::EpiDown, true, true, 127 - F8_U_LOG2, 127 - F8_W_LOG2>(lds, g, S, E, wv);
        }
        SEAM(pb + 8);
    }
    if (IN(NPHASE - 1)) {
        kptr_t ka = okarg(); const int bxo = osi(bx), vco = osi(vcu); (void)bxo; (void)vco; unsigned char* w = karg_ws(ka); int* RT = WSP(int, WS_ROUTE);
        norm_phase<2>(WSP(bf16_t, WS_XB), karg_out(ka), nullptr, WSP(bf16_t, WS_YP), RT + 6 * M, RT + 7 * M, WSP(float, WS_MOD) + (size_t)3 * 8 * 6144 + 5 * DM, karg_in(ka, I_GFINAL), nullptr, 0, 0, nullptr, nullptr, nullptr, nullptr, nullptr, nullptr, nullptr, nullptr, nullptr, lds, vco, G, wv);
    }
#undef WSP
#undef IN
#undef SEAM
}

extern "C" void kernel_launch(void* const* d_in, const int* in_sizes, int n_in, void* d_out, int out_size, void* d_ws, size_t ws_size, hipStream_t stream) {
    static int grid = 0;
    if (grid == 0) {
        if (n_in != 24 || out_size != M * DM || ws_size < WS_END) { fprintf(stderr, "kernel_launch: built for 24 inputs, out %d floats, >= %zu bytes of workspace; got n_in %d out %d ws %zu\n", M * DM, (size_t)WS_END, n_in, out_size, ws_size); grid = -1; return; }
        int dev = 0, cus = 0, per_cu = 0;
        if (hipGetDevice(&dev) != hipSuccess || hipDeviceGetAttribute(&cus, hipDeviceAttributeMultiprocessorCount, dev) != hipSuccess) { grid = -1; return; }
        if (hipFuncSetAttribute((const void*)mk_fwd, hipFuncAttributeMaxDynamicSharedMemorySize, LDS_BYTES) != hipSuccess) { fprintf(stderr, "kernel_launch: hipFuncSetAttribute failed\n"); grid = -1; return; }
        if (hipOccupancyMaxActiveBlocksPerMultiprocessor(&per_cu, (const void*)mk_fwd, 512, LDS_BYTES) != hipSuccess || per_cu < 1) fprintf(stderr, "kernel_launch: occupancy query reports %d\n", per_cu);
        (void)hipGetLastError();
        if (cus < 256) { fprintf(stderr, "kernel_launch: %d CUs; this kernel needs 256 co-resident workgroups (one per CU)\n", cus); grid = -1; return; }
        grid = 256;
    }
    if (grid < 0) return;
    if (hipMemsetAsync((char*)d_ws + WS_CTL, 0, CTL_ZERO_BYTES, stream) != hipSuccess) return;
    Args a{};
    for (int i = 0; i < 24; ++i) a.in[i] = (const float*)d_in[i];
    a.out = (float*)d_out; a.ws = (unsigned char*)d_ws;
#if MK_SPLIT
    for (int p = 0; p < NPHASE; ++p) {
        if (p >= 1 && p < NPHASE - 1) { const int l = (p - 1) / NPH_L, k = (p - 1) % NPH_L; if (k == 6 && !(l & 1)) continue; }
        a.ph_lo = p; a.ph_hi = p + 1;
        hipLaunchKernelGGL(mk_fwd, dim3(grid), dim3(512), LDS_BYTES, stream, a);
    }
#else
    a.ph_lo = 0; a.ph_hi = NPHASE;
    hipLaunchKernelGGL(mk_fwd, dim3(grid), dim3(512), LDS_BYTES, stream, a);
#endif
    const hipError_t le = hipPeekAtLastError();
    if (le != hipSuccess) fprintf(stderr, "kernel_launch: launch failed: %s\n", hipGetErrorName(le));
}
```

```cpp
#include <hip/hip_runtime.h>
#include <cstdio>
#include <cstdint>

#ifndef PROBE_DUP
#define PROBE_DUP 0
#endif
#ifndef PROBE_ABL
#define PROBE_ABL -1
#endif
#define PREPS(bit) (((PROBE_DUP >> (bit)) & 1) ? 2 : 1)
#ifndef F8_UP
#define F8_UP 2
#endif
#ifndef IN_I8
#define IN_I8 1
#endif
#ifndef PROBE_PMASK
#define PROBE_PMASK 0
#endif
#ifndef PROBE_NORM
#define PROBE_NORM 0
#endif
#ifndef MK_SPLIT
#define MK_SPLIT 0
#endif

constexpr int DM = 1024, NB = 8, SEQ = 2048, DEPTH = 4, M = NB * SEQ;
constexpr int INW = 2208, INP = 2304;
constexpr int C_DQ = 0, C_DK = 512, C_DV = 1024, C_MQ = 1536, C_MKV = 1920, C_KR = 2176;
constexpr int QR = 384, KVR = 256, NQ = 768, NKV = 1024;
constexpr int DFF = 2816, NEXP = 8;
constexpr int SLOTS = 34816;
constexpr float EPS = 1e-6f, LOG2E = 1.4426950408889634f;
constexpr float C2D = 0.125f * LOG2E;
constexpr float C2M = 0.10206207261596577f * LOG2E;
constexpr int F8_W_LOG2 = 7, F8_H_LOG2 = 4, F8_U_LOG2 = 2;
constexpr float WSCALE = 128.f, HSCALE = 16.f, USCALE = 4.f;
constexpr int NPH_L = 9, NPHASE = 2 + NPH_L * DEPTH;

constexpr size_t MiB = 1u << 20;
constexpr size_t WS_CTL = 0, CTL_ZERO_BYTES = 1 * MiB;
constexpr size_t WS_MOD = 1 * MiB;
constexpr size_t WS_CS = 2 * MiB;
constexpr size_t WS_ROWSS = 4 * MiB;
constexpr size_t WS_ROUTE = 6 * MiB;
constexpr size_t WS_GSLOT = 7 * MiB;
constexpr size_t WS_MISC = 7 * MiB + 512 * 1024;
constexpr size_t WS_WSC = WS_MISC + 65536;
constexpr size_t WS_WSC2 = WS_GSLOT + 400 * 1024;
constexpr size_t WS_ASL = WS_GSLOT + 256 * 1024;
constexpr size_t WS_WIN = 8 * MiB;
constexpr size_t WS_WUQ = 26 * MiB;
constexpr size_t WS_WUKV = 29 * MiB;
constexpr size_t WS_WO = 31 * MiB;
constexpr size_t WS_WD13 = 39 * MiB;
constexpr size_t WS_WD2 = 61 * MiB;
constexpr size_t WS_WM13 = 72 * MiB;
constexpr size_t WS_WM2 = 248 * MiB;
constexpr size_t WS_H = 336 * MiB;
constexpr size_t WS_ACT = 368 * MiB;
constexpr size_t WS_PROJ = WS_ACT;
constexpr size_t WS_QM = WS_ACT + 72 * MiB;
constexpr size_t WS_KN = WS_ACT + 96 * MiB;
constexpr size_t WS_VM = WS_ACT + 112 * MiB;
constexpr size_t WS_AO = WS_ACT + 128 * MiB;
constexpr size_t WS_STASH = WS_ACT + 160 * MiB;
constexpr size_t WS_U = WS_ACT;
constexpr size_t WS_HPERM = WS_ACT + 188 * MiB;
constexpr size_t WS_YP = WS_ACT + 256 * MiB;
constexpr size_t WS_XB = WS_ACT + 324 * MiB;
constexpr size_t WS_END = WS_XB + 32 * MiB;
constexpr int CW_TMO = 0, CW_CODE = 1;
constexpr int CW_BAR = 4096;
constexpr int CW_QCTR = 8192;
constexpr int CW_CNT = 8704;

constexpr int RING_BYTES = 131072, LDSCTL_OFF = RING_BYTES, MISC_OFF = LDSCTL_OFF + 320, LDS_BYTES = 147456;

#define GAS __attribute__((address_space(1)))
#define LAS __attribute__((address_space(3)))
typedef unsigned short bf16_t;
typedef short bf16x8 __attribute__((ext_vector_type(8)));
typedef short s16x4 __attribute__((ext_vector_type(4)));
typedef float f32x4 __attribute__((ext_vector_type(4)));
typedef float f32x2 __attribute__((ext_vector_type(2)));
typedef float f32x16 __attribute__((ext_vector_type(16)));
typedef unsigned u32x4 __attribute__((ext_vector_type(4)));
typedef unsigned u32x8 __attribute__((ext_vector_type(8)));
typedef unsigned u32x2 __attribute__((ext_vector_type(2)));
typedef GAS unsigned gu32;
#define RLX_AGENT __ATOMIC_RELAXED, __HIP_MEMORY_SCOPE_AGENT
#define LDS_WAIT() asm volatile("s_waitcnt lgkmcnt(0)" ::: "memory")
#define VM_WAIT() asm volatile("s_waitcnt vmcnt(0)" ::: "memory")

__device__ __forceinline__ unsigned cvt_pk_bf16(float lo, float hi) { unsigned r; asm volatile("v_cvt_pk_bf16_f32 %0, %1, %2" : "=v"(r) : "v"(lo), "v"(hi)); return r; }
__device__ __forceinline__ unsigned pk_fp8x4(float a, float b, float c, float d) {
    a = __builtin_amdgcn_fmed3f(a, -448.f, 448.f); b = __builtin_amdgcn_fmed3f(b, -448.f, 448.f); c = __builtin_amdgcn_fmed3f(c, -448.f, 448.f); d = __builtin_amdgcn_fmed3f(d, -448.f, 448.f);
    int w = 0; w = __builtin_amdgcn_cvt_pk_fp8_f32(a, b, w, false); w = __builtin_amdgcn_cvt_pk_fp8_f32(c, d, w, true); return (unsigned)w; }
__device__ __forceinline__ float bf_lo(unsigned w) { return __uint_as_float(w << 16); }
__device__ __forceinline__ float bf_hi(unsigned w) { return __uint_as_float(w & 0xffff0000u); }
template <int K> __device__ __forceinline__ float sx(float v) { return __int_as_float(__builtin_amdgcn_ds_swizzle(__float_as_int(v), (K << 10) | 0x1f)); }
__device__ __forceinline__ float x32_sum(float v) { auto rr = __builtin_amdgcn_permlane32_swap(__float_as_uint(v), __float_as_uint(v), false, false); return __uint_as_float(rr[0]) + __uint_as_float(rr[1]); }
__device__ __forceinline__ float wave_max(float v) { v = fmaxf(v, sx<1>(v)); v = fmaxf(v, sx<2>(v)); v = fmaxf(v, sx<4>(v)); v = fmaxf(v, sx<8>(v)); v = fmaxf(v, sx<16>(v));
    auto rr = __builtin_amdgcn_permlane32_swap(__float_as_uint(v), __float_as_uint(v), false, false); return fmaxf(__uint_as_float(rr[0]), __uint_as_float(rr[1])); }
__device__ __forceinline__ unsigned pk_i8x4(float a, float b, float c, float d) {
    const int ia = (int)__builtin_rintf(a), ib = (int)__builtin_rintf(b), ic = (int)__builtin_rintf(c), id = (int)__builtin_rintf(d);
    return (unsigned)(ia & 0xff) | ((unsigned)(ib & 0xff) << 8) | ((unsigned)(ic & 0xff) << 16) | ((unsigned)id << 24); }
__device__ __forceinline__ float wave_sum(float v) { v += sx<1>(v); v += sx<2>(v); v += sx<4>(v); v += sx<8>(v); v += sx<16>(v); return x32_sum(v); }


__device__ __forceinline__ int otid(int wv) { int l; asm volatile("v_mbcnt_lo_u32_b32 %0, -1, 0\n\tv_mbcnt_hi_u32_b32 %0, -1, %0" : "=v"(l)); return (wv << 6) | l; }
template <class T> __device__ __forceinline__ T* optr(T* p) { asm volatile("" : "+s"(p)); return p; }
__device__ __forceinline__ int osi(int v) { asm volatile("" : "+s"(v)); return v; }
typedef __attribute__((address_space(4))) const unsigned char* kptr_t;
__device__ __forceinline__ kptr_t okarg() { kptr_t p = (kptr_t)__builtin_amdgcn_kernarg_segment_ptr(); asm volatile("" : "+s"(p)); return p; }
typedef const float* cfp_t; typedef float* fp_t; typedef unsigned char* ucp_t;
typedef __attribute__((address_space(4))) const cfp_t* k_cfp; typedef __attribute__((address_space(4))) const fp_t* k_fp; typedef __attribute__((address_space(4))) const ucp_t* k_ucp; typedef __attribute__((address_space(4))) const int* k_int;
__device__ __forceinline__ const float* karg_in(kptr_t k, int i) { return (const float*)(GAS const float*)(*(k_cfp)(k + 8 * i)); }
__device__ __forceinline__ float* karg_out(kptr_t k) { return (float*)(GAS float*)(*(k_fp)(k + 192)); }
__device__ __forceinline__ unsigned char* karg_ws(kptr_t k) { return (unsigned char*)(GAS unsigned char*)(*(k_ucp)(k + 200)); }
__device__ __forceinline__ int karg_lo(kptr_t k) { return *(k_int)(k + 208); }
__device__ __forceinline__ int karg_hi(kptr_t k) { return *(k_int)(k + 212); }
namespace pg8 {
constexpr int BM = 256, BK = 64, HALF = 128, HTB = HALF * BK * 2, STAGE_BYTES = 8 * HTB, NXCD = 8, WGM = 8;
__host__ __device__ __forceinline__ int lds_byte(int r, int c) { const int st = (r >> 4) * 2 + (c >> 5), rr = r & 15, cc = c & 31, ob = rr * 64 + cc * 2; return st * 1024 + (ob ^ (((ob >> 9) & 1) << 5)); }
__host__ __device__ __forceinline__ void stage_rc(int b, int& R, int& C) { const int st = b / 1024, sb = b % 1024, swz = sb ^ (((sb >> 9) & 1) << 5); R = (st >> 1) * 16 + swz / 64; C = (st & 1) * 32 + (swz % 64) / 2; }
__host__ __device__ __forceinline__ int perm32(int rho) { const int n = rho >> 4, i = rho & 15; return 8 * (i >> 2) + 4 * n + (i & 3); }

struct Unit { int pm, pn, e; };
struct Gemm { const bf16_t* A; const bf16_t* Bt; int lda, ldb, K; size_t estride; };

struct GroupOrder {
    int nM, nN, nwg, G, c; const int* pexp;
    __device__ __forceinline__ void init(int nM_, int nN_, int G_, int c_, const int* pexp_) { nM = nM_; nN = nN_; nwg = nM * nN; G = G_; c = c_; pexp = pexp_; }
    __device__ __forceinline__ bool next(int i, Unit& u) const {
        const long L = (long)i * G + c; if (L >= nwg) return false;
        int wgid = (int)L; { const int q = nwg / NXCD, r = nwg % NXCD, xcd = wgid % NXCD, off = wgid / NXCD; wgid = (xcd < r ? xcd * (q + 1) : r * (q + 1) + (xcd - r) * q) + off; }
        const int nig = WGM * nN, gid = wgid / nig, fm = gid * WGM, gsz = (nM - fm) < WGM ? (nM - fm) : WGM;
        u.pm = fm + ((wgid % nig) % gsz); u.pn = (wgid % nig) / gsz;
        u.e = pexp ? __builtin_amdgcn_readfirstlane(pexp[u.pm]) : 0; return true;
    }
};

typedef int v8i32 __attribute__((ext_vector_type(8)));
typedef int i32x4 __attribute__((ext_vector_type(4)));
template <class Epi, bool ALIGN_EPI, int F8 = 0  , int SCA = 127, int SCB = 127>
__device__ __forceinline__ void gemm_phase(LAS unsigned char* lds, const Gemm g, const GroupOrder& S, const Epi& E, int wv) {
    const int tid = otid(wv), wid = wv, lane = tid & 63, wr = wid >> 2, wc = wid & 3, fr = lane & 15, fq = lane >> 4;
    const int nt = g.K / BK;
    unsigned voffA[2], voffB[2];
#pragma unroll
    for (int i = 0; i < 2; ++i) { int R, C; stage_rc(tid * 16 + i * 8192, R, C); const int Rb = Epi::PERM ? ((R & ~31) + perm32(R & 31)) : R;
        voffA[i] = (unsigned)(R * g.lda + C) * 2u; voffB[i] = (unsigned)(Rb * g.ldb + C) * 2u; }
    const size_t kstep = (size_t)(BK * 2);
    const size_t hstepA = (size_t)HALF * g.lda * 2, hstepB = (size_t)HALF * g.ldb * 2;
    const size_t tstepA = 2 * hstepA, tstepB = 2 * hstepB;
    const unsigned ldsw = (unsigned)wid * 1024u;
    const int aoff = lds_byte(wr * 64 + fr, fq * 8), boff = lds_byte(wc * 32 + fr, fq * 8);
#define PG8_SA(b, h) (((b) * 2 + (h)) * HTB)
#define PG8_SB(b, h) ((4 + (b) * 2 + (h)) * HTB)
#define PG8_STAGE(bufoff, gbase, voff) do { _Pragma("unroll") for (int _i = 0; _i < 2; ++_i) { unsigned _vo = (voff)[_i]; asm volatile("" : "+v"(_vo)); \
        __builtin_amdgcn_global_load_lds((const unsigned*)((const char*)(gbase) + _vo), (LAS unsigned*)(lds + (bufoff) + ldsw + _i * 8192), 16, 0, 0); } } while (0)
#define PG8_LD2(p) __builtin_shufflevector(*(const LAS u32x4*)(p), *(const LAS u32x4*)((p) + 1024), 0, 1, 2, 3, 4, 5, 6, 7)
#define PG8_LDA(dst, b, h) do { _Pragma("unroll") for (int m = 0; m < 4; ++m) dst[m] = PG8_LD2(lds + PG8_SA(b, h) + aoff + m * 2048); } while (0)
#define PG8_LDB(dst, b, h) do { _Pragma("unroll") for (int n = 0; n < 2; ++n) dst[n] = PG8_LD2(lds + PG8_SB(b, h) + boff + n * 2048); } while (0)
#define PG8_LO(x) __builtin_bit_cast(bf16x8, __builtin_shufflevector(x, x, 0, 1, 2, 3))
#define PG8_HI(x) __builtin_bit_cast(bf16x8, __builtin_shufflevector(x, x, 4, 5, 6, 7))
#define PG8_MMA(ai, bj, At, Bt) do { __builtin_amdgcn_s_setprio(1); _Pragma("unroll") for (int m = 0; m < 4; ++m) _Pragma("unroll") for (int n = 0; n < 2; ++n) { \
        if constexpr (F8 == 1) acc[ai][bj][m][n] = __builtin_amdgcn_mfma_scale_f32_16x16x128_f8f6f4(__builtin_bit_cast(v8i32, Bt[n]), __builtin_bit_cast(v8i32, At[m]), acc[ai][bj][m][n], 0, 0, 0, SCB, 0, SCA); \
        else if constexpr (F8 == 2) { i32x4 c_ = __builtin_bit_cast(i32x4, acc[ai][bj][m][n]); \
               c_ = __builtin_amdgcn_mfma_i32_16x16x64_i8(__builtin_bit_cast(i32x4, PG8_LO(Bt[n])), __builtin_bit_cast(i32x4, PG8_LO(At[m])), c_, 0, 0, 0); \
               c_ = __builtin_amdgcn_mfma_i32_16x16x64_i8(__builtin_bit_cast(i32x4, PG8_HI(Bt[n])), __builtin_bit_cast(i32x4, PG8_HI(At[m])), c_, 0, 0, 0); acc[ai][bj][m][n] = __builtin_bit_cast(f32x4, c_); } \
        else { acc[ai][bj][m][n] = __builtin_amdgcn_mfma_f32_16x16x32_bf16(PG8_LO(Bt[n]), PG8_LO(At[m]), acc[ai][bj][m][n], 0, 0, 0); \
               acc[ai][bj][m][n] = __builtin_amdgcn_mfma_f32_16x16x32_bf16(PG8_HI(Bt[n]), PG8_HI(At[m]), acc[ai][bj][m][n], 0, 0, 0); } } \
        __builtin_amdgcn_s_setprio(0); } while (0)
#define PG8_WAIT_V(n) asm volatile("s_waitcnt vmcnt(" #n ")" ::: "memory")
#define PG8_WAIT_L(n) asm volatile("s_waitcnt lgkmcnt(" #n ")" ::: "memory")
#define PG8_BAR __builtin_amdgcn_s_barrier()
#define PG8_SCHED __builtin_amdgcn_sched_barrier(0)
    Unit cur, nxt; int ui = 0;
    if (!S.next(0, cur)) return;
    f32x4 acc[2][2][4][2];
#pragma unroll
    for (int a = 0; a < 2; ++a)
#pragma unroll
        for (int b = 0; b < 2; ++b)
#pragma unroll
            for (int m = 0; m < 4; ++m)
#pragma unroll
                for (int n = 0; n < 2; ++n) acc[a][b][m][n] = (f32x4){0.f, 0.f, 0.f, 0.f};
    u32x8 At[4], B0[2], B1[2];
    const char* cA = (const char*)g.A + (size_t)cur.pm * tstepA; const char* cB = (const char*)g.Bt + ((size_t)cur.e * g.estride) * 2 + (size_t)cur.pn * tstepB;
    PG8_STAGE(PG8_SB(0, 0), cB, voffB); PG8_STAGE(PG8_SB(0, 1), cB + hstepB, voffB); PG8_STAGE(PG8_SA(0, 0), cA, voffA); PG8_STAGE(PG8_SA(0, 1), cA + hstepA, voffA);
    if (wr == 1) PG8_BAR;
    PG8_WAIT_V(2); PG8_BAR;
    PG8_STAGE(PG8_SB(1, 0), cB + kstep, voffB); PG8_STAGE(PG8_SA(1, 0), cA + kstep, voffA); PG8_STAGE(PG8_SB(1, 1), cB + hstepB + kstep, voffB);
    PG8_WAIT_V(6); PG8_BAR;
    for (;;) {
        const bool has_next = S.next(ui + 1, nxt);
        const char* nA = has_next ? (const char*)g.A + (size_t)nxt.pm * tstepA : cA;
        const char* nB = has_next ? (const char*)g.Bt + ((size_t)nxt.e * g.estride) * 2 + (size_t)nxt.pn * tstepB : cB;
#pragma clang loop unroll(disable)
        for (int t = 0; t < nt; t += 2) {
            const bool last = (t == nt - 2);
            const char* a1 = cA + (size_t)(t + 1) * kstep;
            const char* a2 = last ? nA : cA + (size_t)(t + 2) * kstep; const char* b2 = last ? nB : cB + (size_t)(t + 2) * kstep;
            const char* a3 = a2 + kstep; const char* b3 = b2 + kstep;
            PG8_LDB(B0, 0, 0); PG8_LDB(B1, 0, 1); PG8_SCHED; PG8_LDA(At, 0, 0); PG8_STAGE(PG8_SA(1, 1), a1 + hstepA, voffA);
            PG8_WAIT_V(8); PG8_WAIT_L(0); PG8_BAR; PG8_MMA(0, 0, At, B0); PG8_MMA(0, 1, At, B1); PG8_BAR; PG8_SCHED;
            PG8_LDA(At, 0, 1); PG8_STAGE(PG8_SB(0, 0), b2, voffB); PG8_STAGE(PG8_SB(0, 1), b2 + hstepB, voffB); PG8_STAGE(PG8_SA(0, 0), a2, voffA);
            PG8_WAIT_V(8); PG8_WAIT_L(0); PG8_BAR; PG8_MMA(1, 0, At, B0); PG8_MMA(1, 1, At, B1); PG8_BAR; PG8_SCHED;
            PG8_LDB(B0, 1, 0); PG8_LDB(B1, 1, 1); PG8_SCHED; PG8_LDA(At, 1, 0); PG8_STAGE(PG8_SA(0, 1), a2 + hstepA, voffA);
            PG8_WAIT_V(8); PG8_WAIT_L(0); PG8_BAR; PG8_MMA(0, 0, At, B0); PG8_MMA(0, 1, At, B1); PG8_BAR; PG8_SCHED;
            PG8_LDA(At, 1, 1); PG8_STAGE(PG8_SB(1, 0), b3, voffB); PG8_STAGE(PG8_SB(1, 1), b3 + hstepB, voffB); PG8_STAGE(PG8_SA(1, 0), a3, voffA);
            PG8_WAIT_V(8); PG8_WAIT_L(0); PG8_BAR; PG8_MMA(1, 0, At, B0); PG8_MMA(1, 1, At, B1); PG8_BAR; PG8_SCHED;
        }
        if constexpr (ALIGN_EPI) { if (wr == 0) PG8_BAR; }
        { const int l2 = otid(wv) & 63; E(acc, cur, wr, wc, l2 & 15, l2 >> 4); }
        if (!has_next) break;
#pragma unroll
        for (int a = 0; a < 2; ++a)
#pragma unroll
            for (int b = 0; b < 2; ++b)
#pragma unroll
                for (int m = 0; m < 4; ++m)
#pragma unroll
                    for (int n = 0; n < 2; ++n) acc[a][b][m][n] = (f32x4){0.f, 0.f, 0.f, 0.f};
        cur = nxt; cA = nA; cB = nB; ++ui;
        if constexpr (ALIGN_EPI) { if (wr == 1) PG8_BAR; }
    }
    PG8_WAIT_V(0);
    if constexpr (!ALIGN_EPI) { if (wr == 0) PG8_BAR; }
    PG8_BAR;
#undef PG8_SA
#undef PG8_SB
#undef PG8_STAGE
#undef PG8_LDA
#undef PG8_LDB
#undef PG8_MMA
#undef PG8_LO
#undef PG8_HI
#undef PG8_LD2
#undef PG8_WAIT_V
#undef PG8_WAIT_L
#undef PG8_BAR
#undef PG8_SCHED
}

__device__ __forceinline__ void st8(bf16_t* p, f32x4 v0, f32x4 v1) {
    u32x4 w; w.x = cvt_pk_bf16(v0[0], v0[1]); w.y = cvt_pk_bf16(v0[2], v0[3]); w.z = cvt_pk_bf16(v1[0], v1[1]); w.w = cvt_pk_bf16(v1[2], v1[3]); *(u32x4*)p = w; }
__device__ __forceinline__ void rope8(f32x4& v0, f32x4& v1, const float* cs8) {
    const f32x4 c0 = *(const f32x4*)cs8, c1 = *(const f32x4*)(cs8 + 4);
    const float a0 = v0[0] * c0[0] - v0[1] * c0[1], a1 = v0[1] * c0[0] + v0[0] * c0[1];
    const float a2 = v0[2] * c0[2] - v0[3] * c0[3], a3 = v0[3] * c0[2] + v0[2] * c0[3];
    const float b0 = v1[0] * c1[0] - v1[1] * c1[1], b1 = v1[1] * c1[0] + v1[0] * c1[1];
    const float b2 = v1[2] * c1[2] - v1[3] * c1[3], b3 = v1[3] * c1[2] + v1[2] * c1[3];
    v0 = (f32x4){a0, a1, a2, a3}; v1 = (f32x4){b0, b1, b2, b3};
}

template <bool I8>
struct EpiProj {
    static constexpr bool PERM = true;
    bf16_t* P; float* rowss; const float* cs; const float* asc; const float* wsc;
    __device__ __forceinline__ void operator()(const f32x4 (&acc)[2][2][4][2], const Unit& u, int wr, int wc, int fr, int fq) const {
        const int row0 = u.pm * BM + wr * 64 + fr;
        float sa[2][4];
        if (I8) {
#pragma unroll
            for (int ai = 0; ai < 2; ++ai)
#pragma unroll
                for (int m = 0; m < 4; ++m) sa[ai][m] = asc[row0 + ai * HALF + m * 16]; }
#pragma unroll
        for (int bj = 0; bj < 2; ++bj) {
            const int cg = u.pn * BM + bj * HALF + wc * 32, col0 = cg + 8 * fq;
            const float sc = (cg < C_DK) ? C2D : 1.f;
            f32x4 sw0, sw1; if (I8) { sw0 = *(const f32x4*)(wsc + col0) * sc; sw1 = *(const f32x4*)(wsc + col0 + 4) * sc; }
            const bool do_ss = (cg >= C_MQ && cg < C_KR), do_rope = (cg == C_KR);
#pragma unroll
            for (int ai = 0; ai < 2; ++ai)
#pragma unroll
                for (int m = 0; m < 4; ++m) {
                    const int row = row0 + ai * HALF + m * 16;
                    f32x4 v0, v1;
                    if (I8) { const i32x4 i0 = __builtin_bit_cast(i32x4, acc[ai][bj][m][0]), i1 = __builtin_bit_cast(i32x4, acc[ai][bj][m][1]);
                        v0 = (f32x4){(float)i0[0], (float)i0[1], (float)i0[2], (float)i0[3]} * sw0 * sa[ai][m]; v1 = (f32x4){(float)i1[0], (float)i1[1], (float)i1[2], (float)i1[3]} * sw1 * sa[ai][m]; }
                    else { v0 = acc[ai][bj][m][0] * sc; v1 = acc[ai][bj][m][1] * sc; }
                    if (do_ss) { float s = (v0[0] * v0[0] + v0[1] * v0[1]) + (v0[2] * v0[2] + v0[3] * v0[3]) + (v1[0] * v1[0] + v1[1] * v1[1]) + (v1[2] * v1[2] + v1[3] * v1[3]);
                        s += sx<16>(s); s = x32_sum(s); if (fq == 0) rowss[(size_t)row * 20 + ((cg - C_MQ) >> 5)] = s; }
                    if (do_rope) rope8(v0, v1, cs + (size_t)row * 32 + 8 * fq);
                    st8(P + (size_t)row * INP + col0, v0, v1);
                }
        }
    }
};
struct EpiQ {
    static constexpr bool PERM = true;
    bf16_t* Q; const float* rowss; const float* cs;
    __device__ __forceinline__ void operator()(const f32x4 (&acc)[2][2][4][2], const Unit& u, int wr, int wc, int fr, int fq) const {
        const int row0 = u.pm * BM + wr * 64 + fr;
#pragma unroll
        for (int ai = 0; ai < 2; ++ai)
#pragma unroll
            for (int m = 0; m < 4; ++m) {
                const int row = row0 + ai * HALF + m * 16;
                const f32x4* rp = (const f32x4*)(rowss + (size_t)row * 20);
                const f32x4 s0 = rp[0], s1 = rp[1], s2 = rp[2];
                const float ss = ((s0[0] + s0[1]) + (s0[2] + s0[3])) + ((s1[0] + s1[1]) + (s1[2] + s1[3])) + ((s2[0] + s2[1]) + (s2[2] + s2[3]));
                const float rs = __builtin_amdgcn_rsqf(ss * (1.f / QR) + EPS) * C2M;
#pragma unroll
                for (int bj = 0; bj < 2; ++bj) {
                    const int cg = u.pn * BM + bj * HALF + wc * 32, col0 = cg + 8 * fq;
                    f32x4 v0 = acc[ai][bj][m][0] * rs, v1 = acc[ai][bj][m][1] * rs;
                    if ((cg % 96) == 64) rope8(v0, v1, cs + (size_t)row * 32 + 8 * fq);
                    st8(Q + (size_t)row * NQ + col0, v0, v1);
                }
            }
    }
};
struct EpiKV {
    static constexpr bool PERM = true;
    bf16_t* Kn; bf16_t* Vm; const float* rowss;
    __device__ __forceinline__ void operator()(const f32x4 (&acc)[2][2][4][2], const Unit& u, int wr, int wc, int fr, int fq) const {
        const int row0 = u.pm * BM + wr * 64 + fr;
        bf16_t* base = (u.pn < 2) ? Kn : Vm; const int colt = (u.pn & 1) * BM;
#pragma unroll
        for (int ai = 0; ai < 2; ++ai)
#pragma unroll
            for (int m = 0; m < 4; ++m) {
                const int row = row0 + ai * HALF + m * 16;
                const f32x4* rp = (const f32x4*)(rowss + (size_t)row * 20 + 12);
                const f32x4 s0 = rp[0], s1 = rp[1];
                const float ss = ((s0[0] + s0[1]) + (s0[2] + s0[3])) + ((s1[0] + s1[1]) + (s1[2] + s1[3]));
                const float rs = __builtin_amdgcn_rsqf(ss * (1.f / KVR) + EPS);
#pragma unroll
                for (int bj = 0; bj < 2; ++bj) {
                    const int col0 = colt + bj * HALF + wc * 32 + 8 * fq;
                    st8(base + (size_t)row * 512 + col0, acc[ai][bj][m][0] * rs, acc[ai][bj][m][1] * rs);
                }
            }
    }
};
struct EpiRes {
    static constexpr bool PERM = true;
    const float* base32; const bf16_t* base16; bf16_t* out; const float* gate;
    __device__ __forceinline__ void operator()(const f32x4 (&acc)[2][2][4][2], const Unit& u, int wr, int wc, int fr, int fq) const {
        const int row0 = u.pm * BM + wr * 64 + fr; const float* gp = gate + (size_t)(u.pm >> 3) * 6144;
#pragma unroll
        for (int bj = 0; bj < 2; ++bj) {
            const int col = u.pn * BM + bj * HALF + wc * 32 + 8 * fq;
            const f32x4 g0 = *(const f32x4*)(gp + col) + 1.0f, g1 = *(const f32x4*)(gp + col + 4) + 1.0f;
#pragma unroll
            for (int ai = 0; ai < 2; ++ai)
#pragma unroll
                for (int m = 0; m < 4; ++m) { const size_t off = (size_t)(row0 + ai * HALF + m * 16) * DM + col;
                    f32x4 b0, b1;
                    if (base32) { b0 = *(const f32x4*)(base32 + off); b1 = *(const f32x4*)(base32 + off + 4); }
                    else { const u32x4 w = *(const u32x4*)(base16 + off); b0 = (f32x4){bf_lo(w.x), bf_hi(w.x), bf_lo(w.y), bf_hi(w.y)}; b1 = (f32x4){bf_lo(w.z), bf_hi(w.z), bf_lo(w.w), bf_hi(w.w)}; }
                    st8(out + off, b0 + g0 * acc[ai][bj][m][0], b1 + g1 * acc[ai][bj][m][1]); }
        }
    }
};
template <bool I8>
struct EpiSwiGLU {
    static constexpr bool PERM = true;
    unsigned char* U;
    int dummy;
    const float* asc; const float* wsc;
    __device__ __forceinline__ void operator()(const f32x4 (&acc)[2][2][4][2], const Unit& u, int wr, int wc, int fr, int fq) const {
        if (dummy) return;
        const int row0 = u.pm * BM + wr * 64 + fr, col0 = u.pn * HALF + wc * 32 + 8 * fq;
        f32x4 sw[2][2];
        if (I8) { const float* wp = wsc + (size_t)u.e * (2 * DFF) + u.pn * BM + wc * 32 + 8 * fq;
#pragma unroll
            for (int bj = 0; bj < 2; ++bj) { sw[bj][0] = *(const f32x4*)(wp + bj * HALF); sw[bj][1] = *(const f32x4*)(wp + bj * HALF + 4); } }
#pragma unroll
        for (int ai = 0; ai < 2; ++ai)
#pragma unroll
            for (int m = 0; m < 4; ++m) {
                const int row = row0 + ai * HALF + m * 16;
                float sa = 1.f; if (I8) sa = asc[row];
                f32x4 r[2];
#pragma unroll
                for (int n = 0; n < 2; ++n) { f32x4 a = acc[ai][0][m][n], b = acc[ai][1][m][n];
                    if (I8) { const i32x4 ia = __builtin_bit_cast(i32x4, a), ib = __builtin_bit_cast(i32x4, b);
                        a = (f32x4){(float)ia[0], (float)ia[1], (float)ia[2], (float)ia[3]} * sw[0][n] * sa; b = (f32x4){(float)ib[0], (float)ib[1], (float)ib[2], (float)ib[3]} * sw[1][n] * sa; }
#pragma unroll
                    for (int k = 0; k < 4; ++k) { const float e = __builtin_amdgcn_exp2f(-a[k] * LOG2E); r[n][k] = a[k] * __builtin_amdgcn_rcpf(1.f + e) * b[k] * USCALE; } }
                u32x2 w; w.x = pk_fp8x4(r[0][0], r[0][1], r[0][2], r[0][3]); w.y = pk_fp8x4(r[1][0], r[1][1], r[1][2], r[1][3]);
                *(u32x2*)(U + (size_t)row * DFF + col0) = w;
            }
    }
};
struct EpiDown {
    static constexpr bool PERM = true;
    bf16_t* Y; const float* gslot;
    __device__ __forceinline__ void operator()(const f32x4 (&acc)[2][2][4][2], const Unit& u, int wr, int wc, int fr, int fq) const {
        const int row0 = u.pm * BM + wr * 64 + fr;
#pragma unroll
        for (int ai = 0; ai < 2; ++ai)
#pragma unroll
            for (int m = 0; m < 4; ++m) {
                const int row = row0 + ai * HALF + m * 16; const float gv = gslot ? gslot[row] : 1.f;
#pragma unroll
                for (int bj = 0; bj < 2; ++bj) st8(Y + (size_t)row * DM + u.pn * BM + bj * HALF + wc * 32 + 8 * fq, acc[ai][bj][m][0] * gv, acc[ai][bj][m][1] * gv);
            }
    }
};
}

namespace att {
constexpr int NSLOT = 4, KBMAX = 12288, VBMAX = 16384;
constexpr int OFF_V = NSLOT * KBMAX, OFF_WS = OFF_V + NSLOT * VBMAX, OFF_LUT = OFF_WS + 8 * 256, OFF_Q = OFF_LUT + 512;
static_assert(OFF_Q + 16 <= RING_BYTES, "attention LDS map");
__device__ __forceinline__ void glds16(const void* gsrc, unsigned lds_dst) { unsigned keep;
    asm volatile("s_mov_b32 %0, m0\n\ts_mov_b32 m0, %2\n\ts_nop 0\n\tglobal_load_lds_dwordx4 %1, off\n\ts_mov_b32 m0, %0" : "=&s"(keep) : "v"(gsrc), "s"(lds_dst) : "memory"); }
constexpr float THR = 8.f;
#define SBAR() __builtin_amdgcn_sched_barrier(0)
__device__ __forceinline__ int crow(int r, int hi) { return (r & 3) + 8 * (r >> 2) + 4 * hi; }
template <int DV> __device__ __forceinline__ int v_st(int k, int c) { const int kk = (k & ~0xC) | ((k & 4) << 1) | ((k & 8) >> 1); return ((kk >> 3) * (DV / 32) + (c >> 5)) * 512 + ((kk & 7) * 32 + (c & 31)) * 2; }
__device__ __forceinline__ int v_rd_base(int lane) { return ((lane & 3) << 3) | (((lane >> 2) & 3) << 6) | (((lane >> 4) & 1) << 5) | (((lane >> 5) & 1) << 8); }
template <int DV> constexpr int v_rd_off(int d0, int ks, int half) { return ((2 * ks + half) * (DV / 32) + d0) * 512; }
template <int OFF> __device__ __forceinline__ s16x4 tr_read(int vb) { s16x4 r; asm volatile("ds_read_b64_tr_b16 %0, %1 offset:%2" : "=&v"(r) : "v"(vb), "i"(OFF) : "memory"); return r; }
template <int DV, int D0> __device__ __forceinline__ void pv_one(f32x16& od, int vb, bf16x8 pa0, bf16x8 pa1, bf16x8 pa2, bf16x8 pa3) {
    const s16x4 l0 = tr_read<v_rd_off<DV>(D0, 0, 0)>(vb), h0 = tr_read<v_rd_off<DV>(D0, 0, 1)>(vb), l1 = tr_read<v_rd_off<DV>(D0, 1, 0)>(vb), h1 = tr_read<v_rd_off<DV>(D0, 1, 1)>(vb);
    const s16x4 l2 = tr_read<v_rd_off<DV>(D0, 2, 0)>(vb), h2 = tr_read<v_rd_off<DV>(D0, 2, 1)>(vb), l3 = tr_read<v_rd_off<DV>(D0, 3, 0)>(vb), h3 = tr_read<v_rd_off<DV>(D0, 3, 1)>(vb);
    asm volatile("s_waitcnt lgkmcnt(0)" ::: "memory"); SBAR();
#define PK(L, H) (bf16x8){L[0], L[1], L[2], L[3], H[0], H[1], H[2], H[3]}
    od = __builtin_amdgcn_mfma_f32_32x32x16_bf16(pa0, PK(l0, h0), od, 0, 0, 0);
    od = __builtin_amdgcn_mfma_f32_32x32x16_bf16(pa1, PK(l1, h1), od, 0, 0, 0);
    od = __builtin_amdgcn_mfma_f32_32x32x16_bf16(pa2, PK(l2, h2), od, 0, 0, 0);
    od = __builtin_amdgcn_mfma_f32_32x32x16_bf16(pa3, PK(l3, h3), od, 0, 0, 0);
#undef PK
}
template <int DV, int KS_, int D0> __device__ __forceinline__ void pv_rd(s16x4 (&lo)[DV / 32], s16x4 (&hi)[DV / 32], int vb) {
    lo[D0] = tr_read<v_rd_off<DV>(D0, KS_, 0)>(vb); hi[D0] = tr_read<v_rd_off<DV>(D0, KS_, 1)>(vb);
    if constexpr (D0 + 1 < DV / 32) pv_rd<DV, KS_, D0 + 1>(lo, hi, vb);
}
template <int DV> __device__ __forceinline__ void pv_all(f32x16 (&o)[DV / 32], f32x16& lacc, int vb, bf16x8 pa0, bf16x8 pa1, bf16x8 pa2, bf16x8 pa3) {
    constexpr int NO = DV / 32;
    const bf16x8 ones = {0x3F80, 0x3F80, 0x3F80, 0x3F80, 0x3F80, 0x3F80, 0x3F80, 0x3F80};
    s16x4 la[NO], ha[NO], lb[NO], hb[NO];
#define PK(L, H) (bf16x8){L[0], L[1], L[2], L[3], H[0], H[1], H[2], H[3]}
#define PVW(n) do { if (n == 8) asm volatile("s_waitcnt lgkmcnt(8)" ::: "memory"); else if (n == 4) asm volatile("s_waitcnt lgkmcnt(4)" ::: "memory"); else asm volatile("s_waitcnt lgkmcnt(0)" ::: "memory"); SBAR(); } while (0)
    pv_rd<DV, 0, 0>(la, ha, vb); pv_rd<DV, 1, 0>(lb, hb, vb); PVW(2 * NO);
#pragma unroll
    for (int d = 0; d < NO; ++d) o[d] = __builtin_amdgcn_mfma_f32_32x32x16_bf16(pa0, PK(la[d], ha[d]), o[d], 0, 0, 0);
    lacc = __builtin_amdgcn_mfma_f32_32x32x16_bf16(pa0, ones, lacc, 0, 0, 0);
    SBAR(); pv_rd<DV, 2, 0>(la, ha, vb); PVW(2 * NO);
#pragma unroll
    for (int d = 0; d < NO; ++d) o[d] = __builtin_amdgcn_mfma_f32_32x32x16_bf16(pa1, PK(lb[d], hb[d]), o[d], 0, 0, 0);
    lacc = __builtin_amdgcn_mfma_f32_32x32x16_bf16(pa1, ones, lacc, 0, 0, 0);
    SBAR(); pv_rd<DV, 3, 0>(lb, hb, vb); PVW(2 * NO);
#pragma unroll
    for (int d = 0; d < NO; ++d) o[d] = __builtin_amdgcn_mfma_f32_32x32x16_bf16(pa2, PK(la[d], ha[d]), o[d], 0, 0, 0);
    lacc = __builtin_amdgcn_mfma_f32_32x32x16_bf16(pa2, ones, lacc, 0, 0, 0);
    PVW(0);
#pragma unroll
    for (int d = 0; d < NO; ++d) o[d] = __builtin_amdgcn_mfma_f32_32x32x16_bf16(pa3, PK(lb[d], hb[d]), o[d], 0, 0, 0);
    lacc = __builtin_amdgcn_mfma_f32_32x32x16_bf16(pa3, ones, lacc, 0, 0, 0);
#undef PK
#undef PVW
}
__device__ __forceinline__ int rel_bucket(int n) {
    if (n < 16) return n;
    const int v = 16 + (int)(logf((float)n * (1.f / 16.f)) * (16.f / 2.0794415416798357f));
    return v < 31 ? v : 31;
}

template <int DQK, int DV, bool BIAS, int ABL = 0>
__device__ __forceinline__ void attn_core(const bf16_t* __restrict__ Qp, const bf16_t* __restrict__ K1, int ldk1, const bf16_t* __restrict__ K2, int ldk2,
                                          const bf16_t* __restrict__ Vp, int ldv, const int* __restrict__ posb, int posq, int qfirst, int qidx, int NT,
                                          const int* __restrict__ kmaxb, int qmin_w, float bias_far, LAS unsigned char* lds, int tid, int wid, int lane,
                                          f32x16 (&o)[DV / 32], f32x16& lacc) {
    constexpr int KB = 8 * DQK * 16, VB = 64 * DV * 2, ND = DQK / 16, NO = DV / 32, NVP = DV / 64;
    const int r32 = lane & 31, hi = lane >> 5, grp = wid >> 2;
    LAS unsigned char* Kl = lds; LAS unsigned char* Vl = lds + OFF_V;
    LAS float* wsc = (LAS float*)(lds + OFF_WS) + wid * 64; const LAS float* lut = (const LAS float*)(lds + OFF_LUT);
    bf16x8 qr[ND];
#pragma unroll
    for (int d0 = 0; d0 < ND; ++d0) qr[d0] = *(const bf16x8*)(Qp + d0 * 16 + hi * 8);
    float m_reg = 0.f; lacc = f32x16{};
    const u32x4 kxu = {hi == 0 ? 0xBF80BF80u : 0u, 0u, 0u, 0u}; const bf16x8 kx = __builtin_bit_cast(bf16x8, kxu);
#pragma unroll
    for (int d = 0; d < NO; ++d) o[d] = f32x16{};
    const bf16_t* ksrc = K1 + (size_t)lane * ldk1 + wid * 8;
    const bf16_t* ksrc2 = (DQK == 96) ? K2 + (size_t)lane * ldk2 + (wid & 3) * 8 : nullptr;
    const bf16_t* vsrc[NVP]; unsigned vdst[NVP];
#pragma unroll
    for (int q = 0; q < NVP; ++q) { const int p = wid * NVP + q, s = 2 * p + (lane >> 5), kk = 8 * (s / (DV / 32)) + ((lane & 31) >> 2), c = 32 * (s % (DV / 32)) + 8 * (lane & 3);
        const int k = (kk & ~0xC) | ((kk & 4) << 1) | ((kk & 8) >> 1);
        vsrc[q] = Vp + (size_t)k * ldv + c; vdst[q] = (unsigned)(uintptr_t)Vl + p * 1024; }
    const unsigned kdst = (unsigned)(uintptr_t)Kl + wid * 1024, kdst2 = (unsigned)(uintptr_t)Kl + (8 + (wid & 3)) * 1024;
    const int vb0 = (int)(unsigned)(uintptr_t)Vl + v_rd_base(lane);
#define RFL(x) ((unsigned)__builtin_amdgcn_readfirstlane((int)(x)))
#define DMA_K(t) do { if (ABL & 8) break; const int t_ = (t) < NT ? (t) : NT - 1; glds16(ksrc + (size_t)t_ * 64 * ldk1, RFL(kdst + ((t) & 3) * KB)); \
        if (DQK == 96) { if (grp == 0) glds16(ksrc2 + (size_t)t_ * 64 * ldk2, RFL(kdst2 + ((t) & 3) * KB)); } } while (0)
#define DMA_V(t) do { if (ABL & 8) break; const int t_ = (t) < NT ? (t) : NT - 1; _Pragma("unroll") for (int q = 0; q < NVP; ++q) glds16(vsrc[q] + (size_t)t_ * 64 * ldv, RFL(vdst[q] + ((t) & 3) * VB)); } while (0)
#define WAITBAR_G0() do { if (DQK == 96) asm volatile("s_waitcnt vmcnt(6) lgkmcnt(0)\n\ts_barrier" ::: "memory"); else if (NVP == 2) asm volatile("s_waitcnt vmcnt(6) lgkmcnt(0)\n\ts_barrier" ::: "memory"); \
        else asm volatile("s_waitcnt vmcnt(4) lgkmcnt(0)\n\ts_barrier" ::: "memory"); } while (0)
#define WAITBAR_G1() do { if (DQK == 96) asm volatile("s_waitcnt vmcnt(2) lgkmcnt(0)\n\ts_barrier" ::: "memory"); else if (NVP == 2) asm volatile("s_waitcnt vmcnt(3) lgkmcnt(0)\n\ts_barrier" ::: "memory"); \
        else asm volatile("s_waitcnt vmcnt(2) lgkmcnt(0)\n\ts_barrier" ::: "memory"); } while (0)
#define PBAR() asm volatile("s_waitcnt lgkmcnt(0)\n\ts_barrier" ::: "memory")
#define QKT(t) do { if (ABL & 4) { _Pragma("unroll") for (int r = 0; r < 16; ++r) { p0[r] = 0.f; p1[r] = 0.f; } break; } const LAS unsigned char* Kc = Kl + ((t) & 3) * KB + hi * 1024 + r32 * 16; \
        bool far_ = false; if (BIAS) far_ = (qmin_w - kmaxb[t]) >= 113; isfar = far_; \
          \
        { const float me = m_reg - ((BIAS && far_) ? bias_far : 0.f); const unsigned bh = cvt_pk_bf16(me, 0.f) & 0xffffu; const unsigned bl = cvt_pk_bf16(me - __uint_as_float(bh << 16), 0.f) & 0xffffu; \
          const u32x4 qx = {hi == 0 ? (bh | (bl << 16)) : 0u, 0u, 0u, 0u}; \
          p0 = __builtin_amdgcn_mfma_f32_32x32x16_bf16(kx, __builtin_bit_cast(bf16x8, qx), f32x16{}, 0, 0, 0); p1 = __builtin_amdgcn_mfma_f32_32x32x16_bf16(kx, __builtin_bit_cast(bf16x8, qx), f32x16{}, 0, 0, 0); } \
        _Pragma("unroll") for (int d0 = 0; d0 < ND; ++d0) { \
            const bf16x8 b0 = *(const LAS bf16x8*)(Kc + d0 * 2048), b1 = *(const LAS bf16x8*)(Kc + d0 * 2048 + 512); \
            p0 = __builtin_amdgcn_mfma_f32_32x32x16_bf16(b0, qr[d0], p0, 0, 0, 0); p1 = __builtin_amdgcn_mfma_f32_32x32x16_bf16(b1, qr[d0], p1, 0, 0, 0); } } while (0)
    f32x16 p0, p1; bool isfar = false; bf16x8 pa0, pa1, pa2, pa3;
    DMA_K(0); DMA_V(0); DMA_K(1); DMA_V(1); DMA_K(2);
    asm volatile("s_waitcnt vmcnt(0) lgkmcnt(0)\n\ts_barrier" ::: "memory");
    if (grp) PBAR();
    if (0 <= qfirst + 31) QKT(0);
    if (grp) WAITBAR_G1(); else PBAR();
    for (int i = 0; i < ((ABL & 16) ? 0 : NT); ++i) {
        const int kv0 = i * 64; const bool act = kv0 <= qfirst + 31;
        DMA_K(i + 3); DMA_V(i + 2);
        if (act && (ABL & 1)) { pa0 = __builtin_bit_cast(bf16x8, (f32x4){p0[0], p0[1], p0[2], p0[3]}); pa1 = __builtin_bit_cast(bf16x8, (f32x4){p0[4], p0[5], p0[6], p0[7]}); pa2 = __builtin_bit_cast(bf16x8, (f32x4){p1[0], p1[1], p1[2], p1[3]}); pa3 = __builtin_bit_cast(bf16x8, (f32x4){p1[4], p1[5], p1[6], p1[7]});
#pragma unroll
            for (int r = 0; r < 16; ++r) lacc[r] = 1.f; }
        if (act && !(ABL & 1)) {
            if (BIAS) { if (!isfar) {
                GAS const int* pb = (GAS const int*)(posb + kv0 + 4 * hi); asm volatile("" : "+v"(pb));
#pragma unroll
                for (int r = 0; r < 16; ++r) {
                    const int cr = (r & 3) + 8 * (r >> 2);
                    int d0_ = posq - pb[cr]; d0_ = d0_ < 0 ? 0 : (d0_ > 127 ? 127 : d0_);
                    int d1_ = posq - pb[cr + 32]; d1_ = d1_ < 0 ? 0 : (d1_ > 127 ? 127 : d1_);
                    p0[r] += lut[d0_]; p1[r] += lut[d1_]; } } }
            if (kv0 + 63 > qfirst) {
                int lim = qidx - kv0 - 4 * hi; asm volatile("" : "+v"(lim));
#pragma unroll
                for (int r = 0; r < 16; ++r) { const int cr = (r & 3) + 8 * (r >> 2); if (cr > lim) p0[r] = -INFINITY; if (cr + 32 > lim) p1[r] = -INFINITY; }
            }
            float pmax = p0[0];
#pragma unroll
            for (int r = 1; r < 16; ++r) pmax = fmaxf(pmax, p0[r]);
#pragma unroll
            for (int r = 0; r < 16; ++r) pmax = fmaxf(pmax, p1[r]);
            { auto rr = __builtin_amdgcn_permlane32_swap(__float_as_uint(pmax), __float_as_uint(pmax), false, false); pmax = fmaxf(__uint_as_float(rr[0]), __uint_as_float(rr[1])); }
            float alpha = 1.f;
            if (i == 0 || !__all(pmax <= THR)) { const float dl = (i == 0) ? pmax : fmaxf(pmax, 0.f); m_reg += dl; alpha = (i == 0) ? 1.f : __builtin_amdgcn_exp2f(-dl);
#pragma unroll
                for (int r = 0; r < 16; ++r) { p0[r] -= dl; p1[r] -= dl; } }
#pragma unroll
            for (int r = 0; r < 16; ++r) { p0[r] = __builtin_amdgcn_exp2f(p0[r]); p1[r] = __builtin_amdgcn_exp2f(p1[r]); }
            if (__any(alpha < 1.f)) { if (hi == 0) wsc[r32] = alpha; asm volatile("s_waitcnt lgkmcnt(0)" ::: "memory");
                const LAS float* wb = wsc + 4 * hi; asm volatile("" : "+v"(wb));
#pragma unroll
                for (int r = 0; r < 16; ++r) { const float a = wb[(r & 3) + 8 * (r >> 2)]; lacc[r] *= a;
#pragma unroll
                    for (int d = 0; d < NO; ++d) o[d][r] *= a; }
                asm volatile("s_waitcnt lgkmcnt(0)" ::: "memory"); }
#define PK4(P, BASE, OUT) do { unsigned a0 = cvt_pk_bf16(P[BASE + 0], P[BASE + 1]), a1 = cvt_pk_bf16(P[BASE + 2], P[BASE + 3]);   \
    unsigned b0 = cvt_pk_bf16(P[BASE + 4], P[BASE + 5]), b1 = cvt_pk_bf16(P[BASE + 6], P[BASE + 7]);                              \
    auto r0 = __builtin_amdgcn_permlane32_swap(a0, b0, false, false); auto r1 = __builtin_amdgcn_permlane32_swap(a1, b1, false, false); \
    u32x4 w = {r0[0], r1[0], r0[1], r1[1]}; OUT = __builtin_bit_cast(bf16x8, w); } while (0)
            PK4(p0, 0, pa0); PK4(p0, 8, pa1); PK4(p1, 0, pa2); PK4(p1, 8, pa3);
#undef PK4
        }
        if (grp) PBAR(); else WAITBAR_G0();
        if (act) {
            const int vb = vb0 + (i & 3) * VB;
            if (!(ABL & 2)) pv_all<DV>(o, lacc, vb, pa0, pa1, pa2, pa3);
        }
        if (i + 1 < NT && kv0 + 64 <= qfirst + 31) QKT(i + 1);
        if (grp) WAITBAR_G1(); else PBAR();
    }
    asm volatile("s_waitcnt vmcnt(0)" ::: "memory");
    if (!grp) PBAR();
    PBAR();
#undef RFL
#undef DMA_K
#undef DMA_V
#undef WAITBAR_G0
#undef WAITBAR_G1
#undef PBAR
#undef QKT
}

__device__ __forceinline__ bool decode_unit(int idx, int& type, int& qb, int& bh) {
    constexpr int NCLS = 16;
    constexpr int ctype[NCLS] = {0, 0, 0, 0, 0, 1, 0, 1, 1, 1, 0, 1, 1, 0, 1, 1};
    constexpr int cqb[NCLS]   = {7, 6, 5, 4, 3, 7, 2, 6, 5, 4, 1, 3, 2, 0, 1, 0};
    int start = 0; bool found = false;
#pragma unroll
    for (int c = 0; c < NCLS; ++c) { const int n = ctype[c] ? 64 : 32; if (!found && idx < start + n) { type = ctype[c]; qb = cqb[c]; bh = idx - start; found = true; } start += n; }
    return found;
}
constexpr int NUNITS = 768;

struct AttnArgs { const int* bkt; const bf16_t* proj; const bf16_t* qm; const bf16_t* kn; const bf16_t* vm; bf16_t* ao; float* stash; const int* pos; const int* kmax; const int* qmin;
                  const float* rel_bias; const float* subln_g; float lam, lam_init; };

template <int ABL = 0>
__device__ __forceinline__ void attn_phase(LAS unsigned char* lds, const AttnArgs& A, gu32* qctr, int wv) {
    const int wid = wv;
    LAS float* wsc = (LAS float*)(lds + OFF_WS) + wid * 64; LAS float* lut = (LAS float*)(lds + OFF_LUT); volatile LAS int* qw = (volatile LAS int*)(lds + OFF_Q);
    if (wid >= 4) __builtin_amdgcn_s_setprio(1);
    for (;;) {
        const int tid = otid(wv), lane = tid & 63, r32 = lane & 31, hi = lane >> 5;
        if (tid == 0) qw[0] = (int)__hip_atomic_fetch_add(qctr, 1u, RLX_AGENT);
        __syncthreads();
        const int idx = qw[0];
        __syncthreads();
        if (idx >= NUNITS) break;
        int type = 0, qb = 0, bh = 0; decode_unit(idx, type, qb, bh);
        const int q0 = qb * 256, NT = (q0 + 256) / 64, qfirst = q0 + wid * 32, qidx = qfirst + r32;
        if (type == 0) {
            const int b = bh >> 2, h = bh & 3; const size_t rowbase = (size_t)b * SEQ;
            const int* posb = A.pos + b * SEQ; const int posq = posb[qidx]; const int qmin_w = A.qmin[b * 64 + (qfirst >> 5)];
            if (tid < 128) { const float bv = A.rel_bias[A.bkt[tid] * 4 + h] * LOG2E; lut[otid(wv)] = bv; }
            const float bias_far = A.rel_bias[31 * 4 + h] * LOG2E;
            __syncthreads();
            float* st = A.stash + (size_t)blockIdx.x * 32768;
            for (int mp = 0; mp < 2; ++mp) {
                f32x16 o[4]; f32x16 l;
                attn_core<64, 128, true, ABL>(A.proj + (rowbase + qidx) * INP + C_DQ + h * 128 + mp * 64, A.proj + rowbase * INP + C_DK + h * 128 + mp * 64, INP, nullptr, 0,
                                         A.proj + rowbase * INP + C_DV + h * 128, INP, posb, posq, qfirst, qidx, NT, A.kmax + b * 32, qmin_w, bias_far, lds, tid, wid, lane, o, l);
                float rli[16];
#pragma unroll
                for (int r = 0; r < 16; ++r) rli[r] = __builtin_amdgcn_rcpf(l[r]);
                GAS float* stp = (GAS float*)(st + tid); asm volatile("" : "+v"(stp));
                if (mp == 0) {
#pragma unroll
                    for (int d = 0; d < 4; ++d)
#pragma unroll
                        for (int r = 0; r < 16; ++r) stp[(d * 16 + r) * 512] = o[d][r] * rli[r];
                } else {
                    const float lam = A.lam, post = 1.f - A.lam_init;
                    float gv[4];
#pragma unroll
                    for (int d = 0; d < 4; ++d) gv[d] = A.subln_g[d * 32 + r32] * post;
                    GAS bf16_t* aop = (GAS bf16_t*)(A.ao + (rowbase + qfirst + 4 * hi) * DM + h * 128 + r32); asm volatile("" : "+v"(aop));
#pragma unroll
                    for (int r = 0; r < 16; ++r) {
                        float v[4], ss = 0.f;
#pragma unroll
                        for (int d = 0; d < 4; ++d) { v[d] = stp[(d * 16 + r) * 512] - lam * (o[d][r] * rli[r]); ss += v[d] * v[d]; }
                        ss += sx<1>(ss); ss += sx<2>(ss); ss += sx<4>(ss); ss += sx<8>(ss); ss += sx<16>(ss);
                        const float rn = __builtin_amdgcn_rsqf(ss * (1.f / 128.f) + EPS);
                        GAS bf16_t* op = aop + (size_t)((r & 3) + 8 * (r >> 2)) * DM;
#pragma unroll
                        for (int d = 0; d < 4; ++d) op[d * 32] = (bf16_t)(cvt_pk_bf16(v[d] * rn * gv[d], 0.f) & 0xffffu);
                    }
                }
            }
        } else {
            const int b = bh >> 3, h = bh & 7; const size_t rowbase = (size_t)b * SEQ;
            f32x16 o[2]; f32x16 l;
            attn_core<96, 64, false, ABL>(A.qm + (rowbase + qidx) * NQ + h * 96, A.kn + rowbase * 512 + h * 64, 512, A.proj + rowbase * INP + C_KR, INP,
                                     A.vm + rowbase * 512 + h * 64, 512, nullptr, 0, qfirst, qidx, NT, nullptr, 0, 0.f, lds, tid, wid, lane, o, l);
            GAS bf16_t* aop = (GAS bf16_t*)(A.ao + (rowbase + qfirst + 4 * hi) * DM + 512 + h * 64 + r32); asm volatile("" : "+v"(aop));
#pragma unroll
            for (int r = 0; r < 16; ++r) { const float rl = __builtin_amdgcn_rcpf(l[r]);
                GAS bf16_t* op = aop + (size_t)((r & 3) + 8 * (r >> 2)) * DM;
#pragma unroll
                for (int d = 0; d < 2; ++d) op[d * 32] = (bf16_t)(cvt_pk_bf16(o[d][r] * rl, 0.f) & 0xffffu); }
            asm volatile("s_waitcnt lgkmcnt(0)" ::: "memory");
        }
    }
    __builtin_amdgcn_s_setprio(0);
}
#undef SBAR
}

#define XB_TMO      128
#define XB_XCNT(j)  (256  + 64 * (j))
#define XB_XSUB(j)  (1280 + 64 * (j))
#define XB_XGEN(j)  (2304 + 64 * (j))
#define XB_TOP      3328
#define XB_TOPGEN   3392
#define XCD_BAR_WORDS 3456
#define XB_SPIN_CAP (1u << 18)
__device__ __forceinline__ unsigned xb_ld(unsigned* p)              { return __hip_atomic_load(p, __ATOMIC_RELAXED, __HIP_MEMORY_SCOPE_AGENT); }
__device__ __forceinline__ unsigned xb_add(unsigned* p, unsigned v) { return __hip_atomic_fetch_add(p, v, __ATOMIC_RELAXED, __HIP_MEMORY_SCOPE_AGENT); }
__device__ __forceinline__ unsigned xb_xcc_id() { return (unsigned)__builtin_amdgcn_s_getreg((3 << 11) | 20) & 0xFu; }
#define XB_SPIN(cond, bar) do { unsigned _sp = 0; while (cond) { __builtin_amdgcn_s_sleep(1); \
    if ((++_sp & 255u) == 0u) { if (xb_ld(&(bar)[XB_TMO])) break; if (_sp > XB_SPIN_CAP) { atomicAdd(&(bar)[XB_TMO], 1u); break; } } } } while (0)
struct XcdBarrier { unsigned* bar; unsigned x; volatile LAS unsigned* st; };
__device__ __forceinline__ XcdBarrier xcd_barrier_post(unsigned* bar, volatile LAS unsigned* st) {
    XcdBarrier b; b.bar = bar; b.x = xb_xcc_id(); b.st = st;
    if (threadIdx.x == 0) (void)xb_add(&bar[XB_XCNT(b.x)], 1u);
    return b;
}
__device__ __forceinline__ void xcd_barrier_complete(unsigned* bar, unsigned x, unsigned& nloc, unsigned& nx) {
    const unsigned G = gridDim.x * gridDim.y * gridDim.z;
    unsigned sum, cnt, mine, sp = 0u;
    for (;;) {
        sum = 0u; cnt = 0u; mine = 0u;
#pragma unroll
        for (unsigned j = 0; j < 16; ++j) { const unsigned c = xb_ld(&bar[XB_XCNT(j)]); sum += c; cnt += (c > 0u) ? 1u : 0u; mine = (j == x) ? c : mine; }
        if (sum == G) break;
        __builtin_amdgcn_s_sleep(1);
        if ((++sp & 255u) == 0u) { if (xb_ld(&bar[XB_TMO])) break; if (sp > XB_SPIN_CAP) { atomicAdd(&bar[XB_TMO], 1u); break; } }
    }
    nloc = mine > 0u ? mine : 1u; nx = cnt > 0u ? cnt : 1u;
}
__device__ __forceinline__ void xcd_barrier(const XcdBarrier& b) {
    asm volatile("s_waitcnt vmcnt(0)" ::: "memory");
    __syncthreads();
    if (threadIdx.x == 0) {
        GAS unsigned* gbar = (GAS unsigned*)b.bar; unsigned bx_ = b.x;
        asm volatile("" : "+s"(gbar), "+s"(bx_));
        unsigned* bar = (unsigned*)gbar;
        __builtin_amdgcn_s_waitcnt(0);
        unsigned nloc = b.st[0], nx = b.st[1];
        if (nloc == 0u) { xcd_barrier_complete(bar, bx_, nloc, nx); b.st[0] = nloc; b.st[1] = nx; }
        const unsigned old = xb_add(&bar[XB_XSUB(bx_)], 1u);
        const unsigned gen = old / nloc;
        if (old + 1u == (gen + 1u) * nloc) {
            __builtin_amdgcn_fence(__ATOMIC_RELEASE, "agent");
            asm volatile("s_waitcnt vmcnt(0)" ::: "memory");
            const unsigned og = xb_add(&bar[XB_TOP], 1u);
            const unsigned tg = og / nx;
            if (og + 1u == (tg + 1u) * nx) xb_add(&bar[XB_TOPGEN], 1u);
            else XB_SPIN(xb_ld(&bar[XB_TOPGEN]) == tg, bar);
            __builtin_amdgcn_fence(__ATOMIC_ACQUIRE, "agent");
            xb_add(&bar[XB_XGEN(bx_)], 1u);
            asm volatile("s_waitcnt vmcnt(0)" ::: "memory");
        } else {
            XB_SPIN(xb_ld(&bar[XB_XGEN(bx_)]) == gen, bar);
            __builtin_amdgcn_fence(__ATOMIC_ACQUIRE, "agent");
            asm volatile("s_waitcnt vmcnt(0)" ::: "memory");
        }
    }
    __syncthreads();
}

struct Args {
    const float* in[24]; float* out; unsigned char* ws; int ph_lo, ph_hi;
};
enum { I_X = 0, I_C, I_POS, I_WADA, I_BADA, I_GATTN, I_WIN, I_DLAM, I_SUBG, I_RELB, I_QNORM, I_WUQ, I_KVNORM, I_WUKV, I_WO, I_GFFN, I_W1, I_W3, I_W2, I_ROUTER, I_MW1, I_MW3, I_MW2, I_GFINAL };

__device__ __forceinline__ int rowmap(int kind, int n) {
    switch (kind) {
        case 1: { if (n < C_KR) return n; const int i = n - C_KR; return C_KR + (i < 16 ? 2 * i : 2 * (i - 16) + 1); }
        case 2: { const int h = n / 96, j = n % 96; if (j < 64) return n; return h * 96 + 64 + (j < 80 ? 2 * (j - 64) : 2 * (j - 80) + 1); }
        case 3: { const int h = n >> 7, j = n & 127; return j < 64 ? h * 64 + j : 512 + h * 64 + (j - 64); }
        case 4: return (n >> 7) * 256 + (n & 127);
        case 5: return (n >> 7) * 256 + 128 + (n & 127);
        default: return n;
    }
}
__device__ __forceinline__ void transpose_item(const float* W, int K, int N, bf16_t* WT, int kind, const float* gain, LAS float* scr, int item, int lane) {
    const int nblk = N / 32, kb = item / nblk, nb = item % nblk, k0 = 64 * kb, n0 = 32 * nb;
#pragma unroll 8
    for (int i = 0; i < 32; ++i) { const int kk = 2 * i + (lane >> 5); float v = __builtin_nontemporal_load(W + (size_t)(k0 + kk) * N + n0 + (lane & 31)); if (gain) v *= gain[k0 + kk]; scr[kk * 33 + (lane & 31)] = v; }
    LDS_WAIT(); asm volatile("" ::: "memory");
    const int c = lane & 7;
#pragma unroll
    for (int j = 0; j < 4; ++j) { const int n = (lane >> 3) + 8 * j; const LAS float* s = scr + (8 * c) * 33 + n;
        u32x4 o; o.x = cvt_pk_bf16(s[0 * 33], s[1 * 33]); o.y = cvt_pk_bf16(s[2 * 33], s[3 * 33]); o.z = cvt_pk_bf16(s[4 * 33], s[5 * 33]); o.w = cvt_pk_bf16(s[6 * 33], s[7 * 33]);
        *(u32x4*)(WT + (size_t)rowmap(kind, n0 + n) * K + k0 + 8 * c) = o; }
    LDS_WAIT(); asm volatile("" ::: "memory");
}

__device__ __forceinline__ void transpose_item_f8(const float* W, int K, int N, unsigned char* WT, int kind, LAS float* scr, int item, int lane) {
    const int nblk = N / 32, kb = item / nblk, nb = item % nblk, k0 = 64 * kb, n0 = 32 * nb;
#pragma unroll 8
    for (int i = 0; i < 32; ++i) { const int kk = 2 * i + (lane >> 5); scr[kk * 33 + (lane & 31)] = __builtin_nontemporal_load(W + (size_t)(k0 + kk) * N + n0 + (lane & 31)) * WSCALE; }
    LDS_WAIT(); asm volatile("" ::: "memory");
#pragma unroll
    for (int j = 0; j < 2; ++j) { const int idx = lane + 64 * j, n = idx >> 2, c = idx & 3; const LAS float* s = scr + (16 * c) * 33 + n;
        u32x4 o; o.x = pk_fp8x4(s[0 * 33], s[1 * 33], s[2 * 33], s[3 * 33]); o.y = pk_fp8x4(s[4 * 33], s[5 * 33], s[6 * 33], s[7 * 33]);
        o.z = pk_fp8x4(s[8 * 33], s[9 * 33], s[10 * 33], s[11 * 33]); o.w = pk_fp8x4(s[12 * 33], s[13 * 33], s[14 * 33], s[15 * 33]);
        *(u32x4*)(WT + (size_t)rowmap(kind, n0 + n) * K + k0 + 16 * c) = o; }
    LDS_WAIT(); asm volatile("" ::: "memory");
}

template <int PM = 7  >
__device__ __forceinline__ void prologue(LAS unsigned char* lds, int vcu, int G, int wv) {
    const int tid = otid(wv), lane = tid & 63, wave = wv;
    unsigned char* ws = karg_ws(okarg());
    if (PM & 1) {
        LAS float* sl = (LAS float*)lds;
        LAS float* red = (LAS float*)(lds + 32768);
        const float* c = karg_in(okarg(), I_C);
        for (int i = tid; i < NB * DM; i += 512) { const int b = i >> 10, k = i & 1023; const float v = c[i]; sl[k * 8 + b] = v / (1.f + __expf(-v)); }
        __syncthreads();
        float* mod = (float*)(ws + WS_MOD);
        for (int it = vcu; it < DEPTH * 48; it += G) {
            const int l = it / 48, n0 = (it % 48) * 128, cl = tid & 31, ks = tid >> 5;
            const float* wp = karg_in(okarg(), I_WADA) + (size_t)l * DM * 6144 + (size_t)(ks * 64) * 6144 + n0 + 4 * cl;
            f32x4 acc[8];
#pragma unroll
            for (int b = 0; b < 8; ++b) acc[b] = (f32x4){0.f, 0.f, 0.f, 0.f};
#pragma unroll 8
            for (int k = 0; k < 64; ++k) { const f32x4 w = __builtin_nontemporal_load((const f32x4*)(wp + (size_t)k * 6144));
                const f32x4 s0 = *(const LAS f32x4*)(sl + (ks * 64 + k) * 8), s1 = *(const LAS f32x4*)(sl + (ks * 64 + k) * 8 + 4);
                acc[0] += w * s0[0]; acc[1] += w * s0[1]; acc[2] += w * s0[2]; acc[3] += w * s0[3]; acc[4] += w * s1[0]; acc[5] += w * s1[1]; acc[6] += w * s1[2]; acc[7] += w * s1[3]; }
#pragma unroll
            for (int b = 0; b < 8; ++b) *(LAS f32x4*)(red + (ks * 8 + b) * 128 + 4 * cl) = acc[b];
            __syncthreads();
            for (int o = tid; o < 1024; o += 512) { const int b = o >> 7, n = o & 127; float s = 0.f;
#pragma unroll
                for (int k2 = 0; k2 < 16; ++k2) s += red[(k2 * 8 + b) * 128 + n];
                mod[((size_t)l * 8 + b) * 6144 + n0 + n] = s + karg_in(okarg(), I_BADA)[(size_t)l * 6144 + n0 + n]; }
            __syncthreads();
        }
    }
    {
        const int* pos = (const int*)karg_in(okarg(), I_POS);
        float* cs = (float*)(ws + WS_CS);
        for (int i = vcu * 512 + tid; i < M * 16; i += G * 512) {
            const int row = i >> 4, f = i & 15;
            const double base[4] = {1.0, 0.5623413251903491, 0.31622776601683794, 0.1778279410038923};
            double inv = base[f & 3]; for (int q = 0; q < (f >> 2); ++q) inv *= 0.1;
            const double rev = (double)pos[row] * inv * 0.15915494309189535;
            const float fr = (float)(rev - rint(rev));
            cs[2 * i] = __builtin_amdgcn_cosf(fr); cs[2 * i + 1] = __builtin_amdgcn_sinf(fr);
        }
        int* kmax = (int*)(ws + WS_MISC) + 64; int* qmin = kmax + 256; float* lamv = (float*)(ws + WS_MISC);
        if (vcu == 1 % G) {
            if (tid < 256) { int mx = pos[tid * 64]; for (int k = 1; k < 64; ++k) { const int p = pos[tid * 64 + k]; mx = p > mx ? p : mx; } kmax[tid] = mx; }
            { int mn = pos[tid * 32]; for (int k = 1; k < 32; ++k) { const int p = pos[tid * 32 + k]; mn = p < mn ? p : mn; } qmin[tid] = mn; }
        }
        if (vcu == 3 % G && tid < 128) ((int*)(ws + WS_MISC))[2048 + tid] = att::rel_bucket(tid);
        if (vcu == 2 % G && tid < DEPTH) {
            const float* lv = karg_in(okarg(), I_DLAM) + tid * 256; float s1 = 0.f, s2 = 0.f;
            for (int k = 0; k < 64; ++k) { s1 += lv[k] * lv[64 + k]; s2 += lv[128 + k] * lv[192 + k]; }
            lamv[tid] = expf(s1) - expf(s2) + (0.8f - 0.6f * expf(-0.3f * (float)tid));
        }
    }
    __syncthreads();
    if ((F8_UP == 2 || IN_I8) && (PM & 2)) {
        LAS float* scr = (LAS float*)lds; LAS float* red = (LAS float*)(lds + 133120); LAS float* cinv = (LAS float*)(lds + 133120 + 2048);
        constexpr int N_UP = (F8_UP == 2) ? 36 * 88 : 0, N_IN = IN_I8 ? 4 * 69 : 0;
#define LBAR() asm volatile("s_waitcnt lgkmcnt(0)\n\ts_barrier" ::: "memory")
#define STRIP_SRC(it_, W_, ldw_, n0_) do { if ((it_) < N_UP) { const int mat_ = (it_) / 88, w3_ = mat_ & 1, dm_ = mat_ >> 1; n0_ = ((it_) % 88) * 32; ldw_ = DFF; \
                W_ = (dm_ < 2) ? karg_in(okarg(), w3_ ? I_W3 : I_W1) + (size_t)dm_ * DM * DFF : karg_in(okarg(), w3_ ? I_MW3 : I_MW1) + (size_t)(dm_ - 2) * DM * DFF; } \
            else { const int r_ = (it_) - N_UP; n0_ = (r_ % 69) * 32; ldw_ = INW; W_ = karg_in(okarg(), I_WIN) + (size_t)(r_ / 69) * DM * INW; } } while (0)
#define STRIP_LOAD(it_) do { const float* W_; int ldw_, n0_; STRIP_SRC(it_, W_, ldw_, n0_); const float* wp_ = W_ + (size_t)(128 * wave + (lane >> 5)) * ldw_ + n0_ + (lane & 31); \
            _Pragma("unroll") for (int i = 0; i < 64; ++i) rv[i] = __builtin_nontemporal_load(wp_ + (size_t)(2 * i) * ldw_); } while (0)
        float rv[64];
        if (vcu < N_UP + N_IN) STRIP_LOAD(vcu);
        for (int it = vcu; it < N_UP + N_IN; it += G) {
            unsigned char* WT; float* sc; int n0, kind;
            if (it < N_UP) { const int mat = it / 88, w3 = mat & 1, dm = mat >> 1;
                n0 = (it % 88) * 32; kind = 4 + w3;
                WT = (dm < 2) ? ws + WS_WD13 + (size_t)dm * 2 * DFF * DM : ws + WS_WM13 + (size_t)(dm - 2) * 2 * DFF * DM;
                sc = (float*)(ws + WS_WSC) + (size_t)dm * (2 * DFF);
            } else { const int r = it - N_UP, l = r / 69; n0 = (r % 69) * 32; kind = 1;
                WT = ws + WS_WIN + (size_t)l * INP * DM; sc = (float*)(ws + WS_WSC2) + (size_t)l * INP; }
#pragma unroll
            for (int i = 0; i < 64; ++i) { const int k = 128 * wave + 2 * i + (lane >> 5), n = lane & 31; scr[k * 32 + ((n + (k >> 4)) & 31)] = rv[i]; }
            if (it + G < N_UP + N_IN) STRIP_LOAD(it + G);
            LBAR();
            { const int n = tid & 31, ks = tid >> 5; float m = 0.f;
#pragma unroll 16
              for (int k = 64 * ks; k < 64 * ks + 64; ++k) m = fmaxf(m, fabsf(scr[k * 32 + ((n + (k >> 4)) & 31)]));
              red[ks * 32 + n] = m; }
            LBAR();
            if (tid < 32) { float m = 0.f;
#pragma unroll
                for (int s = 0; s < 16; ++s) m = fmaxf(m, red[s * 32 + tid]);
                cinv[tid] = m > 0.f ? 127.f / m : 0.f; sc[rowmap(kind, n0 + tid)] = m > 0.f ? m * (1.f / 127.f) : 1.f; }
            LBAR();
#pragma unroll
            for (int j = 0; j < 4; ++j) { const int nl = 4 * wave + j, c = lane; const float iv = cinv[nl];
                const LAS float* s = scr + (16 * c) * 32 + ((nl + c) & 31);
                u32x4 o; o.x = pk_i8x4(s[0] * iv, s[32] * iv, s[64] * iv, s[96] * iv); o.y = pk_i8x4(s[128] * iv, s[160] * iv, s[192] * iv, s[224] * iv);
                o.z = pk_i8x4(s[256] * iv, s[288] * iv, s[320] * iv, s[352] * iv); o.w = pk_i8x4(s[384] * iv, s[416] * iv, s[448] * iv, s[480] * iv);
                *(u32x4*)(WT + (size_t)rowmap(kind, n0 + nl) * DM + 16 * c) = o; }
            LBAR();
        }
#undef LBAR
#undef STRIP_SRC
#undef STRIP_LOAD
    }
    if (PM & 4) {
        LAS float* scr = (LAS float*)(lds + wave * 16384);
        const int gw = vcu * 8 + wave, NGW = G * 8;
        constexpr int IA = 16 * 69, IB = 6 * 24, IC = 4 * 32, ID = 16 * 32, IE = 16 * 88, IF = 44 * 32;
        constexpr int NA = IN_I8 ? 0 : 4 * IA, NBq = 4 * IB, NC = 4 * IC, ND = 4 * ID, NE = (F8_UP == 2) ? 0 : 4 * IE, NF = 2 * IF, NG = (F8_UP == 2) ? 0 : 32 * IE, NH = 16 * IF;
        constexpr int NITEMS = NA + NBq + NC + ND + NE + NF + NG + NH;
        struct TD { const float* W; const float* gain; unsigned char* WT; int K, N, kind, f8, item; };
#define TDEC(it_, d) do { int r = (it_); \
            if (r < NA) { const int l = r / IA; d = TD{karg_in(okarg(), I_WIN) + (size_t)l * DM * INW, nullptr, ws + WS_WIN + (size_t)l * INP * DM * 2, DM, INW, 1, 0, r % IA}; break; } r -= NA; \
            if (r < NBq) { const int l = r / IB; d = TD{karg_in(okarg(), I_WUQ) + (size_t)l * QR * NQ, karg_in(okarg(), I_QNORM) + l * QR, ws + WS_WUQ + (size_t)l * NQ * QR * 2, QR, NQ, 2, 0, r % IB}; break; } r -= NBq; \
            if (r < NC) { const int l = r / IC; d = TD{karg_in(okarg(), I_WUKV) + (size_t)l * KVR * NKV, karg_in(okarg(), I_KVNORM) + l * KVR, ws + WS_WUKV + (size_t)l * NKV * KVR * 2, KVR, NKV, 3, 0, r % IC}; break; } r -= NC; \
            if (r < ND) { const int l = r / ID; d = TD{karg_in(okarg(), I_WO) + (size_t)l * DM * DM, nullptr, ws + WS_WO + (size_t)l * DM * DM * 2, DM, DM, 0, 0, r % ID}; break; } r -= ND; \
            if (r < NE) { const int j = r / IE, dl = j >> 1, w3 = j & 1; d = TD{karg_in(okarg(), w3 ? I_W3 : I_W1) + (size_t)dl * DM * DFF, nullptr, ws + WS_WD13 + (size_t)dl * 2 * DFF * DM * (F8_UP ? 1 : 2), DM, DFF, 4 + w3, F8_UP ? 1 : 0, r % IE}; break; } r -= NE; \
            if (r < NF) { const int dl = r / IF; d = TD{karg_in(okarg(), I_W2) + (size_t)dl * DFF * DM, nullptr, ws + WS_WD2 + (size_t)dl * DM * DFF, DFF, DM, 0, 1, r % IF}; break; } r -= NF; \
            if (r < NG) { const int j = r / IE, me = j >> 1, w3 = j & 1; d = TD{karg_in(okarg(), w3 ? I_MW3 : I_MW1) + (size_t)me * DM * DFF, nullptr, ws + WS_WM13 + (size_t)me * 2 * DFF * DM * (F8_UP ? 1 : 2), DM, DFF, 4 + w3, F8_UP ? 1 : 0, r % IE}; break; } r -= NG; \
            { const int me = r / IF; d = TD{karg_in(okarg(), I_MW2) + (size_t)me * DFF * DM, nullptr, ws + WS_WM2 + (size_t)me * DM * DFF, DFF, DM, 0, 1, r % IF}; } } while (0)
#define TLOAD(d) do { const int nblk_ = d.N / 32, k0_ = 64 * (d.item / nblk_), n0_ = 32 * (d.item % nblk_); const float* wp_ = d.W + (size_t)(k0_ + (lane >> 5)) * d.N + n0_ + (lane & 31); \
            _Pragma("unroll") for (int i = 0; i < 32; ++i) tv[i] = __builtin_nontemporal_load(wp_ + (size_t)(2 * i) * d.N); } while (0)
        float tv[32]; TD cur{}, nxt{};
        if (gw < NITEMS) { TDEC(gw, cur); TLOAD(cur); }
        for (int it = gw; it < NITEMS; it += NGW) {
            const int nblk = cur.N / 32, k0 = 64 * (cur.item / nblk), n0 = 32 * (cur.item % nblk);
#pragma unroll
            for (int i = 0; i < 32; ++i) { const int kk = 2 * i + (lane >> 5); float v = tv[i]; if (cur.gain) v *= cur.gain[k0 + kk]; if (cur.f8) v *= WSCALE; scr[kk * 33 + (lane & 31)] = v; }
            const bool hn = it + NGW < NITEMS;
            if (hn) { TDEC(it + NGW, nxt); TLOAD(nxt); }
            LDS_WAIT(); asm volatile("" ::: "memory");
            if (cur.f8) {
#pragma unroll
                for (int j = 0; j < 2; ++j) { const int idx = lane + 64 * j, n = idx >> 2, c = idx & 3; const LAS float* s = scr + (16 * c) * 33 + n;
                    u32x4 o; o.x = pk_fp8x4(s[0 * 33], s[1 * 33], s[2 * 33], s[3 * 33]); o.y = pk_fp8x4(s[4 * 33], s[5 * 33], s[6 * 33], s[7 * 33]);
                    o.z = pk_fp8x4(s[8 * 33], s[9 * 33], s[10 * 33], s[11 * 33]); o.w = pk_fp8x4(s[12 * 33], s[13 * 33], s[14 * 33], s[15 * 33]);
                    *(u32x4*)(cur.WT + (size_t)rowmap(cur.kind, n0 + n) * cur.K + k0 + 16 * c) = o; }
            } else { const int c = lane & 7;
#pragma unroll
                for (int j = 0; j < 4; ++j) { const int n = (lane >> 3) + 8 * j; const LAS float* s = scr + (8 * c) * 33 + n;
                    u32x4 o; o.x = cvt_pk_bf16(s[0 * 33], s[1 * 33]); o.y = cvt_pk_bf16(s[2 * 33], s[3 * 33]); o.z = cvt_pk_bf16(s[4 * 33], s[5 * 33]); o.w = cvt_pk_bf16(s[6 * 33], s[7 * 33]);
                    *(u32x4*)((bf16_t*)cur.WT + (size_t)rowmap(cur.kind, n0 + n) * cur.K + k0 + 8 * c) = o; }
            }
            LDS_WAIT(); asm volatile("" ::: "memory");
            cur = nxt;
        }
#undef TDEC
#undef TLOAD
    }    __syncthreads();
}

template <int MODE, int F8O = 0, bool XF32 = false>
__device__ __forceinline__ void norm_phase(const void* xin_, void* xout_, float* asc, const bf16_t* yp, const int* slot0, const int* slot1, const float* gate_prev  ,
                                           const float* gvec, const float* modl, int ch_sh, int ch_sc, bf16_t* H,
                                           const float* wrouter, unsigned* cnt, int* re0, int* re1, int* rr0, int* rr1, float* rg0, float* rg1,
                                           LAS unsigned char* lds, int vcu, int G, int wv) {
    const int tid = otid(wv), lane = tid & 63, wave = wv;
    const int gw = vcu * 8 + wave;
    LAS float* wr_l = (LAS float*)lds;
    LAS int* rsel = (LAS int*)(lds + 40960); LAS float* rgate = (LAS float*)(lds + 40960 + 512); LAS int* rrank = (LAS int*)(lds + 40960 + 1024); LAS int* rbase = (LAS int*)(lds + 40960 + 1536);
    if (MODE == 1) { for (int i = tid; i < DM * NEXP / 4; i += 512) { const int col = i >> 1; *(LAS f32x4*)(wr_l + col * 8 + (col >> 2) * 4 + 4 * (i & 1)) = ((const f32x4*)wrouter)[i]; } __syncthreads(); }
    const int mbase = gw * 8, b = mbase >> 11;
    f32x4 gs[4], sh4[4], gp[4];
#pragma unroll
    for (int j = 0; j < 4; ++j) { const int col = 4 * lane + 256 * j;
        if (MODE == 2) gs[j] = *(const f32x4*)(gvec + col);
        else { gs[j] = *(const f32x4*)(gvec + col) * (*(const f32x4*)(modl + (size_t)b * 6144 + ch_sc * DM + col) + 1.0f); sh4[j] = *(const f32x4*)(modl + (size_t)b * 6144 + ch_sh * DM + col); }
        if (yp) gp[j] = *(const f32x4*)(gate_prev + (size_t)b * 6144 + col) + 1.0f; }
#pragma unroll 1
    for (int grp = 0; grp < 2; ++grp) {
        const int m0 = mbase + grp * 4;
        f32x4 v[4][4]; u32x2 y0[4][4], y1[4][4]; int s1v[4];
        if (yp) {
#pragma unroll
            for (int r = 0; r < 4; ++r) { const int m = m0 + r;
                const int s0 = slot0 ? __builtin_amdgcn_readfirstlane(slot0[m]) : m; s1v[r] = slot1 ? __builtin_amdgcn_readfirstlane(slot1[m]) : -1;
#pragma unroll
                for (int j = 0; j < 4; ++j) { const int col = 4 * lane + 256 * j; y0[r][j] = *(const u32x2*)(yp + (size_t)s0 * DM + col); if (s1v[r] >= 0) y1[r][j] = *(const u32x2*)(yp + (size_t)s1v[r] * DM + col); } }
        }
#pragma unroll
        for (int r = 0; r < 4; ++r)
#pragma unroll
            for (int j = 0; j < 4; ++j) { const size_t off = (size_t)(m0 + r) * DM + 4 * lane + 256 * j;
                if (XF32) v[r][j] = *(const f32x4*)((const float*)xin_ + off);
                else { const u32x2 w = *(const u32x2*)((const bf16_t*)xin_ + off); v[r][j] = (f32x4){bf_lo(w.x), bf_hi(w.x), bf_lo(w.y), bf_hi(w.y)}; } }
#pragma unroll
        for (int r = 0; r < 4; ++r) {
            const int m = m0 + r;
            if (yp) {
#pragma unroll
                for (int j = 0; j < 4; ++j) { const int col = 4 * lane + 256 * j;
                    f32x4 y = (f32x4){bf_lo(y0[r][j].x), bf_hi(y0[r][j].x), bf_lo(y0[r][j].y), bf_hi(y0[r][j].y)};
                    if (s1v[r] >= 0) y += (f32x4){bf_lo(y1[r][j].x), bf_hi(y1[r][j].x), bf_lo(y1[r][j].y), bf_hi(y1[r][j].y)};
                    v[r][j] += gp[j] * y;
                    if (MODE != 2) { u32x2 w; w.x = cvt_pk_bf16(v[r][j][0], v[r][j][1]); w.y = cvt_pk_bf16(v[r][j][2], v[r][j][3]); *(u32x2*)((bf16_t*)xout_ + (size_t)m * DM + col) = w; } }
            }
            float ss = 0.f;
#pragma unroll
            for (int j = 0; j < 4; ++j) ss += (v[r][j][0] * v[r][j][0] + v[r][j][1] * v[r][j][1]) + (v[r][j][2] * v[r][j][2] + v[r][j][3] * v[r][j][3]);
            const float rs = 1.0f / sqrtf(wave_sum(ss) * (1.f / DM) + EPS);
            if (MODE == 2) {
#pragma unroll
                for (int j = 0; j < 4; ++j) *(f32x4*)((float*)xout_ + (size_t)m * DM + 4 * lane + 256 * j) = v[r][j] * rs * gs[j];
            } else {
                float lg[NEXP];
#pragma unroll
                for (int e = 0; e < NEXP; ++e) lg[e] = 0.f;
                float qinv = 0.f;
                if (F8O == 2) {
                    float am = 0.f;
#pragma unroll
                    for (int j = 0; j < 4; ++j) { const f32x4 h = v[r][j] * rs * gs[j] + sh4[j]; am = fmaxf(am, fmaxf(fmaxf(fabsf(h[0]), fabsf(h[1])), fmaxf(fabsf(h[2]), fabsf(h[3])))); }
                    am = wave_max(am); qinv = am > 0.f ? 127.f / am : 0.f; if (lane == 0) asc[m] = am > 0.f ? am * (1.f / 127.f) : 1.f;
                }
#pragma unroll
                for (int j = 0; j < 4; ++j) {
                    const int col = 4 * lane + 256 * j;
                    const f32x4 h = v[r][j] * rs * gs[j] + sh4[j];
                    if (F8O == 2) *(unsigned*)((unsigned char*)H + (size_t)m * DM + col) = pk_i8x4(h[0] * qinv, h[1] * qinv, h[2] * qinv, h[3] * qinv);
                    else if (F8O == 1) *(unsigned*)((unsigned char*)H + (size_t)m * DM + col) = pk_fp8x4(h[0] * HSCALE, h[1] * HSCALE, h[2] * HSCALE, h[3] * HSCALE);
                    else { u32x2 w; w.x = cvt_pk_bf16(h[0], h[1]); w.y = cvt_pk_bf16(h[2], h[3]); *(u32x2*)(H + (size_t)m * DM + col) = w; }
                    if (MODE == 1) {
#pragma unroll
                        for (int k = 0; k < 4; ++k) { const f32x4 w0 = *(const LAS f32x4*)(wr_l + (col + k) * 8 + (col >> 2) * 4), w1 = *(const LAS f32x4*)(wr_l + (col + k) * 8 + (col >> 2) * 4 + 4);
                            lg[0] += h[k] * w0[0]; lg[1] += h[k] * w0[1]; lg[2] += h[k] * w0[2]; lg[3] += h[k] * w0[3]; lg[4] += h[k] * w1[0]; lg[5] += h[k] * w1[1]; lg[6] += h[k] * w1[2]; lg[7] += h[k] * w1[3]; }
                    }
                }
                if (MODE == 1) {
#pragma unroll
                    for (int e = 0; e < NEXP; ++e) lg[e] = wave_sum(lg[e]);
                    int e0 = 0; float v0 = lg[0];
#pragma unroll
                    for (int e = 1; e < NEXP; ++e) if (lg[e] > v0) { v0 = lg[e]; e0 = e; }
                    int e1 = -1; float v1 = -INFINITY;
#pragma unroll
                    for (int e = 0; e < NEXP; ++e) if (e != e0 && lg[e] > v1) { v1 = lg[e]; e1 = e; }
                    const float g0 = 1.f / (1.f + __expf(v1 - v0)), g1 = 1.f - g0;
                    if (lane == 0) { const int rl = m - vcu * 64; rsel[rl * 2] = e0; rsel[rl * 2 + 1] = e1; rgate[rl * 2] = g0; rgate[rl * 2 + 1] = g1; }
                }
            }
        }
    }
    if (MODE == 1) {
        __syncthreads();
        if (tid < NEXP) { int c = 0; for (int p = 0; p < 128; ++p) if (rsel[p] == tid) { rrank[p] = c; ++c; }
            rbase[tid] = c ? (int)__hip_atomic_fetch_add(cnt + tid, (unsigned)c, RLX_AGENT) : 0; }
        __syncthreads();
        if (tid < 64) { const int m = vcu * 64 + tid; const int e0 = rsel[2 * tid], e1 = rsel[2 * tid + 1];
            re0[m] = e0; re1[m] = e1; rr0[m] = rbase[e0] + rrank[2 * tid]; rr1[m] = rbase[e1] + rrank[2 * tid + 1]; rg0[m] = rgate[2 * tid]; rg1[m] = rgate[2 * tid + 1]; }
    }
}

__device__ __forceinline__ void gather_phase(const bf16_t* H, bf16_t* HP, unsigned* cnt, const int* re0, const int* re1, const int* rr0, const int* rr1, const float* rg0, const float* rg1,
                                             int* slot0, int* slot1, float* gslot, int* pexp, const float* asc, float* asl, int vcu, int G, int wv) {
    const int tid = otid(wv), lane = tid & 63, wave = wv;
    const int gw = vcu * 8 + wave, NGW = G * 8;
    int off[NEXP]; int tot;
    { int s = 0;
#pragma unroll
        for (int e = 0; e < NEXP; ++e) { off[e] = s; s += (((int)__hip_atomic_load(cnt + e, RLX_AGENT) + 255) >> 8) << 8; }
        tot = s; }
    if (vcu == 0 && tid < 160) {
        int e = 0;
#pragma unroll
        for (int k = 1; k < NEXP; ++k) e += (tid * 256 >= off[k]) ? 1 : 0;
        pexp[tid] = e; if (tid == 0) pexp[160] = tot >> 8;
    }
    for (int m = gw; m < M; m += NGW) {
        const int e0 = re0[m], e1 = re1[m]; int o0 = 0, o1 = 0;
#pragma unroll
        for (int e = 0; e < NEXP; ++e) { o0 = (e == e0) ? off[e] : o0; o1 = (e == e1) ? off[e] : o1; }
        const int s0 = o0 + rr0[m], s1 = o1 + rr1[m];
        if (F8_UP) { const u32x4 x0 = ((const u32x4*)((const unsigned char*)H + (size_t)m * DM))[lane];
            ((u32x4*)((unsigned char*)HP + (size_t)s0 * DM))[lane] = x0; ((u32x4*)((unsigned char*)HP + (size_t)s1 * DM))[lane] = x0; }
        else { const u32x4* srcp = (const u32x4*)(H + (size_t)m * DM); const u32x4 x0 = srcp[lane], x1 = srcp[64 + lane];
            u32x4* d0 = (u32x4*)(HP + (size_t)s0 * DM); u32x4* d1 = (u32x4*)(HP + (size_t)s1 * DM); d0[lane] = x0; d0[64 + lane] = x1; d1[lane] = x0; d1[64 + lane] = x1; }
        if (lane == 0) { slot0[m] = s0; slot1[m] = s1; gslot[s0] = rg0[m]; gslot[s1] = rg1[m]; if (F8_UP == 2) { const float a = asc[m]; asl[s0] = a; asl[s1] = a; } }
    }
}

__global__ void __launch_bounds__(512, 2) mk_fwd(Args args) {
    extern __shared__ __attribute__((aligned(16))) unsigned char lds_raw[];
    LAS unsigned char* lds = (LAS unsigned char*)lds_raw;
    volatile LAS unsigned* MISC = (volatile LAS unsigned*)(lds + MISC_OFF);
    const int tid = threadIdx.x; const int wv = __builtin_amdgcn_readfirstlane(tid >> 6);
    constexpr int G = 256;
    const int bx = blockIdx.x; const int vcu = (bx % 8) * (G / 8) + bx / 8;
    gu32* ctl = (gu32*)(karg_ws(okarg()) + WS_CTL);
    for (int u = tid; u < (LDS_BYTES - LDSCTL_OFF) / 4; u += 512) ((LAS unsigned*)(lds + LDSCTL_OFF))[u] = 0u;
    __syncthreads();
    XcdBarrier bar = xcd_barrier_post((unsigned*)ctl + CW_BAR, MISC + 8);
    const int lo = karg_lo(okarg()), hi = karg_hi(okarg());
#define IN(k) (lo <= (k) && (k) < hi)
#define SEAM(k) do { if (IN(k) && IN((k) + 1)) { xcd_barrier(bar); if (PREPS(9) == 2) xcd_barrier(bar); } } while (0)

#define WSP(T, off) ((T*)(w + (off)))
    if (IN(0)) { prologue<7>(lds, vcu, G, wv); if (PROBE_PMASK) prologue<PROBE_PMASK>(lds, vcu, G, wv); }
    SEAM(0);

    for (int l = 0; l < DEPTH; ++l) {
        const int pb = 1 + l * NPH_L; const bool moe = (l & 1) != 0; const int li = l >> 1;
        if (IN(pb + 0)) {
            kptr_t ka = okarg(); const int bxo = osi(bx), vco = osi(vcu); (void)bxo; (void)vco; unsigned char* w = karg_ws(ka); const float* modl = WSP(float, WS_MOD) + (size_t)l * 8 * 6144; int* RT = WSP(int, WS_ROUTE);
            if (PROBE_NORM & 1) { bf16_t* dx = (bf16_t*)(w + WS_U); bf16_t* dh = (bf16_t*)(w + WS_U + 64 * MiB); float* da = (float*)(w + WS_U + 128 * MiB);
                if (l == 0) norm_phase<0, IN_I8 ? 2 : 0, true>(karg_in(ka, I_X), nullptr, da, nullptr, nullptr, nullptr, nullptr, karg_in(ka, I_GATTN), modl, 0, 1, dh, nullptr, nullptr, nullptr, nullptr, nullptr, nullptr, nullptr, nullptr, lds, vco, G, wv);
                else { const bool pm = ((l - 1) & 1) != 0;
                    norm_phase<0, IN_I8 ? 2 : 0>(WSP(bf16_t, WS_XB), dx, da, WSP(bf16_t, WS_YP), pm ? RT + 6 * M : nullptr, pm ? RT + 7 * M : nullptr, WSP(float, WS_MOD) + (size_t)(l - 1) * 8 * 6144 + 5 * DM, karg_in(ka, I_GATTN) + l * DM, modl, 0, 1, dh, nullptr, nullptr, nullptr, nullptr, nullptr, nullptr, nullptr, nullptr, lds, vco, G, wv); }
                __syncthreads(); }
            if (l == 0) norm_phase<0, IN_I8 ? 2 : 0, true>(karg_in(ka, I_X), nullptr, WSP(float, WS_ROUTE) + 8 * M, nullptr, nullptr, nullptr, nullptr, karg_in(ka, I_GATTN), modl, 0, 1, WSP(bf16_t, WS_H), nullptr, nullptr, nullptr, nullptr, nullptr, nullptr, nullptr, nullptr, lds, vco, G, wv);
            else { const bool pm = ((l - 1) & 1) != 0;
                norm_phase<0, IN_I8 ? 2 : 0>(WSP(bf16_t, WS_XB), WSP(bf16_t, WS_XB), WSP(float, WS_ROUTE) + 8 * M, WSP(bf16_t, WS_YP), pm ? RT + 6 * M : nullptr, pm ? RT + 7 * M : nullptr, WSP(float, WS_MOD) + (size_t)(l - 1) * 8 * 6144 + 5 * DM, karg_in(ka, I_GATTN) + l * DM, modl, 0, 1, WSP(bf16_t, WS_H), nullptr, nullptr, nullptr, nullptr, nullptr, nullptr, nullptr, nullptr, lds, vco, G, wv); }
        }
        SEAM(pb + 0);
        if (IN(pb + 1)) {
            kptr_t ka = okarg(); const int bxo = osi(bx), vco = osi(vcu); (void)bxo; (void)vco; unsigned char* w = karg_ws(ka);
            constexpr int KI = IN_I8 ? DM / 2 : DM;
            pg8::Gemm g{WSP(bf16_t, WS_H), (const bf16_t*)(w + WS_WIN + (size_t)l * INP * DM * (IN_I8 ? 1 : 2)), KI, KI, KI, 0};
            pg8::GroupOrder S; S.init(M / 256, INP / 256, G, bxo, nullptr);
            pg8::EpiProj<IN_I8 != 0> E{WSP(bf16_t, WS_PROJ), WSP(float, WS_ROWSS), WSP(float, WS_CS), WSP(float, WS_ROUTE) + 8 * M, WSP(float, WS_WSC2) + (size_t)l * INP};
            for (int rp = 0; rp < PREPS(4); ++rp) pg8::gemm_phase<pg8::EpiProj<IN_I8 != 0>, true, IN_I8 ? 2 : 0>(lds, g, S, E, wv);
        }
        SEAM(pb + 1);
        if (IN(pb + 2)) { for (int rp = 0; rp < PREPS(5); ++rp) {
            { kptr_t ka = okarg(); const int bxo = osi(bx), vco = osi(vcu); (void)bxo; (void)vco; unsigned char* w = karg_ws(ka);
              pg8::Gemm g{WSP(bf16_t, WS_PROJ) + C_MQ, WSP(bf16_t, WS_WUQ) + (size_t)l * NQ * QR, INP, QR, QR, 0};
              pg8::GroupOrder S; S.init(M / 256, NQ / 256, G, bxo, nullptr);
              pg8::EpiQ E{WSP(bf16_t, WS_QM), WSP(float, WS_ROWSS), WSP(float, WS_CS)};
              pg8::gemm_phase<pg8::EpiQ, true>(lds, g, S, E, wv); }
            { kptr_t ka = okarg(); const int bxo = osi(bx), vco = osi(vcu); (void)bxo; (void)vco; unsigned char* w = karg_ws(ka);
              pg8::Gemm g{WSP(bf16_t, WS_PROJ) + C_MKV, WSP(bf16_t, WS_WUKV) + (size_t)l * NKV * KVR, INP, KVR, KVR, 0};
              pg8::GroupOrder S; S.init(M / 256, NKV / 256, G, G - 1 - bxo, nullptr);
              pg8::EpiKV E{WSP(bf16_t, WS_KN), WSP(bf16_t, WS_VM), WSP(float, WS_ROWSS)};
              pg8::gemm_phase<pg8::EpiKV, true>(lds, g, S, E, wv); }
        } }
        SEAM(pb + 2);
        if (IN(pb + 3)) {
            kptr_t ka = okarg(); const int bxo = osi(bx), vco = osi(vcu); (void)bxo; (void)vco; unsigned char* w = karg_ws(ka);
            att::AttnArgs A{WSP(int, WS_MISC) + 2048, WSP(bf16_t, WS_PROJ), WSP(bf16_t, WS_QM), WSP(bf16_t, WS_KN), WSP(bf16_t, WS_VM), WSP(bf16_t, WS_AO), WSP(float, WS_STASH), (const int*)karg_in(ka, I_POS),
                            WSP(int, WS_MISC) + 64, WSP(int, WS_MISC) + 64 + 256, karg_in(ka, I_RELB), karg_in(ka, I_SUBG) + l * 128,
                            WSP(float, WS_MISC)[l], 0.8f - 0.6f * __expf(-0.3f * (float)l)};
            for (int rp = 0; rp < PREPS(1); ++rp) att::attn_phase<0>(lds, A, ctl + CW_QCTR + 64 * l + 32 * rp, wv);
            if (PROBE_ABL >= 0) { att::AttnArgs A2 = A; A2.ao = WSP(bf16_t, WS_YP); att::attn_phase<(PROBE_ABL >= 0 ? PROBE_ABL : 0)>(lds, A2, ctl + CW_QCTR + 64 * l + 48, wv); }
        }
        SEAM(pb + 3);
        if (IN(pb + 4)) {
            kptr_t ka = okarg(); const int bxo = osi(bx), vco = osi(vcu); (void)bxo; (void)vco; unsigned char* w = karg_ws(ka);
            pg8::Gemm g{WSP(bf16_t, WS_AO), WSP(bf16_t, WS_WO) + (size_t)l * DM * DM, DM, DM, DM, 0};
            pg8::GroupOrder S; S.init(M / 256, DM / 256, G, bxo, nullptr);
            pg8::EpiRes E{l == 0 ? karg_in(ka, I_X) : nullptr, WSP(bf16_t, WS_XB), WSP(bf16_t, WS_XB), WSP(float, WS_MOD) + (size_t)l * 8 * 6144 + 2 * DM};
            pg8::gemm_phase<pg8::EpiRes, false>(lds, g, S, E, wv);
        }
        SEAM(pb + 4);
        if (IN(pb + 5)) {
            kptr_t ka = okarg(); const int bxo = osi(bx), vco = osi(vcu); (void)bxo; (void)vco; unsigned char* w = karg_ws(ka); const float* modl = WSP(float, WS_MOD) + (size_t)l * 8 * 6144; int* RT = WSP(int, WS_ROUTE);
            if (PROBE_NORM & 2) { bf16_t* dh = (bf16_t*)(w + WS_U + 64 * MiB); float* da = (float*)(w + WS_U + 128 * MiB); int* dr = (int*)(w + WS_U + 130 * MiB);
                if (moe) norm_phase<1, F8_UP>(WSP(bf16_t, WS_XB), nullptr, da, nullptr, nullptr, nullptr, nullptr, karg_in(ka, I_GFFN) + l * DM, modl, 3, 4, dh, karg_in(ka, I_ROUTER) + (size_t)li * DM * NEXP, (unsigned*)ctl + CW_CNT + 64 * li + 32,
                                   dr, dr + M, dr + 2 * M, dr + 3 * M, (float*)(dr + 4 * M), (float*)(dr + 5 * M), lds, vco, G, wv);
                else norm_phase<0, F8_UP>(WSP(bf16_t, WS_XB), nullptr, da, nullptr, nullptr, nullptr, nullptr, karg_in(ka, I_GFFN) + l * DM, modl, 3, 4, dh, nullptr, nullptr, nullptr, nullptr, nullptr, nullptr, nullptr, nullptr, lds, vco, G, wv);
                __syncthreads(); }
            if (moe) norm_phase<1, F8_UP>(WSP(bf16_t, WS_XB), nullptr, WSP(float, WS_ROUTE) + 8 * M, nullptr, nullptr, nullptr, nullptr, karg_in(ka, I_GFFN) + l * DM, modl, 3, 4, WSP(bf16_t, WS_H), karg_in(ka, I_ROUTER) + (size_t)li * DM * NEXP, (unsigned*)ctl + CW_CNT + 64 * li,
                                   RT, RT + M, RT + 2 * M, RT + 3 * M, (float*)(RT + 4 * M), (float*)(RT + 5 * M), lds, vco, G, wv);
            else norm_phase<0, F8_UP>(WSP(bf16_t, WS_XB), nullptr, WSP(float, WS_ROUTE) + 8 * M, nullptr, nullptr, nullptr, nullptr, karg_in(ka, I_GFFN) + l * DM, modl, 3, 4, WSP(bf16_t, WS_H), nullptr, nullptr, nullptr, nullptr, nullptr, nullptr, nullptr, nullptr, lds, vco, G, wv);
        }
        SEAM(pb + 5);
        if (IN(pb + 6)) { if (moe) { kptr_t ka = okarg(); const int bxo = osi(bx), vco = osi(vcu); (void)bxo; (void)vco; unsigned char* w = karg_ws(ka); int* RT = WSP(int, WS_ROUTE);
            for (int rp = 0; rp < PREPS(8); ++rp) gather_phase(WSP(bf16_t, WS_H), WSP(bf16_t, WS_HPERM), (unsigned*)ctl + CW_CNT + 64 * li, RT, RT + M, RT + 2 * M, RT + 3 * M, (float*)(RT + 4 * M), (float*)(RT + 5 * M), RT + 6 * M, RT + 7 * M,
                         WSP(float, WS_GSLOT), WSP(int, WS_MISC) + 1024, WSP(float, WS_ROUTE) + 8 * M, WSP(float, WS_ASL), vco, G, wv); } }
        if (moe) SEAM(pb + 6);
        if (IN(pb + 7)) {
            kptr_t ka = okarg(); const int bxo = osi(bx), vco = osi(vcu); (void)bxo; (void)vco; unsigned char* w = karg_ws(ka); const int* pexp = moe ? WSP(int, WS_MISC) + 1024 : nullptr;
            constexpr int KU = F8_UP ? DM / 2 : DM;
            pg8::Gemm g{moe ? WSP(bf16_t, WS_HPERM) : WSP(bf16_t, WS_H), (const bf16_t*)((moe ? w + WS_WM13 : w + WS_WD13) + (moe ? (size_t)li * 8 * 2 * DFF * DM : (size_t)li * 2 * DFF * DM) * (F8_UP ? 1 : 2)), KU, KU, KU, (size_t)2 * DFF * KU};
            pg8::GroupOrder S; S.init(moe ? __builtin_amdgcn_readfirstlane(pexp[160]) : M / 256, 2 * DFF / 256, G, bxo, pexp);
            pg8::EpiSwiGLU<F8_UP == 2> E{w + WS_U, 0, moe ? WSP(float, WS_ASL) : WSP(float, WS_ROUTE) + 8 * M, WSP(float, WS_WSC) + (size_t)(moe ? 2 + li * 8 : li) * (2 * DFF)};
            for (int rp = 0; rp < PREPS(2); ++rp) pg8::gemm_phase<pg8::EpiSwiGLU<F8_UP == 2>, true, F8_UP, 127 - F8_H_LOG2, 127 - F8_W_LOG2>(lds, g, S, E, wv);
        }
        SEAM(pb + 7);
        if (IN(pb + 8)) {
            kptr_t ka = okarg(); const int bxo = osi(bx), vco = osi(vcu); (void)bxo; (void)vco; unsigned char* w = karg_ws(ka); const int* pexp = moe ? WSP(int, WS_MISC) + 1024 : nullptr;
            pg8::Gemm g{WSP(bf16_t, WS_U), (const bf16_t*)(moe ? w + WS_WM2 + (size_t)li * 8 * DM * DFF : w + WS_WD2 + (size_t)li * DM * DFF), DFF / 2, DFF / 2, DFF / 2, (size_t)DM * DFF / 2};
            pg8::GroupOrder S; S.init(moe ? __builtin_amdgcn_readfirstlane(pexp[160]) : M / 256, DM / 256, G, bxo, pexp);
            pg8::EpiDown E{WSP(bf16_t, WS_YP), moe ? WSP(float, WS_GSLOT) : nullptr};
            for (int rp = 0; rp < PREPS(3); ++rp) pg8::gemm_phase<pg8::EpiDown, true, true, 127 - F8_U_LOG2, 127 - F8_W_LOG2>(lds, g, S, E, wv);
        }
        SEAM(pb + 8);
    }
    if (IN(NPHASE - 1)) {
        kptr_t ka = okarg(); const int bxo = osi(bx), vco = osi(vcu); (void)bxo; (void)vco; unsigned char* w = karg_ws(ka); int* RT = WSP(int, WS_ROUTE);
        norm_phase<2>(WSP(bf16_t, WS_XB), karg_out(ka), nullptr, WSP(bf16_t, WS_YP), RT + 6 * M, RT + 7 * M, WSP(float, WS_MOD) + (size_t)3 * 8 * 6144 + 5 * DM, karg_in(ka, I_GFINAL), nullptr, 0, 0, nullptr, nullptr, nullptr, nullptr, nullptr, nullptr, nullptr, nullptr, nullptr, lds, vco, G, wv);
    }
#undef WSP
#undef IN
#undef SEAM
}

extern "C" void kernel_launch(void* const* d_in, const int* in_sizes, int n_in, void* d_out, int out_size, void* d_ws, size_t ws_size, hipStream_t stream) {
    static int grid = 0;
    if (grid == 0) {
        if (n_in != 24 || out_size != M * DM || ws_size < WS_END) { fprintf(stderr, "kernel_launch: built for 24 inputs, out %d floats, >= %zu bytes of workspace; got n_in %d out %d ws %zu\n", M * DM, (size_t)WS_END, n_in, out_size, ws_size); grid = -1; return; }
        int dev = 0, cus = 0, per_cu = 0;
        if (hipGetDevice(&dev) != hipSuccess || hipDeviceGetAttribute(&cus, hipDeviceAttributeMultiprocessorCount, dev) != hipSuccess) { grid = -1; return; }
        if (hipFuncSetAttribute((const void*)mk_fwd, hipFuncAttributeMaxDynamicSharedMemorySize, LDS_BYTES) != hipSuccess) { fprintf(stderr, "kernel_launch: hipFuncSetAttribute failed\n"); grid = -1; return; }
        if (hipOccupancyMaxActiveBlocksPerMultiprocessor(&per_cu, (const void*)mk_fwd, 512, LDS_BYTES) != hipSuccess || per_cu < 1) fprintf(stderr, "kernel_launch: occupancy query reports %d\n", per_cu);
        (void)hipGetLastError();
        if (cus < 256) { fprintf(stderr, "kernel_launch: %d CUs; this kernel needs 256 co-resident workgroups (one per CU)\n", cus); grid = -1; return; }
        grid = 256;
    }
    if (grid < 0) return;
    if (hipMemsetAsync((char*)d_ws + WS_CTL, 0, CTL_ZERO_BYTES, stream) != hipSuccess) return;
    Args a{};
    for (int i = 0; i < 24; ++i) a.in[i] = (const float*)d_in[i];
    a.out = (float*)d_out; a.ws = (unsigned char*)d_ws;
#if MK_SPLIT
    for (int p = 0; p < NPHASE; ++p) {
        if (p >= 1 && p < NPHASE - 1) { const int l = (p - 1) / NPH_L, k = (p - 1) % NPH_L; if (k == 6 && !(l & 1)) continue; }
        a.ph_lo = p; a.ph_hi = p + 1;
        hipLaunchKernelGGL(mk_fwd, dim3(grid), dim3(512), LDS_BYTES, stream, a);
    }
#else
    a.ph_lo = 0; a.ph_hi = NPHASE;
    hipLaunchKernelGGL(mk_fwd, dim3(grid), dim3(512), LDS_BYTES, stream, a);
#endif
    const hipError_t le = hipPeekAtLastError();
    if (le != hipSuccess) fprintf(stderr, "kernel_launch: launch failed: %s\n", hipGetErrorName(le));
}
```

```cpp
#include <hip/hip_runtime.h>
#include <cstdio>
#include <cstdint>

#ifndef PROBE_DUP
#define PROBE_DUP 0
#endif
#ifndef PROBE_ABL
#define PROBE_ABL -1
#endif
#define PREPS(bit) (((PROBE_DUP >> (bit)) & 1) ? 2 : 1)
#ifndef F8_UP
#define F8_UP 2
#endif
#ifndef IN_I8
#define IN_I8 1
#endif
#ifndef PROBE_PMASK
#define PROBE_PMASK 0
#endif
#ifndef PROBE_NORM
#define PROBE_NORM 0
#endif
#ifndef MK_SPLIT
#define MK_SPLIT 0
#endif

constexpr int DM = 1024, NB = 8, SEQ = 2048, DEPTH = 4, M = NB * SEQ;
constexpr int INW = 2208, INP = 2304;
constexpr int C_DQ = 0, C_DK = 512, C_DV = 1024, C_MQ = 1536, C_MKV = 1920, C_KR = 2176;
constexpr int QR = 384, KVR = 256, NQ = 768, NKV = 1024;
constexpr int DFF = 2816, NEXP = 8;
constexpr int SLOTS = 34816;
constexpr float EPS = 1e-6f, LOG2E = 1.4426950408889634f;
constexpr float C2D = 0.125f * LOG2E;
constexpr float C2M = 0.10206207261596577f * LOG2E;
constexpr int F8_W_LOG2 = 7, F8_H_LOG2 = 4, F8_U_LOG2 = 2;
constexpr float WSCALE = 128.f, HSCALE = 16.f, USCALE = 4.f;
constexpr int NPH_L = 9, NPHASE = 2 + NPH_L * DEPTH;

constexpr size_t MiB = 1u << 20;
constexpr size_t WS_CTL = 0, CTL_ZERO_BYTES = 1 * MiB;
constexpr size_t WS_MOD = 1 * MiB;
constexpr size_t WS_CS = 2 * MiB;
constexpr size_t WS_ROWSS = 4 * MiB;
constexpr size_t WS_ROUTE = 6 * MiB;
constexpr size_t WS_GSLOT = 7 * MiB;
constexpr size_t WS_MISC = 7 * MiB + 512 * 1024;
constexpr size_t WS_WSC = WS_MISC + 65536;
constexpr size_t WS_WSC2 = WS_GSLOT + 400 * 1024;
constexpr size_t WS_ASL = WS_GSLOT + 256 * 1024;
constexpr size_t WS_WIN = 8 * MiB;
constexpr size_t WS_WUQ = 26 * MiB;
constexpr size_t WS_WUKV = 29 * MiB;
constexpr size_t WS_WO = 31 * MiB;
constexpr size_t WS_WD13 = 39 * MiB;
constexpr size_t WS_WD2 = 61 * MiB;
constexpr size_t WS_WM13 = 72 * MiB;
constexpr size_t WS_WM2 = 248 * MiB;
constexpr size_t WS_H = 336 * MiB;
constexpr size_t WS_ACT = 368 * MiB;
constexpr size_t WS_PROJ = WS_ACT;
constexpr size_t WS_QM = WS_ACT + 72 * MiB;
constexpr size_t WS_KN = WS_ACT + 96 * MiB;
constexpr size_t WS_VM = WS_ACT + 112 * MiB;
constexpr size_t WS_AO = WS_ACT + 128 * MiB;
constexpr size_t WS_STASH = WS_ACT + 160 * MiB;
constexpr size_t WS_U = WS_ACT;
constexpr size_t WS_HPERM = WS_ACT + 188 * MiB;
constexpr size_t WS_YP = WS_ACT + 256 * MiB;
constexpr size_t WS_XB = WS_ACT + 324 * MiB;
constexpr size_t WS_END = WS_XB + 32 * MiB;
constexpr int CW_TMO = 0, CW_CODE = 1;
constexpr int CW_BAR = 4096;
constexpr int CW_QCTR = 8192;
constexpr int CW_CNT = 8704;

constexpr int RING_BYTES = 131072, LDSCTL_OFF = RING_BYTES, MISC_OFF = LDSCTL_OFF + 320, LDS_BYTES = 147456;

#define GAS __attribute__((address_space(1)))
#define LAS __attribute__((address_space(3)))
typedef unsigned short bf16_t;
typedef short bf16x8 __attribute__((ext_vector_type(8)));
typedef short s16x4 __attribute__((ext_vector_type(4)));
typedef float f32x4 __attribute__((ext_vector_type(4)));
typedef float f32x2 __attribute__((ext_vector_type(2)));
typedef float f32x16 __attribute__((ext_vector_type(16)));
typedef unsigned u32x4 __attribute__((ext_vector_type(4)));
typedef unsigned u32x8 __attribute__((ext_vector_type(8)));
typedef unsigned u32x2 __attribute__((ext_vector_type(2)));
typedef GAS unsigned gu32;
#define RLX_AGENT __ATOMIC_RELAXED, __HIP_MEMORY_SCOPE_AGENT
#define LDS_WAIT() asm volatile("s_waitcnt lgkmcnt(0)" ::: "memory")
#define VM_WAIT() asm volatile("s_waitcnt vmcnt(0)" ::: "memory")

__device__ __forceinline__ unsigned cvt_pk_bf16(float lo, float hi) { unsigned r; asm volatile("v_cvt_pk_bf16_f32 %0, %1, %2" : "=v"(r) : "v"(lo), "v"(hi)); return r; }
__device__ __forceinline__ unsigned pk_fp8x4(float a, float b, float c, float d) {
    a = __builtin_amdgcn_fmed3f(a, -448.f, 448.f); b = __builtin_amdgcn_fmed3f(b, -448.f, 448.f); c = __builtin_amdgcn_fmed3f(c, -448.f, 448.f); d = __builtin_amdgcn_fmed3f(d, -448.f, 448.f);
    int w = 0; w = __builtin_amdgcn_cvt_pk_fp8_f32(a, b, w, false); w = __builtin_amdgcn_cvt_pk_fp8_f32(c, d, w, true); return (unsigned)w; }
__device__ __forceinline__ float bf_lo(unsigned w) { return __uint_as_float(w << 16); }
__device__ __forceinline__ float bf_hi(unsigned w) { return __uint_as_float(w & 0xffff0000u); }
template <int K> __device__ __forceinline__ float sx(float v) { return __int_as_float(__builtin_amdgcn_ds_swizzle(__float_as_int(v), (K << 10) | 0x1f)); }
__device__ __forceinline__ float x32_sum(float v) { auto rr = __builtin_amdgcn_permlane32_swap(__float_as_uint(v), __float_as_uint(v), false, false); return __uint_as_float(rr[0]) + __uint_as_float(rr[1]); }
__device__ __forceinline__ float wave_max(float v) { v = fmaxf(v, sx<1>(v)); v = fmaxf(v, sx<2>(v)); v = fmaxf(v, sx<4>(v)); v = fmaxf(v, sx<8>(v)); v = fmaxf(v, sx<16>(v));
    auto rr = __builtin_amdgcn_permlane32_swap(__float_as_uint(v), __float_as_uint(v), false, false); return fmaxf(__uint_as_float(rr[0]), __uint_as_float(rr[1])); }
__device__ __forceinline__ unsigned pk_i8x4(float a, float b, float c, float d) {
    const int ia = (int)__builtin_rintf(a), ib = (int)__builtin_rintf(b), ic = (int)__builtin_rintf(c), id = (int)__builtin_rintf(d);
    return (unsigned)(ia & 0xff) | ((unsigned)(ib & 0xff) << 8) | ((unsigned)(ic & 0xff) << 16) | ((unsigned)id << 24); }
__device__ __forceinline__ float wave_sum(float v) { v += sx<1>(v); v += sx<2>(v); v += sx<4>(v); v += sx<8>(v); v += sx<16>(v); return x32_sum(v); }


__device__ __forceinline__ int otid(int wv) { int l; asm volatile("v_mbcnt_lo_u32_b32 %0, -1, 0\n\tv_mbcnt_hi_u32_b32 %0, -1, %0" : "=v"(l)); return (wv << 6) | l; }
template <class T> __device__ __forceinline__ T* optr(T* p) { asm volatile("" : "+s"(p)); return p; }
__device__ __forceinline__ int osi(int v) { asm volatile("" : "+s"(v)); return v; }
typedef __attribute__((address_space(4))) const unsigned char* kptr_t;
__device__ __forceinline__ kptr_t okarg() { kptr_t p = (kptr_t)__builtin_amdgcn_kernarg_segment_ptr(); asm volatile("" : "+s"(p)); return p; }
typedef const float* cfp_t; typedef float* fp_t; typedef unsigned char* ucp_t;
typedef __attribute__((address_space(4))) const cfp_t* k_cfp; typedef __attribute__((address_space(4))) const fp_t* k_fp; typedef __attribute__((address_space(4))) const ucp_t* k_ucp; typedef __attribute__((address_space(4))) const int* k_int;
__device__ __forceinline__ const float* karg_in(kptr_t k, int i) { return (const float*)(GAS const float*)(*(k_cfp)(k + 8 * i)); }
__device__ __forceinline__ float* karg_out(kptr_t k) { return (float*)(GAS float*)(*(k_fp)(k + 192)); }
__device__ __forceinline__ unsigned char* karg_ws(kptr_t k) { return (unsigned char*)(GAS unsigned char*)(*(k_ucp)(k + 200)); }
__device__ __forceinline__ int karg_lo(kptr_t k) { return *(k_int)(k + 208); }
__device__ __forceinline__ int karg_hi(kptr_t k) { return *(k_int)(k + 212); }
namespace pg8 {
constexpr int BM = 256, BK = 64, HALF = 128, HTB = HALF * BK * 2, STAGE_BYTES = 8 * HTB, NXCD = 8, WGM = 8;
__host__ __device__ __forceinline__ int lds_byte(int r, int c) { const int st = (r >> 4) * 2 + (c >> 5), rr = r & 15, cc = c & 31, ob = rr * 64 + cc * 2; return st * 1024 + (ob ^ (((ob >> 9) & 1) << 5)); }
__host__ __device__ __forceinline__ void stage_rc(int b, int& R, int& C) { const int st = b / 1024, sb = b % 1024, swz = sb ^ (((sb >> 9) & 1) << 5); R = (st >> 1) * 16 + swz / 64; C = (st & 1) * 32 + (swz % 64) / 2; }
__host__ __device__ __forceinline__ int perm32(int rho) { const int n = rho >> 4, i = rho & 15; return 8 * (i >> 2) + 4 * n + (i & 3); }

struct Unit { int pm, pn, e; };
struct Gemm { const bf16_t* A; const bf16_t* Bt; int lda, ldb, K; size_t estride; };

struct GroupOrder {
    int nM, nN, nwg, G, c; const int* pexp;
    __device__ __forceinline__ void init(int nM_, int nN_, int G_, int c_, const int* pexp_) { nM = nM_; nN = nN_; nwg = nM * nN; G = G_; c = c_; pexp = pexp_; }
    __device__ __forceinline__ bool next(int i, Unit& u) const {
        const long L = (long)i * G + c; if (L >= nwg) return false;
        int wgid = (int)L; { const int q = nwg / NXCD, r = nwg % NXCD, xcd = wgid % NXCD, off = wgid / NXCD; wgid = (xcd < r ? xcd * (q + 1) : r * (q + 1) + (xcd - r) * q) + off; }
        const int nig = WGM * nN, gid = wgid / nig, fm = gid * WGM, gsz = (nM - fm) < WGM ? (nM - fm) : WGM;
        u.pm = fm + ((wgid % nig) % gsz); u.pn = (wgid % nig) / gsz;
        u.e = pexp ? __builtin_amdgcn_readfirstlane(pexp[u.pm]) : 0; return true;
    }
};

typedef int v8i32 __attribute__((ext_vector_type(8)));
typedef int i32x4 __attribute__((ext_vector_type(4)));
template <class Epi, bool ALIGN_EPI, int F8 = 0  , int SCA = 127, int SCB = 127>
__device__ __forceinline__ void gemm_phase(LAS unsigned char* lds, const Gemm g, const GroupOrder& S, const Epi& E, int wv) {
    const int tid = otid(wv), wid = wv, lane = tid & 63, wr = wid >> 2, wc = wid & 3, fr = lane & 15, fq = lane >> 4;
    const int nt = g.K / BK;
    unsigned voffA[2], voffB[2];
#pragma unroll
    for (int i = 0; i < 2; ++i) { int R, C; stage_rc(tid * 16 + i * 8192, R, C); const int Rb = Epi::PERM ? ((R & ~31) + perm32(R & 31)) : R;
        voffA[i] = (unsigned)(R * g.lda + C) * 2u; voffB[i] = (unsigned)(Rb * g.ldb + C) * 2u; }
    const size_t kstep = (size_t)(BK * 2);
    const size_t hstepA = (size_t)HALF * g.lda * 2, hstepB = (size_t)HALF * g.ldb * 2;
    const size_t tstepA = 2 * hstepA, tstepB = 2 * hstepB;
    const unsigned ldsw = (unsigned)wid * 1024u;
    const int aoff = lds_byte(wr * 64 + fr, fq * 8), boff = lds_byte(wc * 32 + fr, fq * 8);
#define PG8_SA(b, h) (((b) * 2 + (h)) * HTB)
#define PG8_SB(b, h) ((4 + (b) * 2 + (h)) * HTB)
#define PG8_STAGE(bufoff, gbase, voff) do { _Pragma("unroll") for (int _i = 0; _i < 2; ++_i) { unsigned _vo = (voff)[_i]; asm volatile("" : "+v"(_vo)); \
        __builtin_amdgcn_global_load_lds((const unsigned*)((const char*)(gbase) + _vo), (LAS unsigned*)(lds + (bufoff) + ldsw + _i * 8192), 16, 0, 0); } } while (0)
#define PG8_LD2(p) __builtin_shufflevector(*(const LAS u32x4*)(p), *(const LAS u32x4*)((p) + 1024), 0, 1, 2, 3, 4, 5, 6, 7)
#define PG8_LDA(dst, b, h) do { _Pragma("unroll") for (int m = 0; m < 4; ++m) dst[m] = PG8_LD2(lds + PG8_SA(b, h) + aoff + m * 2048); } while (0)
#define PG8_LDB(dst, b, h) do { _Pragma("unroll") for (int n = 0; n < 2; ++n) dst[n] = PG8_LD2(lds + PG8_SB(b, h) + boff + n * 2048); } while (0)
#define PG8_LO(x) __builtin_bit_cast(bf16x8, __builtin_shufflevector(x, x, 0, 1, 2, 3))
#define PG8_HI(x) __builtin_bit_cast(bf16x8, __builtin_shufflevector(x, x, 4, 5, 6, 7))
#define PG8_MMA(ai, bj, At, Bt) do { __builtin_amdgcn_s_setprio(1); _Pragma("unroll") for (int m = 0; m < 4; ++m) _Pragma("unroll") for (int n = 0; n < 2; ++n) { \
        if constexpr (F8 == 1) acc[ai][bj][m][n] = __builtin_amdgcn_mfma_scale_f32_16x16x128_f8f6f4(__builtin_bit_cast(v8i32, Bt[n]), __builtin_bit_cast(v8i32, At[m]), acc[ai][bj][m][n], 0, 0, 0, SCB, 0, SCA); \
        else if constexpr (F8 == 2) { i32x4 c_ = __builtin_bit_cast(i32x4, acc[ai][bj][m][n]); \
               c_ = __builtin_amdgcn_mfma_i32_16x16x64_i8(__builtin_bit_cast(i32x4, PG8_LO(Bt[n])), __builtin_bit_cast(i32x4, PG8_LO(At[m])), c_, 0, 0, 0); \
               c_ = __builtin_amdgcn_mfma_i32_16x16x64_i8(__builtin_bit_cast(i32x4, PG8_HI(Bt[n])), __builtin_bit_cast(i32x4, PG8_HI(At[m])), c_, 0, 0, 0); acc[ai][bj][m][n] = __builtin_bit_cast(f32x4, c_); } \
        else { acc[ai][bj][m][n] = __builtin_amdgcn_mfma_f32_16x16x32_bf16(PG8_LO(Bt[n]), PG8_LO(At[m]), acc[ai][bj][m][n], 0, 0, 0); \
               acc[ai][bj][m][n] = __builtin_amdgcn_mfma_f32_16x16x32_bf16(PG8_HI(Bt[n]), PG8_HI(At[m]), acc[ai][bj][m][n], 0, 0, 0); } } \
        __builtin_amdgcn_s_setprio(0); } while (0)
#define PG8_WAIT_V(n) asm volatile("s_waitcnt vmcnt(" #n ")" ::: "memory")
#define PG8_WAIT_L(n) asm volatile("s_waitcnt lgkmcnt(" #n ")" ::: "memory")
#define PG8_BAR __builtin_amdgcn_s_barrier()
#define PG8_SCHED __builtin_amdgcn_sched_barrier(0)
    Unit cur, nxt; int ui = 0;
    if (!S.next(0, cur)) return;
    f32x4 acc[2][2][4][2];
#pragma unroll
    for (int a = 0; a < 2; ++a)
#pragma unroll
        for (int b = 0; b < 2; ++b)
#pragma unroll
            for (int m = 0; m < 4; ++m)
#pragma unroll
                for (int n = 0; n < 2; ++n) acc[a][b][m][n] = (f32x4){0.f, 0.f, 0.f, 0.f};
    u32x8 At[4], B0[2], B1[2];
    const char* cA = (const char*)g.A + (size_t)cur.pm * tstepA; const char* cB = (const char*)g.Bt + ((size_t)cur.e * g.estride) * 2 + (size_t)cur.pn * tstepB;
    PG8_STAGE(PG8_SB(0, 0), cB, voffB); PG8_STAGE(PG8_SB(0, 1), cB + hstepB, voffB); PG8_STAGE(PG8_SA(0, 0), cA, voffA); PG8_STAGE(PG8_SA(0, 1), cA + hstepA, voffA);
    if (wr == 1) PG8_BAR;
    PG8_WAIT_V(2); PG8_BAR;
    PG8_STAGE(PG8_SB(1, 0), cB + kstep, voffB); PG8_STAGE(PG8_SA(1, 0), cA + kstep, voffA); PG8_STAGE(PG8_SB(1, 1), cB + hstepB + kstep, voffB);
    PG8_WAIT_V(6); PG8_BAR;
    for (;;) {
        const bool has_next = S.next(ui + 1, nxt);
        const char* nA = has_next ? (const char*)g.A + (size_t)nxt.pm * tstepA : cA;
        const char* nB = has_next ? (const char*)g.Bt + ((size_t)nxt.e * g.estride) * 2 + (size_t)nxt.pn * tstepB : cB;
#pragma clang loop unroll(disable)
        for (int t = 0; t < nt; t += 2) {
            const bool last = (t == nt - 2);
            const char* a1 = cA + (size_t)(t + 1) * kstep;
            const char* a2 = last ? nA : cA + (size_t)(t + 2) * kstep; const char* b2 = last ? nB : cB + (size_t)(t + 2) * kstep;
            const char* a3 = a2 + kstep; const char* b3 = b2 + kstep;
            PG8_LDB(B0, 0, 0); PG8_LDB(B1, 0, 1); PG8_SCHED; PG8_LDA(At, 0, 0); PG8_STAGE(PG8_SA(1, 1), a1 + hstepA, voffA);
            PG8_WAIT_V(8); PG8_WAIT_L(0); PG8_BAR; PG8_MMA(0, 0, At, B0); PG8_MMA(0, 1, At, B1); PG8_BAR; PG8_SCHED;
            PG8_LDA(At, 0, 1); PG8_STAGE(PG8_SB(0, 0), b2, voffB); PG8_STAGE(PG8_SB(0, 1), b2 + hstepB, voffB); PG8_STAGE(PG8_SA(0, 0), a2, voffA);
            PG8_WAIT_V(8); PG8_WAIT_L(0); PG8_BAR; PG8_MMA(1, 0, At, B0); PG8_MMA(1, 1, At, B1); PG8_BAR; PG8_SCHED;
            PG8_LDB(B0, 1, 0); PG8_LDB(B1, 1, 1); PG8_SCHED; PG8_LDA(At, 1, 0); PG8_STAGE(PG8_SA(0, 1), a2 + hstepA, voffA);
            PG8_WAIT_V(8); PG8_WAIT_L(0); PG8_BAR; PG8_MMA(0, 0, At, B0); PG8_MMA(0, 1, At, B1); PG8_BAR; PG8_SCHED;
            PG8_LDA(At, 1, 1); PG8_STAGE(PG8_SB(1, 0), b3, voffB); PG8_STAGE(PG8_SB(1, 1), b3 + hstepB, voffB); PG8_STAGE(PG8_SA(1, 0), a3, voffA);
            PG8_WAIT_V(8); PG8_WAIT_L(0); PG8_BAR; PG8_MMA(1, 0, At, B0); PG8_MMA(1, 1, At, B1); PG8_BAR; PG8_SCHED;
        }
        if constexpr (ALIGN_EPI) { if (wr == 0) PG8_BAR; }
        { const int l2 = otid(wv) & 63; E(acc, cur, wr, wc, l2 & 15, l2 >> 4); }
        if (!has_next) break;
#pragma unroll
        for (int a = 0; a < 2; ++a)
#pragma unroll
            for (int b = 0; b < 2; ++b)
#pragma unroll
                for (int m = 0; m < 4; ++m)
#pragma unroll
                    for (int n = 0; n < 2; ++n) acc[a][b][m][n] = (f32x4){0.f, 0.f, 0.f, 0.f};
        cur = nxt; cA = nA; cB = nB; ++ui;
        if constexpr (ALIGN_EPI) { if (wr == 1) PG8_BAR; }
    }
    PG8_WAIT_V(0);
    if constexpr (!ALIGN_EPI) { if (wr == 0) PG8_BAR; }
    PG8_BAR;
#undef PG8_SA
#undef PG8_SB
#undef PG8_STAGE
#undef PG8_LDA
#undef PG8_LDB
#undef PG8_MMA
#undef PG8_LO
#undef PG8_HI
#undef PG8_LD2
#undef PG8_WAIT_V
#undef PG8_WAIT_L
#undef PG8_BAR
#undef PG8_SCHED
}

__device__ __forceinline__ void st8(bf16_t* p, f32x4 v0, f32x4 v1) {
    u32x4 w; w.x = cvt_pk_bf16(v0[0], v0[1]); w.y = cvt_pk_bf16(v0[2], v0[3]); w.z = cvt_pk_bf16(v1[0], v1[1]); w.w = cvt_pk_bf16(v1[2], v1[3]); *(u32x4*)p = w; }
__device__ __forceinline__ void rope8(f32x4& v0, f32x4& v1, const float* cs8) {
    const f32x4 c0 = *(const f32x4*)cs8, c1 = *(const f32x4*)(cs8 + 4);
    const float a0 = v0[0] * c0[0] - v0[1] * c0[1], a1 = v0[1] * c0[0] + v0[0] * c0[1];
    const float a2 = v0[2] * c0[2] - v0[3] * c0[3], a3 = v0[3] * c0[2] + v0[2] * c0[3];
    const float b0 = v1[0] * c1[0] - v1[1] * c1[1], b1 = v1[1] * c1[0] + v1[0] * c1[1];
    const float b2 = v1[2] * c1[2] - v1[3] * c1[3], b3 = v1[3] * c1[2] + v1[2] * c1[3];
    v0 = (f32x4){a0, a1, a2, a3}; v1 = (f32x4){b0, b1, b2, b3};
}

template <bool I8>
struct EpiProj {
    static constexpr bool PERM = true;
    bf16_t* P; float* rowss; const float* cs; const float* asc; const float* wsc;
    __device__ __forceinline__ void operator()(const f32x4 (&acc)[2][2][4][2], const Unit& u, int wr, int wc, int fr, int fq) const {
        const int row0 = u.pm * BM + wr * 64 + fr;
        float sa[2][4];
        if (I8) {
#pragma unroll
            for (int ai = 0; ai < 2; ++ai)
#pragma unroll
                for (int m = 0; m < 4; ++m) sa[ai][m] = asc[row0 + ai * HALF + m * 16]; }
#pragma unroll
        for (int bj = 0; bj < 2; ++bj) {
            const int cg = u.pn * BM + bj * HALF + wc * 32, col0 = cg + 8 * fq;
            const float sc = (cg < C_DK) ? C2D : 1.f;
            f32x4 sw0, sw1; if (I8) { sw0 = *(const f32x4*)(wsc + col0) * sc; sw1 = *(const f32x4*)(wsc + col0 + 4) * sc; }
            const bool do_ss = (cg >= C_MQ && cg < C_KR), do_rope = (cg == C_KR);
#pragma unroll
            for (int ai = 0; ai < 2; ++ai)
#pragma unroll
                for (int m = 0; m < 4; ++m) {
                    const int row = row0 + ai * HALF + m * 16;
                    f32x4 v0, v1;
                    if (I8) { const i32x4 i0 = __builtin_bit_cast(i32x4, acc[ai][bj][m][0]), i1 = __builtin_bit_cast(i32x4, acc[ai][bj][m][1]);
                        v0 = (f32x4){(float)i0[0], (float)i0[1], (float)i0[2], (float)i0[3]} * sw0 * sa[ai][m]; v1 = (f32x4){(float)i1[0], (float)i1[1], (float)i1[2], (float)i1[3]} * sw1 * sa[ai][m]; }
                    else { v0 = acc[ai][bj][m][0] * sc; v1 = acc[ai][bj][m][1] * sc; }
                    if (do_ss) { float s = (v0[0] * v0[0] + v0[1] * v0[1]) + (v0[2] * v0[2] + v0[3] * v0[3]) + (v1[0] * v1[0] + v1[1] * v1[1]) + (v1[2] * v1[2] + v1[3] * v1[3]);
                        s += sx<16>(s); s = x32_sum(s); if (fq == 0) rowss[(size_t)row * 20 + ((cg - C_MQ) >> 5)] = s; }
                    if (do_rope) rope8(v0, v1, cs + (size_t)row * 32 + 8 * fq);
                    st8(P + (size_t)row * INP + col0, v0, v1);
                }
        }
    }
};
struct EpiQ {
    static constexpr bool PERM = true;
    bf16_t* Q; const float* rowss; const float* cs;
    __device__ __forceinline__ void operator()(const f32x4 (&acc)[2][2][4][2], const Unit& u, int wr, int wc, int fr, int fq) const {
        const int row0 = u.pm * BM + wr * 64 + fr;
#pragma unroll
        for (int ai = 0; ai < 2; ++ai)
#pragma unroll
            for (int m = 0; m < 4; ++m) {
                const int row = row0 + ai * HALF + m * 16;
                const f32x4* rp = (const f32x4*)(rowss + (size_t)row * 20);
                const f32x4 s0 = rp[0], s1 = rp[1], s2 = rp[2];
                const float ss = ((s0[0] + s0[1]) + (s0[2] + s0[3])) + ((s1[0] + s1[1]) + (s1[2] + s1[3])) + ((s2[0] + s2[1]) + (s2[2] + s2[3]));
                const float rs = __builtin_amdgcn_rsqf(ss * (1.f / QR) + EPS) * C2M;
#pragma unroll
                for (int bj = 0; bj < 2; ++bj) {
                    const int cg = u.pn * BM + bj * HALF + wc * 32, col0 = cg + 8 * fq;
                    f32x4 v0 = acc[ai][bj][m][0] * rs, v1 = acc[ai][bj][m][1] * rs;
                    if ((cg % 96) == 64) rope8(v0, v1, cs + (size_t)row * 32 + 8 * fq);
                    st8(Q + (size_t)row * NQ + col0, v0, v1);
                }
            }
    }
};
struct EpiKV {
    static constexpr bool PERM = true;
    bf16_t* Kn; bf16_t* Vm; const float* rowss;
    __device__ __forceinline__ void operator()(const f32x4 (&acc)[2][2][4][2], const Unit& u, int wr, int wc, int fr, int fq) const {
        const int row0 = u.pm * BM + wr * 64 + fr;
        bf16_t* base = (u.pn < 2) ? Kn : Vm; const int colt = (u.pn & 1) * BM;
#pragma unroll
        for (int ai = 0; ai < 2; ++ai)
#pragma unroll
            for (int m = 0; m < 4; ++m) {
                const int row = row0 + ai * HALF + m * 16;
                const f32x4* rp = (const f32x4*)(rowss + (size_t)row * 20 + 12);
                const f32x4 s0 = rp[0], s1 = rp[1];
                const float ss = ((s0[0] + s0[1]) + (s0[2] + s0[3])) + ((s1[0] + s1[1]) + (s1[2] + s1[3]));
                const float rs = __builtin_amdgcn_rsqf(ss * (1.f / KVR) + EPS);
#pragma unroll
                for (int bj = 0; bj < 2; ++bj) {
                    const int col0 = colt + bj * HALF + wc * 32 + 8 * fq;
                    st8(base + (size_t)row * 512 + col0, acc[ai][bj][m][0] * rs, acc[ai][bj][m][1] * rs);
                }
            }
    }
};
struct EpiRes {
    static constexpr bool PERM = true;
    const float* base32; const bf16_t* base16; bf16_t* out; const float* gate;
    __device__ __forceinline__ void operator()(const f32x4 (&acc)[2][2][4][2], const Unit& u, int wr, int wc, int fr, int fq) const {
        const int row0 = u.pm * BM + wr * 64 + fr; const float* gp = gate + (size_t)(u.pm >> 3) * 6144;
#pragma unroll
        for (int bj = 0; bj < 2; ++bj) {
            const int col = u.pn * BM + bj * HALF + wc * 32 + 8 * fq;
            const f32x4 g0 = *(const f32x4*)(gp + col) + 1.0f, g1 = *(const f32x4*)(gp + col + 4) + 1.0f;
#pragma unroll
            for (int ai = 0; ai < 2; ++ai)
#pragma unroll
                for (int m = 0; m < 4; ++m) { const size_t off = (size_t)(row0 + ai * HALF + m * 16) * DM + col;
                    f32x4 b0, b1;
                    if (base32) { b0 = *(const f32x4*)(base32 + off); b1 = *(const f32x4*)(base32 + off + 4); }
                    else { const u32x4 w = *(const u32x4*)(base16 + off); b0 = (f32x4){bf_lo(w.x), bf_hi(w.x), bf_lo(w.y), bf_hi(w.y)}; b1 = (f32x4){bf_lo(w.z), bf_hi(w.z), bf_lo(w.w), bf_hi(w.w)}; }
                    st8(out + off, b0 + g0 * acc[ai][bj][m][0], b1 + g1 * acc[ai][bj][m][1]); }
        }
    }
};
template <bool I8>
struct EpiSwiGLU {
    static constexpr bool PERM = true;
    unsigned char* U;
    int dummy;
    const float* asc; const float* wsc;
    __device__ __forceinline__ void operator()(const f32x4 (&acc)[2][2][4][2], const Unit& u, int wr, int wc, int fr, int fq) const {
        if (dummy) return;
        const int row0 = u.pm * BM + wr * 64 + fr, col0 = u.pn * HALF + wc * 32 + 8 * fq;
        f32x4 sw[2][2];
        if (I8) { const float* wp = wsc + (size_t)u.e * (2 * DFF) + u.pn * BM + wc * 32 + 8 * fq;
#pragma unroll
            for (int bj = 0; bj < 2; ++bj) { sw[bj][0] = *(const f32x4*)(wp + bj * HALF); sw[bj][1] = *(const f32x4*)(wp + bj * HALF + 4); } }
#pragma unroll
        for (int ai = 0; ai < 2; ++ai)
#pragma unroll
            for (int m = 0; m < 4; ++m) {
                const int row = row0 + ai * HALF + m * 16;
                float sa = 1.f; if (I8) sa = asc[row];
                f32x4 r[2];
#pragma unroll
                for (int n = 0; n < 2; ++n) { f32x4 a = acc[ai][0][m][n], b = acc[ai][1][m][n];
                    if (I8) { const i32x4 ia = __builtin_bit_cast(i32x4, a), ib = __builtin_bit_cast(i32x4, b);
                        a = (f32x4){(float)ia[0], (float)ia[1], (float)ia[2], (float)ia[3]} * sw[0][n] * sa; b = (f32x4){(float)ib[0], (float)ib[1], (float)ib[2], (float)ib[3]} * sw[1][n] * sa; }
#pragma unroll
                    for (int k = 0; k < 4; ++k) { const float e = __builtin_amdgcn_exp2f(-a[k] * LOG2E); r[n][k] = a[k] * __builtin_amdgcn_rcpf(1.f + e) * b[k] * USCALE; } }
                u32x2 w; w.x = pk_fp8x4(r[0][0], r[0][1], r[0][2], r[0][3]); w.y = pk_fp8x4(r[1][0], r[1][1], r[1][2], r[1][3]);
                *(u32x2*)(U + (size_t)row * DFF + col0) = w;
            }
    }
};
struct EpiDown {
    static constexpr bool PERM = true;
    bf16_t* Y; const float* gslot;
    __device__ __forceinline__ void operator()(const f32x4 (&acc)[2][2][4][2], const Unit& u, int wr, int wc, int fr, int fq) const {
        const int row0 = u.pm * BM + wr * 64 + fr;
#pragma unroll
        for (int ai = 0; ai < 2; ++ai)
#pragma unroll
            for (int m = 0; m < 4; ++m) {
                const int row = row0 + ai * HALF + m * 16; const float gv = gslot ? gslot[row] : 1.f;
#pragma unroll
                for (int bj = 0; bj < 2; ++bj) st8(Y + (size_t)row * DM + u.pn * BM + bj * HALF + wc * 32 + 8 * fq, acc[ai][bj][m][0] * gv, acc[ai][bj][m][1] * gv);
            }
    }
};
}

namespace att {
constexpr int NSLOT = 4, KBMAX = 12288, VBMAX = 16384;
constexpr int OFF_V = NSLOT * KBMAX, OFF_WS = OFF_V + NSLOT * VBMAX, OFF_LUT = OFF_WS + 8 * 256, OFF_Q = OFF_LUT + 512;
static_assert(OFF_Q + 16 <= RING_BYTES, "attention LDS map");
__device__ __forceinline__ void glds16(const void* gsrc, unsigned lds_dst) { unsigned keep;
    asm volatile("s_mov_b32 %0, m0\n\ts_mov_b32 m0, %2\n\ts_nop 0\n\tglobal_load_lds_dwordx4 %1, off\n\ts_mov_b32 m0, %0" : "=&s"(keep) : "v"(gsrc), "s"(lds_dst) : "memory"); }
constexpr float THR = 8.f;
#define SBAR() __builtin_amdgcn_sched_barrier(0)
__device__ __forceinline__ int crow(int r, int hi) { return (r & 3) + 8 * (r >> 2) + 4 * hi; }
template <int DV> __device__ __forceinline__ int v_st(int k, int c) { const int kk = (k & ~0xC) | ((k & 4) << 1) | ((k & 8) >> 1); return ((kk >> 3) * (DV / 32) + (c >> 5)) * 512 + ((kk & 7) * 32 + (c & 31)) * 2; }
__device__ __forceinline__ int v_rd_base(int lane) { return ((lane & 3) << 3) | (((lane >> 2) & 3) << 6) | (((lane >> 4) & 1) << 5) | (((lane >> 5) & 1) << 8); }
template <int DV> constexpr int v_rd_off(int d0, int ks, int half) { return ((2 * ks + half) * (DV / 32) + d0) * 512; }
template <int OFF> __device__ __forceinline__ s16x4 tr_read(int vb) { s16x4 r; asm volatile("ds_read_b64_tr_b16 %0, %1 offset:%2" : "=&v"(r) : "v"(vb), "i"(OFF) : "memory"); return r; }
template <int DV, int D0> __device__ __forceinline__ void pv_one(f32x16& od, int vb, bf16x8 pa0, bf16x8 pa1, bf16x8 pa2, bf16x8 pa3) {
    const s16x4 l0 = tr_read<v_rd_off<DV>(D0, 0, 0)>(vb), h0 = tr_read<v_rd_off<DV>(D0, 0, 1)>(vb), l1 = tr_read<v_rd_off<DV>(D0, 1, 0)>(vb), h1 = tr_read<v_rd_off<DV>(D0, 1, 1)>(vb);
    const s16x4 l2 = tr_read<v_rd_off<DV>(D0, 2, 0)>(vb), h2 = tr_read<v_rd_off<DV>(D0, 2, 1)>(vb), l3 = tr_read<v_rd_off<DV>(D0, 3, 0)>(vb), h3 = tr_read<v_rd_off<DV>(D0, 3, 1)>(vb);
    asm volatile("s_waitcnt lgkmcnt(0)" ::: "memory"); SBAR();
#define PK(L, H) (bf16x8){L[0], L[1], L[2], L[3], H[0], H[1], H[2], H[3]}
    od = __builtin_amdgcn_mfma_f32_32x32x16_bf16(pa0, PK(l0, h0), od, 0, 0, 0);
    od = __builtin_amdgcn_mfma_f32_32x32x16_bf16(pa1, PK(l1, h1), od, 0, 0, 0);
    od = __builtin_amdgcn_mfma_f32_32x32x16_bf16(pa2, PK(l2, h2), od, 0, 0, 0);
    od = __builtin_amdgcn_mfma_f32_32x32x16_bf16(pa3, PK(l3, h3), od, 0, 0, 0);
#undef PK
}
template <int DV, int KS_, int D0> __device__ __forceinline__ void pv_rd(s16x4 (&lo)[DV / 32], s16x4 (&hi)[DV / 32], int vb) {
    lo[D0] = tr_read<v_rd_off<DV>(D0, KS_, 0)>(vb); hi[D0] = tr_read<v_rd_off<DV>(D0, KS_, 1)>(vb);
    if constexpr (D0 + 1 < DV / 32) pv_rd<DV, KS_, D0 + 1>(lo, hi, vb);
}
template <int DV> __device__ __forceinline__ void pv_all(f32x16 (&o)[DV / 32], f32x16& lacc, int vb, bf16x8 pa0, bf16x8 pa1, bf16x8 pa2, bf16x8 pa3) {
    constexpr int NO = DV / 32;
    const bf16x8 ones = {0x3F80, 0x3F80, 0x3F80, 0x3F80, 0x3F80, 0x3F80, 0x3F80, 0x3F80};
    s16x4 la[NO], ha[NO], lb[NO], hb[NO];
#define PK(L, H) (bf16x8){L[0], L[1], L[2], L[3], H[0], H[1], H[2], H[3]}
#define PVW(n) do { if (n == 8) asm volatile("s_waitcnt lgkmcnt(8)" ::: "memory"); else if (n == 4) asm volatile("s_waitcnt lgkmcnt(4)" ::: "memory"); else asm volatile("s_waitcnt lgkmcnt(0)" ::: "memory"); SBAR(); } while (0)
    pv_rd<DV, 0, 0>(la, ha, vb); pv_rd<DV, 1, 0>(lb, hb, vb); PVW(2 * NO);
#pragma unroll
    for (int d = 0; d < NO; ++d) o[d] = __builtin_amdgcn_mfma_f32_32x32x16_bf16(pa0, PK(la[d], ha[d]), o[d], 0, 0, 0);
    lacc = __builtin_amdgcn_mfma_f32_32x32x16_bf16(pa0, ones, lacc, 0, 0, 0);
    SBAR(); pv_rd<DV, 2, 0>(la, ha, vb); PVW(2 * NO);
#pragma unroll
    for (int d = 0; d < NO; ++d) o[d] = __builtin_amdgcn_mfma_f32_32x32x16_bf16(pa1, PK(lb[d], hb[d]), o[d], 0, 0, 0);
    lacc = __builtin_amdgcn_mfma_f32_32x32x16_bf16(pa1, ones, lacc, 0, 0, 0);
    SBAR(); pv_rd<DV, 3, 0>(lb, hb, vb); PVW(2 * NO);
#pragma unroll
    for (int d = 0; d < NO; ++d) o[d] = __builtin_amdgcn_mfma_f32_32x32x16_bf16(pa2, PK(la[d], ha[d]), o[d], 0, 0, 0);
    lacc = __builtin_amdgcn_mfma_f32_32x32x16_bf16(pa2, ones, lacc, 0, 0, 0);
    PVW(0);
#pragma unroll
    for (int d = 0; d < NO; ++d) o[d] = __builtin_amdgcn_mfma_f32_32x32x16_bf16(pa3, PK(lb[d], hb[d]), o[d], 0, 0, 0);
    lacc = __builtin_amdgcn_mfma_f32_32x32x16_bf16(pa3, ones, lacc, 0, 0, 0);
#undef PK
#undef PVW
}
__device__ __forceinline__ int rel_bucket(int n) {
    if (n < 16) return n;
    const int v = 16 + (int)(logf((float)n * (1.f / 16.f)) * (16.f / 2.0794415416798357f));
    return v < 31 ? v : 31;
}

template <int DQK, int DV, bool BIAS, int ABL = 0>
__device__ __forceinline__ void attn_core(const bf16_t* __restrict__ Qp, const bf16_t* __restrict__ K1, int ldk1, const bf16_t* __restrict__ K2, int ldk2,
                                          const bf16_t* __restrict__ Vp, int ldv, const int* __restrict__ posb, int posq, int qfirst, int qidx, int NT,
                                          const int* __restrict__ kmaxb, int qmin_w, float bias_far, LAS unsigned char* lds, int tid, int wid, int lane,
                                          f32x16 (&o)[DV / 32], f32x16& lacc) {
    constexpr int KB = 8 * DQK * 16, VB = 64 * DV * 2, ND = DQK / 16, NO = DV / 32, NVP = DV / 64;
    const int r32 = lane & 31, hi = lane >> 5, grp = wid >> 2;
    LAS unsigned char* Kl = lds; LAS unsigned char* Vl = lds + OFF_V;
    LAS float* wsc = (LAS float*)(lds + OFF_WS) + wid * 64; const LAS float* lut = (const LAS float*)(lds + OFF_LUT);
    bf16x8 qr[ND];
#pragma unroll
    for (int d0 = 0; d0 < ND; ++d0) qr[d0] = *(const bf16x8*)(Qp + d0 * 16 + hi * 8);
    float m_reg = 0.f; lacc = f32x16{};
    const u32x4 kxu = {hi == 0 ? 0xBF80BF80u : 0u, 0u, 0u, 0u}; const bf16x8 kx = __builtin_bit_cast(bf16x8, kxu);
#pragma unroll
    for (int d = 0; d < NO; ++d) o[d] = f32x16{};
    const bf16_t* ksrc = K1 + (size_t)lane * ldk1 + wid * 8;
    const bf16_t* ksrc2 = (DQK == 96) ? K2 + (size_t)lane * ldk2 + (wid & 3) * 8 : nullptr;
    const bf16_t* vsrc[NVP]; unsigned vdst[NVP];
#pragma unroll
    for (int q = 0; q < NVP; ++q) { const int p = wid * NVP + q, s = 2 * p + (lane >> 5), kk = 8 * (s / (DV / 32)) + ((lane & 31) >> 2), c = 32 * (s % (DV / 32)) + 8 * (lane & 3);
        const int k = (kk & ~0xC) | ((kk & 4) << 1) | ((kk & 8) >> 1);
        vsrc[q] = Vp + (size_t)k * ldv + c; vdst[q] = (unsigned)(uintptr_t)Vl + p * 1024; }
    const unsigned kdst = (unsigned)(uintptr_t)Kl + wid * 1024, kdst2 = (unsigned)(uintptr_t)Kl + (8 + (wid & 3)) * 1024;
    const int vb0 = (int)(unsigned)(uintptr_t)Vl + v_rd_base(lane);
#define RFL(x) ((unsigned)__builtin_amdgcn_readfirstlane((int)(x)))
#define DMA_K(t) do { if (ABL & 8) break; const int t_ = (t) < NT ? (t) : NT - 1; glds16(ksrc + (size_t)t_ * 64 * ldk1, RFL(kdst + ((t) & 3) * KB)); \
        if (DQK == 96) { if (grp == 0) glds16(ksrc2 + (size_t)t_ * 64 * ldk2, RFL(kdst2 + ((t) & 3) * KB)); } } while (0)
#define DMA_V(t) do { if (ABL & 8) break; const int t_ = (t) < NT ? (t) : NT - 1; _Pragma("unroll") for (int q = 0; q < NVP; ++q) glds16(vsrc[q] + (size_t)t_ * 64 * ldv, RFL(vdst[q] + ((t) & 3) * VB)); } while (0)
#define WAITBAR_G0() do { if (DQK == 96) asm volatile("s_waitcnt vmcnt(6) lgkmcnt(0)\n\ts_barrier" ::: "memory"); else if (NVP == 2) asm volatile("s_waitcnt vmcnt(6) lgkmcnt(0)\n\ts_barrier" ::: "memory"); \
        else asm volatile("s_waitcnt vmcnt(4) lgkmcnt(0)\n\ts_barrier" ::: "memory"); } while (0)
#define WAITBAR_G1() do { if (DQK == 96) asm volatile("s_waitcnt vmcnt(2) lgkmcnt(0)\n\ts_barrier" ::: "memory"); else if (NVP == 2) asm volatile("s_waitcnt vmcnt(3) lgkmcnt(0)\n\ts_barrier" ::: "memory"); \
        else asm volatile("s_waitcnt vmcnt(2) lgkmcnt(0)\n\ts_barrier" ::: "memory"); } while (0)
#define PBAR() asm volatile("s_waitcnt lgkmcnt(0)\n\ts_barrier" ::: "memory")
#define QKT(t) do { if (ABL & 4) { _Pragma("unroll") for (int r = 0; r < 16; ++r) { p0[r] = 0.f; p1[r] = 0.f; } break; } const LAS unsigned char* Kc = Kl + ((t) & 3) * KB + hi * 1024 + r32 * 16; \
        bool far_ = false; if (BIAS) far_ = (qmin_w - kmaxb[t]) >= 113; isfar = far_; \
          \
        { const float me = m_reg - ((BIAS && far_) ? bias_far : 0.f); const unsigned bh = cvt_pk_bf16(me, 0.f) & 0xffffu; const unsigned bl = cvt_pk_bf16(me - __uint_as_float(bh << 16), 0.f) & 0xffffu; \
          const u32x4 qx = {hi == 0 ? (bh | (bl << 16)) : 0u, 0u, 0u, 0u}; \
          p0 = __builtin_amdgcn_mfma_f32_32x32x16_bf16(kx, __builtin_bit_cast(bf16x8, qx), f32x16{}, 0, 0, 0); p1 = __builtin_amdgcn_mfma_f32_32x32x16_bf16(kx, __builtin_bit_cast(bf16x8, qx), f32x16{}, 0, 0, 0); } \
        _Pragma("unroll") for (int d0 = 0; d0 < ND; ++d0) { \
            const bf16x8 b0 = *(const LAS bf16x8*)(Kc + d0 * 2048), b1 = *(const LAS bf16x8*)(Kc + d0 * 2048 + 512); \
            p0 = __builtin_amdgcn_mfma_f32_32x32x16_bf16(b0, qr[d0], p0, 0, 0, 0); p1 = __builtin_amdgcn_mfma_f32_32x32x16_bf16(b1, qr[d0], p1, 0, 0, 0); } } while (0)
    f32x16 p0, p1; bool isfar = false; bf16x8 pa0, pa1, pa2, pa3;
    DMA_K(0); DMA_V(0); DMA_K(1); DMA_V(1); DMA_K(2);
    asm volatile("s_waitcnt vmcnt(0) lgkmcnt(0)\n\ts_barrier" ::: "memory");
    if (grp) PBAR();
    if (0 <= qfirst + 31) QKT(0);
    if (grp) WAITBAR_G1(); else PBAR();
    for (int i = 0; i < ((ABL & 16) ? 0 : NT); ++i) {
        const int kv0 = i * 64; const bool act = kv0 <= qfirst + 31;
        DMA_K(i + 3); DMA_V(i + 2);
        if (act && (ABL & 1)) { pa0 = __builtin_bit_cast(bf16x8, (f32x4){p0[0], p0[1], p0[2], p0[3]}); pa1 = __builtin_bit_cast(bf16x8, (f32x4){p0[4], p0[5], p0[6], p0[7]}); pa2 = __builtin_bit_cast(bf16x8, (f32x4){p1[0], p1[1], p1[2], p1[3]}); pa3 = __builtin_bit_cast(bf16x8, (f32x4){p1[4], p1[5], p1[6], p1[7]});
#pragma unroll
            for (int r = 0; r < 16; ++r) lacc[r] = 1.f; }
        if (act && !(ABL & 1)) {
            if (BIAS) { if (!isfar) {
                GAS const int* pb = (GAS const int*)(posb + kv0 + 4 * hi); asm volatile("" : "+v"(pb));
#pragma unroll
                for (int r = 0; r < 16; ++r) {
                    const int cr = (r & 3) + 8 * (r >> 2);
                    int d0_ = posq - pb[cr]; d0_ = d0_ < 0 ? 0 : (d0_ > 127 ? 127 : d0_);
                    int d1_ = posq - pb[cr + 32]; d1_ = d1_ < 0 ? 0 : (d1_ > 127 ? 127 : d1_);
                    p0[r] += lut[d0_]; p1[r] += lut[d1_]; } } }
            if (kv0 + 63 > qfirst) {
                int lim = qidx - kv0 - 4 * hi; asm volatile("" : "+v"(lim));
#pragma unroll
                for (int r = 0; r < 16; ++r) { const int cr = (r & 3) + 8 * (r >> 2); if (cr > lim) p0[r] = -INFINITY; if (cr + 32 > lim) p1[r] = -INFINITY; }
            }
            float pmax = p0[0];
#pragma unroll
            for (int r = 1; r < 16; ++r) pmax = fmaxf(pmax, p0[r]);
#pragma unroll
            for (int r = 0; r < 16; ++r) pmax = fmaxf(pmax, p1[r]);
            { auto rr = __builtin_amdgcn_permlane32_swap(__float_as_uint(pmax), __float_as_uint(pmax), false, false); pmax = fmaxf(__uint_as_float(rr[0]), __uint_as_float(rr[1])); }
            float alpha = 1.f;
            if (i == 0 || !__all(pmax <= THR)) { const float dl = (i == 0) ? pmax : fmaxf(pmax, 0.f); m_reg += dl; alpha = (i == 0) ? 1.f : __builtin_amdgcn_exp2f(-dl);
#pragma unroll
                for (int r = 0; r < 16; ++r) { p0[r] -= dl; p1[r] -= dl; } }
#pragma unroll
            for (int r = 0; r < 16; ++r) { p0[r] = __builtin_amdgcn_exp2f(p0[r]); p1[r] = __builtin_amdgcn_exp2f(p1[r]); }
            if (__any(alpha < 1.f)) { if (hi == 0) wsc[r32] = alpha; asm volatile("s_waitcnt lgkmcnt(0)" ::: "memory");
                const LAS float* wb = wsc + 4 * hi; asm volatile("" : "+v"(wb));
#pragma unroll
                for (int r = 0; r < 16; ++r) { const float a = wb[(r & 3) + 8 * (r >> 2)]; lacc[r] *= a;
#pragma unroll
                    for (int d = 0; d < NO; ++d) o[d][r] *= a; }
                asm volatile("s_waitcnt lgkmcnt(0)" ::: "memory"); }
#define PK4(P, BASE, OUT) do { unsigned a0 = cvt_pk_bf16(P[BASE + 0], P[BASE + 1]), a1 = cvt_pk_bf16(P[BASE + 2], P[BASE + 3]);   \
    unsigned b0 = cvt_pk_bf16(P[BASE + 4], P[BASE + 5]), b1 = cvt_pk_bf16(P[BASE + 6], P[BASE + 7]);                              \
    auto r0 = __builtin_amdgcn_permlane32_swap(a0, b0, false, false); auto r1 = __builtin_amdgcn_permlane32_swap(a1, b1, false, false); \
    u32x4 w = {r0[0], r1[0], r0[1], r1[1]}; OUT = __builtin_bit_cast(bf16x8, w); } while (0)
            PK4(p0, 0, pa0); PK4(p0, 8, pa1); PK4(p1, 0, pa2); PK4(p1, 8, pa3);
#undef PK4
        }
        if (grp) PBAR(); else WAITBAR_G0();
        if (act) {
            const int vb = vb0 + (i & 3) * VB;
            if (!(ABL & 2)) pv_all<DV>(o, lacc, vb, pa0, pa1, pa2, pa3);
        }
        if (i + 1 < NT && kv0 + 64 <= qfirst + 31) QKT(i + 1);
        if (grp) WAITBAR_G1(); else PBAR();
    }
    asm volatile("s_waitcnt vmcnt(0)" ::: "memory");
    if (!grp) PBAR();
    PBAR();
#undef RFL
#undef DMA_K
#undef DMA_V
#undef WAITBAR_G0
#undef WAITBAR_G1
#undef PBAR
#undef QKT
}

__device__ __forceinline__ bool decode_unit(int idx, int& type, int& qb, int& bh) {
    constexpr int NCLS = 16;
    constexpr int ctype[NCLS] = {0, 0, 0, 0, 0, 1, 0, 1, 1, 1, 0, 1, 1, 0, 1, 1};
    constexpr int cqb[NCLS]   = {7, 6, 5, 4, 3, 7, 2, 6, 5, 4, 1, 3, 2, 0, 1, 0};
    int start = 0; bool found = false;
#pragma unroll
    for (int c = 0; c < NCLS; ++c) { const int n = ctype[c] ? 64 : 32; if (!found && idx < start + n) { type = ctype[c]; qb = cqb[c]; bh = idx - start; found = true; } start += n; }
    return found;
}
constexpr int NUNITS = 768;

struct AttnArgs { const int* bkt; const bf16_t* proj; const bf16_t* qm; const bf16_t* kn; const bf16_t* vm; bf16_t* ao; float* stash; const int* pos; const int* kmax; const int* qmin;
                  const float* rel_bias; const float* subln_g; float lam, lam_init; };

template <int ABL = 0>
__device__ __forceinline__ void attn_phase(LAS unsigned char* lds, const AttnArgs& A, gu32* qctr, int wv) {
    const int wid = wv;
    LAS float* wsc = (LAS float*)(lds + OFF_WS) + wid * 64; LAS float* lut = (LAS float*)(lds + OFF_LUT); volatile LAS int* qw = (volatile LAS int*)(lds + OFF_Q);
    if (wid >= 4) __builtin_amdgcn_s_setprio(1);
    for (;;) {
        const int tid = otid(wv), lane = tid & 63, r32 = lane & 31, hi = lane >> 5;
        if (tid == 0) qw[0] = (int)__hip_atomic_fetch_add(qctr, 1u, RLX_AGENT);
        __syncthreads();
        const int idx = qw[0];
        __syncthreads();
        if (idx >= NUNITS) break;
        int type = 0, qb = 0, bh = 0; decode_unit(idx, type, qb, bh);
        const int q0 = qb * 256, NT = (q0 + 256) / 64, qfirst = q0 + wid * 32, qidx = qfirst + r32;
        if (type == 0) {
            const int b = bh >> 2, h = bh & 3; const size_t rowbase = (size_t)b * SEQ;
            const int* posb = A.pos + b * SEQ; const int posq = posb[qidx]; const int qmin_w = A.qmin[b * 64 + (qfirst >> 5)];
            if (tid < 128) { const float bv = A.rel_bias[A.bkt[tid] * 4 + h] * LOG2E; lut[otid(wv)] = bv; }
            const float bias_far = A.rel_bias[31 * 4 + h] * LOG2E;
            __syncthreads();
            float* st = A.stash + (size_t)blockIdx.x * 32768;
            for (int mp = 0; mp < 2; ++mp) {
                f32x16 o[4]; f32x16 l;
                attn_core<64, 128, true, ABL>(A.proj + (rowbase + qidx) * INP + C_DQ + h * 128 + mp * 64, A.proj + rowbase * INP + C_DK + h * 128 + mp * 64, INP, nullptr, 0,
                                         A.proj + rowbase * INP + C_DV + h * 128, INP, posb, posq, qfirst, qidx, NT, A.kmax + b * 32, qmin_w, bias_far, lds, tid, wid, lane, o, l);
                float rli[16];
#pragma unroll
                for (int r = 0; r < 16; ++r) rli[r] = __builtin_amdgcn_rcpf(l[r]);
                GAS float* stp = (GAS float*)(st + tid); asm volatile("" : "+v"(stp));
                if (mp == 0) {
#pragma unroll
                    for (int d = 0; d < 4; ++d)
#pragma unroll
                        for (int r = 0; r < 16; ++r) stp[(d * 16 + r) * 512] = o[d][r] * rli[r];
                } else {
                    const float lam = A.lam, post = 1.f - A.lam_init;
                    float gv[4];
#pragma unroll
                    for (int d = 0; d < 4; ++d) gv[d] = A.subln_g[d * 32 + r32] * post;
                    GAS bf16_t* aop = (GAS bf16_t*)(A.ao + (rowbase + qfirst + 4 * hi) * DM + h * 128 + r32); asm volatile("" : "+v"(aop));
#pragma unroll
                    for (int r = 0; r < 16; ++r) {
                        float v[4], ss = 0.f;
#pragma unroll
                        for (int d = 0; d < 4; ++d) { v[d] = stp[(d * 16 + r) * 512] - lam * (o[d][r] * rli[r]); ss += v[d] * v[d]; }
                        ss += sx<1>(ss); ss += sx<2>(ss); ss += sx<4>(ss); ss += sx<8>(ss); ss += sx<16>(ss);
                        const float rn = __builtin_amdgcn_rsqf(ss * (1.f / 128.f) + EPS);
                        GAS bf16_t* op = aop + (size_t)((r & 3) + 8 * (r >> 2)) * DM;
#pragma unroll
                        for (int d = 0; d < 4; ++d) op[d * 32] = (bf16_t)(cvt_pk_bf16(v[d] * rn * gv[d], 0.f) & 0xffffu);
                    }
                }
            }
        } else {
            const int b = bh >> 3, h = bh & 7; const size_t rowbase = (size_t)b * SEQ;
            f32x16 o[2]; f32x16 l;
            attn_core<96, 64, false, ABL>(A.qm + (rowbase + qidx) * NQ + h * 96, A.kn + rowbase * 512 + h * 64, 512, A.proj + rowbase * INP + C_KR, INP,
                                     A.vm + rowbase * 512 + h * 64, 512, nullptr, 0, qfirst, qidx, NT, nullptr, 0, 0.f, lds, tid, wid, lane, o, l);
            GAS bf16_t* aop = (GAS bf16_t*)(A.ao + (rowbase + qfirst + 4 * hi) * DM + 512 + h * 64 + r32); asm volatile("" : "+v"(aop));
#pragma unroll
            for (int r = 0; r < 16; ++r) { const float rl = __builtin_amdgcn_rcpf(l[r]);
                GAS bf16_t* op = aop + (size_t)((r & 3) + 8 * (r >> 2)) * DM;
#pragma unroll
                for (int d = 0; d < 2; ++d) op[d * 32] = (bf16_t)(cvt_pk_bf16(o[d][r] * rl, 0.f) & 0xffffu); }
            asm volatile("s_waitcnt lgkmcnt(0)" ::: "memory");
        }
    }
    __builtin_amdgcn_s_setprio(0);
}
#undef SBAR
}

#define XB_TMO      128
#define XB_XCNT(j)  (256  + 64 * (j))
#define XB_XSUB(j)  (1280 + 64 * (j))
#define XB_XGEN(j)  (2304 + 64 * (j))
#define XB_TOP      3328
#define XB_TOPGEN   3392
#define XCD_BAR_WORDS 3456
#define XB_SPIN_CAP (1u << 18)
__device__ __forceinline__ unsigned xb_ld(unsigned* p)              { return __hip_atomic_load(p, __ATOMIC_RELAXED, __HIP_MEMORY_SCOPE_AGENT); }
__device__ __forceinline__ unsigned xb_add(unsigned* p, unsigned v) { return __hip_atomic_fetch_add(p, v, __ATOMIC_RELAXED, __HIP_MEMORY_SCOPE_AGENT); }
__device__ __forceinline__ unsigned xb_xcc_id() { return (unsigned)__builtin_amdgcn_s_getreg((3 << 11) | 20) & 0xFu; }
#define XB_SPIN(cond, bar) do { unsigned _sp = 0; while (cond) { __builtin_amdgcn_s_sleep(1); \
    if ((++_sp & 255u) == 0u) { if (xb_ld(&(bar)[XB_TMO])) break; if (_sp > XB_SPIN_CAP) { atomicAdd(&(bar)[XB_TMO], 1u); break; } } } } while (0)
struct XcdBarrier { unsigned* bar; unsigned x; volatile LAS unsigned* st; };
__device__ __forceinline__ XcdBarrier xcd_barrier_post(unsigned* bar, volatile LAS unsigned* st) {
    XcdBarrier b; b.bar = bar; b.x = xb_xcc_id(); b.st = st;
    if (threadIdx.x == 0) (void)xb_add(&bar[XB_XCNT(b.x)], 1u);
    return b;
}
__device__ __forceinline__ void xcd_barrier_complete(unsigned* bar, unsigned x, unsigned& nloc, unsigned& nx) {
    const unsigned G = gridDim.x * gridDim.y * gridDim.z;
    unsigned sum, cnt, mine, sp = 0u;
    for (;;) {
        sum = 0u; cnt = 0u; mine = 0u;
#pragma unroll
        for (unsigned j = 0; j < 16; ++j) { const unsigned c = xb_ld(&bar[XB_XCNT(j)]); sum += c; cnt += (c > 0u) ? 1u : 0u; mine = (j == x) ? c : mine; }
        if (sum == G) break;
        __builtin_amdgcn_s_sleep(1);
        if ((++sp & 255u) == 0u) { if (xb_ld(&bar[XB_TMO])) break; if (sp > XB_SPIN_CAP) { atomicAdd(&bar[XB_TMO], 1u); break; } }
    }
    nloc = mine > 0u ? mine : 1u; nx = cnt > 0u ? cnt : 1u;
}
__device__ __forceinline__ void xcd_barrier(const XcdBarrier& b) {
    asm volatile("s_waitcnt vmcnt(0)" ::: "memory");
    __syncthreads();
    if (threadIdx.x == 0) {
        GAS unsigned* gbar = (GAS unsigned*)b.bar; unsigned bx_ = b.x;
        asm volatile("" : "+s"(gbar), "+s"(bx_));
        unsigned* bar = (unsigned*)gbar;
        __builtin_amdgcn_s_waitcnt(0);
        unsigned nloc = b.st[0], nx = b.st[1];
        if (nloc == 0u) { xcd_barrier_complete(bar, bx_, nloc, nx); b.st[0] = nloc; b.st[1] = nx; }
        const unsigned old = xb_add(&bar[XB_XSUB(bx_)], 1u);
        const unsigned gen = old / nloc;
        if (old + 1u == (gen + 1u) * nloc) {
            __builtin_amdgcn_fence(__ATOMIC_RELEASE, "agent");
            asm volatile("s_waitcnt vmcnt(0)" ::: "memory");
            const unsigned og = xb_add(&bar[XB_TOP], 1u);
            const unsigned tg = og / nx;
            if (og + 1u == (tg + 1u) * nx) xb_add(&bar[XB_TOPGEN], 1u);
            else XB_SPIN(xb_ld(&bar[XB_TOPGEN]) == tg, bar);
            __builtin_amdgcn_fence(__ATOMIC_ACQUIRE, "agent");
            xb_add(&bar[XB_XGEN(bx_)], 1u);
            asm volatile("s_waitcnt vmcnt(0)" ::: "memory");
        } else {
            XB_SPIN(xb_ld(&bar[XB_XGEN(bx_)]) == gen, bar);
            __builtin_amdgcn_fence(__ATOMIC_ACQUIRE, "agent");
            asm volatile("s_waitcnt vmcnt(0)" ::: "memory");
        }
    }
    __syncthreads();
}

struct Args {
    const float* in[24]; float* out; unsigned char* ws; int ph_lo, ph_hi;
};
enum { I_X = 0, I_C, I_POS, I_WADA, I_BADA, I_GATTN, I_WIN, I_DLAM, I_SUBG, I_RELB, I_QNORM, I_WUQ, I_KVNORM, I_WUKV, I_WO, I_GFFN, I_W1, I_W3, I_W2, I_ROUTER, I_MW1, I_MW3, I_MW2, I_GFINAL };

__device__ __forceinline__ int rowmap(int kind, int n) {
    switch (kind) {
        case 1: { if (n < C_KR) return n; const int i = n - C_KR; return C_KR + (i < 16 ? 2 * i : 2 * (i - 16) + 1); }
        case 2: { const int h = n / 96, j = n % 96; if (j < 64) return n; return h * 96 + 64 + (j < 80 ? 2 * (j - 64) : 2 * (j - 80) + 1); }
        case 3: { const int h = n >> 7, j = n & 127; return j < 64 ? h * 64 + j : 512 + h * 64 + (j - 64); }
        case 4: return (n >> 7) * 256 + (n & 127);
        case 5: return (n >> 7) * 256 + 128 + (n & 127);
        default: return n;
    }
}
__device__ __forceinline__ void transpose_item(const float* W, int K, int N, bf16_t* WT, int kind, const float* gain, LAS float* scr, int item, int lane) {
    const int nblk = N / 32, kb = item / nblk, nb = item % nblk, k0 = 64 * kb, n0 = 32 * nb;
#pragma unroll 8
    for (int i = 0; i < 32; ++i) { const int kk = 2 * i + (lane >> 5); float v = __builtin_nontemporal_load(W + (size_t)(k0 + kk) * N + n0 + (lane & 31)); if (gain) v *= gain[k0 + kk]; scr[kk * 33 + (lane & 31)] = v; }
    LDS_WAIT(); asm volatile("" ::: "memory");
    const int c = lane & 7;
#pragma unroll
    for (int j = 0; j < 4; ++j) { const int n = (lane >> 3) + 8 * j; const LAS float* s = scr + (8 * c) * 33 + n;
        u32x4 o; o.x = cvt_pk_bf16(s[0 * 33], s[1 * 33]); o.y = cvt_pk_bf16(s[2 * 33], s[3 * 33]); o.z = cvt_pk_bf16(s[4 * 33], s[5 * 33]); o.w = cvt_pk_bf16(s[6 * 33], s[7 * 33]);
        *(u32x4*)(WT + (size_t)rowmap(kind, n0 + n) * K + k0 + 8 * c) = o; }
    LDS_WAIT(); asm volatile("" ::: "memory");
}

__device__ __forceinline__ void transpose_item_f8(const float* W, int K, int N, unsigned char* WT, int kind, LAS float* scr, int item, int lane) {
    const int nblk = N / 32, kb = item / nblk, nb = item % nblk, k0 = 64 * kb, n0 = 32 * nb;
#pragma unroll 8
    for (int i = 0; i < 32; ++i) { const int kk = 2 * i + (lane >> 5); scr[kk * 33 + (lane & 31)] = __builtin_nontemporal_load(W + (size_t)(k0 + kk) * N + n0 + (lane & 31)) * WSCALE; }
    LDS_WAIT(); asm volatile("" ::: "memory");
#pragma unroll
    for (int j = 0; j < 2; ++j) { const int idx = lane + 64 * j, n = idx >> 2, c = idx & 3; const LAS float* s = scr + (16 * c) * 33 + n;
        u32x4 o; o.x = pk_fp8x4(s[0 * 33], s[1 * 33], s[2 * 33], s[3 * 33]); o.y = pk_fp8x4(s[4 * 33], s[5 * 33], s[6 * 33], s[7 * 33]);
        o.z = pk_fp8x4(s[8 * 33], s[9 * 33], s[10 * 33], s[11 * 33]); o.w = pk_fp8x4(s[12 * 33], s[13 * 33], s[14 * 33], s[15 * 33]);
        *(u32x4*)(WT + (size_t)rowmap(kind, n0 + n) * K + k0 + 16 * c) = o; }
    LDS_WAIT(); asm volatile("" ::: "memory");
}

template <int PM = 7  >
__device__ __forceinline__ void prologue(LAS unsigned char* lds, int vcu, int G, int wv) {
    const int tid = otid(wv), lane = tid & 63, wave = wv;
    unsigned char* ws = karg_ws(okarg());
    if (PM & 1) {
        LAS float* sl = (LAS float*)lds;
        LAS float* red = (LAS float*)(lds + 32768);
        const float* c = karg_in(okarg(), I_C);
        for (int i = tid; i < NB * DM; i += 512) { const int b = i >> 10, k = i & 1023; const float v = c[i]; sl[k * 8 + b] = v / (1.f + __expf(-v)); }
        __syncthreads();
        float* mod = (float*)(ws + WS_MOD);
        for (int it = vcu; it < DEPTH * 48; it += G) {
            const int l = it / 48, n0 = (it % 48) * 128, cl = tid & 31, ks = tid >> 5;
            const float* wp = karg_in(okarg(), I_WADA) + (size_t)l * DM * 6144 + (size_t)(ks * 64) * 6144 + n0 + 4 * cl;
            f32x4 acc[8];
#pragma unroll
            for (int b = 0; b < 8; ++b) acc[b] = (f32x4){0.f, 0.f, 0.f, 0.f};
#pragma unroll 8
            for (int k = 0; k < 64; ++k) { const f32x4 w = __builtin_nontemporal_load((const f32x4*)(wp + (size_t)k * 6144));
                const f32x4 s0 = *(const LAS f32x4*)(sl + (ks * 64 + k) * 8), s1 = *(const LAS f32x4*)(sl + (ks * 64 + k) * 8 + 4);
                acc[0] += w * s0[0]; acc[1] += w * s0[1]; acc[2] += w * s0[2]; acc[3] += w * s0[3]; acc[4] += w * s1[0]; acc[5] += w * s1[1]; acc[6] += w * s1[2]; acc[7] += w * s1[3]; }
#pragma unroll
            for (int b = 0; b < 8; ++b) *(LAS f32x4*)(red + (ks * 8 + b) * 128 + 4 * cl) = acc[b];
            __syncthreads();
            for (int o = tid; o < 1024; o += 512) { const int b = o >> 7, n = o & 127; float s = 0.f;
#pragma unroll
                for (int k2 = 0; k2 < 16; ++k2) s += red[(k2 * 8 + b) * 128 + n];
                mod[((size_t)l * 8 + b) * 6144 + n0 + n] = s + karg_in(okarg(), I_BADA)[(size_t)l * 6144 + n0 + n]; }
            __syncthreads();
        }
    }
    {
        const int* pos = (const int*)karg_in(okarg(), I_POS);
        float* cs = (float*)(ws + WS_CS);
        for (int i = vcu * 512 + tid; i < M * 16; i += G * 512) {
            const int row = i >> 4, f = i & 15;
            const double base[4] = {1.0, 0.5623413251903491, 0.31622776601683794, 0.1778279410038923};
            double inv = base[f & 3]; for (int q = 0; q < (f >> 2); ++q) inv *= 0.1;
            const double rev = (double)pos[row] * inv * 0.15915494309189535;
            const float fr = (float)(rev - rint(rev));
            cs[2 * i] = __builtin_amdgcn_cosf(fr); cs[2 * i + 1] = __builtin_amdgcn_sinf(fr);
        }
        int* kmax = (int*)(ws + WS_MISC) + 64; int* qmin = kmax + 256; float* lamv = (float*)(ws + WS_MISC);
        if (vcu == 1 % G) {
            if (tid < 256) { int mx = pos[tid * 64]; for (int k = 1; k < 64; ++k) { const int p = pos[tid * 64 + k]; mx = p > mx ? p : mx; } kmax[tid] = mx; }
            { int mn = pos[tid * 32]; for (int k = 1; k < 32; ++k) { const int p = pos[tid * 32 + k]; mn = p < mn ? p : mn; } qmin[tid] = mn; }
        }
        if (vcu == 3 % G && tid < 128) ((int*)(ws + WS_MISC))[2048 + tid] = att::rel_bucket(tid);
        if (vcu == 2 % G && tid < DEPTH) {
            const float* lv = karg_in(okarg(), I_DLAM) + tid * 256; float s1 = 0.f, s2 = 0.f;
            for (int k = 0; k < 64; ++k) { s1 += lv[k] * lv[64 + k]; s2 += lv[128 + k] * lv[192 + k]; }
            lamv[tid] = expf(s1) - expf(s2) + (0.8f - 0.6f * expf(-0.3f * (float)tid));
        }
    }
    __syncthreads();
    if ((F8_UP == 2 || IN_I8) && (PM & 2)) {
        LAS float* scr = (LAS float*)lds; LAS float* red = (LAS float*)(lds + 133120); LAS float* cinv = (LAS float*)(lds + 133120 + 2048);
        constexpr int N_UP = (F8_UP == 2) ? 36 * 88 : 0, N_IN = IN_I8 ? 4 * 69 : 0;
#define LBAR() asm volatile("s_waitcnt lgkmcnt(0)\n\ts_barrier" ::: "memory")
#define STRIP_SRC(it_, W_, ldw_, n0_) do { if ((it_) < N_UP) { const int mat_ = (it_) / 88, w3_ = mat_ & 1, dm_ = mat_ >> 1; n0_ = ((it_) % 88) * 32; ldw_ = DFF; \
                W_ = (dm_ < 2) ? karg_in(okarg(), w3_ ? I_W3 : I_W1) + (size_t)dm_ * DM * DFF : karg_in(okarg(), w3_ ? I_MW3 : I_MW1) + (size_t)(dm_ - 2) * DM * DFF; } \
            else { const int r_ = (it_) - N_UP; n0_ = (r_ % 69) * 32; ldw_ = INW; W_ = karg_in(okarg(), I_WIN) + (size_t)(r_ / 69) * DM * INW; } } while (0)
#define STRIP_LOAD(it_) do { const float* W_; int ldw_, n0_; STRIP_SRC(it_, W_, ldw_, n0_); const float* wp_ = W_ + (size_t)(128 * wave + (lane >> 5)) * ldw_ + n0_ + (lane & 31); \
            _Pragma("unroll") for (int i = 0; i < 64; ++i) rv[i] = __builtin_nontemporal_load(wp_ + (size_t)(2 * i) * ldw_); } while (0)
        float rv[64];
        if (vcu < N_UP + N_IN) STRIP_LOAD(vcu);
        for (int it = vcu; it < N_UP + N_IN; it += G) {
            unsigned char* WT; float* sc; int n0, kind;
            if (it < N_UP) { const int mat = it / 88, w3 = mat & 1, dm = mat >> 1;
                n0 = (it % 88) * 32; kind = 4 + w3;
                WT = (dm < 2) ? ws + WS_WD13 + (size_t)dm * 2 * DFF * DM : ws + WS_WM13 + (size_t)(dm - 2) * 2 * DFF * DM;
                sc = (float*)(ws + WS_WSC) + (size_t)dm * (2 * DFF);
            } else { const int r = it - N_UP, l = r / 69; n0 = (r % 69) * 32; kind = 1;
                WT = ws + WS_WIN + (size_t)l * INP * DM; sc = (float*)(ws + WS_WSC2) + (size_t)l * INP; }
#pragma unroll
            for (int i = 0; i < 64; ++i) { const int k = 128 * wave + 2 * i + (lane >> 5), n = lane & 31; scr[k * 32 + ((n + (k >> 4)) & 31)] = rv[i]; }
            if (it + G < N_UP + N_IN) STRIP_LOAD(it + G);
            LBAR();
            { const int n = tid & 31, ks = tid >> 5; float m = 0.f;
#pragma unroll 16
              for (int k = 64 * ks; k < 64 * ks + 64; ++k) m = fmaxf(m, fabsf(scr[k * 32 + ((n + (k >> 4)) & 31)]));
              red[ks * 32 + n] = m; }
            LBAR();
            if (tid < 32) { float m = 0.f;
#pragma unroll
                for (int s = 0; s < 16; ++s) m = fmaxf(m, red[s * 32 + tid]);
                cinv[tid] = m > 0.f ? 127.f / m : 0.f; sc[rowmap(kind, n0 + tid)] = m > 0.f ? m * (1.f / 127.f) : 1.f; }
            LBAR();
#pragma unroll
            for (int j = 0; j < 4; ++j) { const int nl = 4 * wave + j, c = lane; const float iv = cinv[nl];
                const LAS float* s = scr + (16 * c) * 32 + ((nl + c) & 31);
                u32x4 o; o.x = pk_i8x4(s[0] * iv, s[32] * iv, s[64] * iv, s[96] * iv); o.y = pk_i8x4(s[128] * iv, s[160] * iv, s[192] * iv, s[224] * iv);
                o.z = pk_i8x4(s[256] * iv, s[288] * iv, s[320] * iv, s[352] * iv); o.w = pk_i8x4(s[384] * iv, s[416] * iv, s[448] * iv, s[480] * iv);
                *(u32x4*)(WT + (size_t)rowmap(kind, n0 + nl) * DM + 16 * c) = o; }
            LBAR();
        }
#undef LBAR
#undef STRIP_SRC
#undef STRIP_LOAD
    }
    if (PM & 4) {
        LAS float* scr = (LAS float*)(lds + wave * 16384);
        const int gw = vcu * 8 + wave, NGW = G * 8;
        constexpr int IA = 16 * 69, IB = 6 * 24, IC = 4 * 32, ID = 16 * 32, IE = 16 * 88, IF = 44 * 32;
        constexpr int NA = IN_I8 ? 0 : 4 * IA, NBq = 4 * IB, NC = 4 * IC, ND = 4 * ID, NE = (F8_UP == 2) ? 0 : 4 * IE, NF = 2 * IF, NG = (F8_UP == 2) ? 0 : 32 * IE, NH = 16 * IF;
        constexpr int NITEMS = NA + NBq + NC + ND + NE + NF + NG + NH;
        struct TD { const float* W; const float* gain; unsigned char* WT; int K, N, kind, f8, item; };
#define TDEC(it_, d) do { int r = (it_); \
            if (r < NA) { const int l = r / IA; d = TD{karg_in(okarg(), I_WIN) + (size_t)l * DM * INW, nullptr, ws + WS_WIN + (size_t)l * INP * DM * 2, DM, INW, 1, 0, r % IA}; break; } r -= NA; \
            if (r < NBq) { const int l = r / IB; d = TD{karg_in(okarg(), I_WUQ) + (size_t)l * QR * NQ, karg_in(okarg(), I_QNORM) + l * QR, ws + WS_WUQ + (size_t)l * NQ * QR * 2, QR, NQ, 2, 0, r % IB}; break; } r -= NBq; \
            if (r < NC) { const int l = r / IC; d = TD{karg_in(okarg(), I_WUKV) + (size_t)l * KVR * NKV, karg_in(okarg(), I_KVNORM) + l * KVR, ws + WS_WUKV + (size_t)l * NKV * KVR * 2, KVR, NKV, 3, 0, r % IC}; break; } r -= NC; \
            if (r < ND) { const int l = r / ID; d = TD{karg_in(okarg(), I_WO) + (size_t)l * DM * DM, nullptr, ws + WS_WO + (size_t)l * DM * DM * 2, DM, DM, 0, 0, r % ID}; break; } r -= ND; \
            if (r < NE) { const int j = r / IE, dl = j >> 1, w3 = j & 1; d = TD{karg_in(okarg(), w3 ? I_W3 : I_W1) + (size_t)dl * DM * DFF, nullptr, ws + WS_WD13 + (size_t)dl * 2 * DFF * DM * (F8_UP ? 1 : 2), DM, DFF, 4 + w3, F8_UP ? 1 : 0, r % IE}; break; } r -= NE; \
            if (r < NF) { const int dl = r / IF; d = TD{karg_in(okarg(), I_W2) + (size_t)dl * DFF * DM, nullptr, ws + WS_WD2 + (size_t)dl * DM * DFF, DFF, DM, 0, 1, r % IF}; break; } r -= NF; \
            if (r < NG) { const int j = r / IE, me = j >> 1, w3 = j & 1; d = TD{karg_in(okarg(), w3 ? I_MW3 : I_MW1) + (size_t)me * DM * DFF, nullptr, ws + WS_WM13 + (size_t)me * 2 * DFF * DM * (F8_UP ? 1 : 2), DM, DFF, 4 + w3, F8_UP ? 1 : 0, r % IE}; break; } r -= NG; \
            { const int me = r / IF; d = TD{karg_in(okarg(), I_MW2) + (size_t)me * DFF * DM, nullptr, ws + WS_WM2 + (size_t)me * DM * DFF, DFF, DM, 0, 1, r % IF}; } } while (0)
#define TLOAD(d) do { const int nblk_ = d.N / 32, k0_ = 64 * (d.item / nblk_), n0_ = 32 * (d.item % nblk_); const float* wp_ = d.W + (size_t)(k0_ + (lane >> 5)) * d.N + n0_ + (lane & 31); \
            _Pragma("unroll") for (int i = 0; i < 32; ++i) tv[i] = __builtin_nontemporal_load(wp_ + (size_t)(2 * i) * d.N); } while (0)
        float tv[32]; TD cur{}, nxt{};
        if (gw < NITEMS) { TDEC(gw, cur); TLOAD(cur); }
        for (int it = gw; it < NITEMS; it += NGW) {
            const int nblk = cur.N / 32, k0 = 64 * (cur.item / nblk), n0 = 32 * (cur.item % nblk);
#pragma unroll
            for (int i = 0; i < 32; ++i) { const int kk = 2 * i + (lane >> 5); float v = tv[i]; if (cur.gain) v *= cur.gain[k0 + kk]; if (cur.f8) v *= WSCALE; scr[kk * 33 + (lane & 31)] = v; }
            const bool hn = it + NGW < NITEMS;
            if (hn) { TDEC(it + NGW, nxt); TLOAD(nxt); }
            LDS_WAIT(); asm volatile("" ::: "memory");
            if (cur.f8) {
#pragma unroll
                for (int j = 0; j < 2; ++j) { const int idx = lane + 64 * j, n = idx >> 2, c = idx & 3; const LAS float* s = scr + (16 * c) * 33 + n;
                    u32x4 o; o.x = pk_fp8x4(s[0 * 33], s[1 * 33], s[2 * 33], s[3 * 33]); o.y = pk_fp8x4(s[4 * 33], s[5 * 33], s[6 * 33], s[7 * 33]);
                    o.z = pk_fp8x4(s[8 * 33], s[9 * 33], s[10 * 33], s[11 * 33]); o.w = pk_fp8x4(s[12 * 33], s[13 * 33], s[14 * 33], s[15 * 33]);
                    *(u32x4*)(cur.WT + (size_t)rowmap(cur.kind, n0 + n) * cur.K + k0 + 16 * c) = o; }
            } else { const int c = lane & 7;
#pragma unroll
                for (int j = 0; j < 4; ++j) { const int n = (lane >> 3) + 8 * j; const LAS float* s = scr + (8 * c) * 33 + n;
                    u32x4 o; o.x = cvt_pk_bf16(s[0 * 33], s[1 * 33]); o.y = cvt_pk_bf16(s[2 * 33], s[3 * 33]); o.z = cvt_pk_bf16(s[4 * 33], s[5 * 33]); o.w = cvt_pk_bf16(s[6 * 33], s[7 * 33]);
                    *(u32x4*)((bf16_t*)cur.WT + (size_t)rowmap(cur.kind, n0 + n) * cur.K + k0 + 8 * c) = o; }
            }
            LDS_WAIT(); asm volatile("" ::: "memory");
            cur = nxt;
        }
#undef TDEC
#undef TLOAD
    }    __syncthreads();
}

template <int MODE, int F8O = 0, bool XF32 = false, int RPG = 4  >
__device__ __forceinline__ void norm_phase(const void* xin_, void* xout_, float* asc, const bf16_t* yp, const int* slot0, const int* slot1, const float* gate_prev  ,
                                           const float* gvec, const float* modl, int ch_sh, int ch_sc, bf16_t* H,
                                           const float* wrouter, unsigned* cnt, int* re0, int* re1, int* rr0, int* rr1, float* rg0, float* rg1,
                                           LAS unsigned char* lds, int vcu, int G, int wv) {
    const int tid = otid(wv), lane = tid & 63, wave = wv;
    const int gw = vcu * 8 + wave;
    LAS float* wr_l = (LAS float*)lds;
    LAS int* rsel = (LAS int*)(lds + 40960); LAS float* rgate = (LAS float*)(lds + 40960 + 512); LAS int* rrank = (LAS int*)(lds + 40960 + 1024); LAS int* rbase = (LAS int*)(lds + 40960 + 1536);
    if (MODE == 1) { for (int i = tid; i < DM * NEXP / 4; i += 512) { const int col = i >> 1; *(LAS f32x4*)(wr_l + col * 8 + (col >> 2) * 4 + 4 * (i & 1)) = ((const f32x4*)wrouter)[i]; } __syncthreads(); }
    const int mbase = gw * 8, b = mbase >> 11;
    f32x4 gs[4], sh4[4], gp[4];
#pragma unroll
    for (int j = 0; j < 4; ++j) { const int col = 4 * lane + 256 * j;
        if (MODE == 2) gs[j] = *(const f32x4*)(gvec + col);
        else { gs[j] = *(const f32x4*)(gvec + col) * (*(const f32x4*)(modl + (size_t)b * 6144 + ch_sc * DM + col) + 1.0f); sh4[j] = *(const f32x4*)(modl + (size_t)b * 6144 + ch_sh * DM + col); }
        if (yp) gp[j] = *(const f32x4*)(gate_prev + (size_t)b * 6144 + col) + 1.0f; }
    static_assert(RPG == 4 || (RPG == 8 && !XF32), "norm_phase row groups");
#pragma unroll 1
    for (int grp = 0; grp < 8 / RPG; ++grp) {
        const int m0 = mbase + grp * RPG;
        f32x4 vx[XF32 ? 4 : 1][4]; u32x2 raw[XF32 ? 1 : RPG][4]; u32x2 y0[4][4], y1[4][4]; int s1v[4];
        if (yp && RPG == 4) {
#pragma unroll
            for (int r = 0; r < 4; ++r) { const int m = m0 + r;
                const int s0 = slot0 ? __builtin_amdgcn_readfirstlane(slot0[m]) : m; s1v[r] = slot1 ? __builtin_amdgcn_readfirstlane(slot1[m]) : -1;
#pragma unroll
                for (int j = 0; j < 4; ++j) { const int col = 4 * lane + 256 * j; y0[r][j] = *(const u32x2*)(yp + (size_t)s0 * DM + col); if (s1v[r] >= 0) y1[r][j] = *(const u32x2*)(yp + (size_t)s1v[r] * DM + col); } }
        }
#pragma unroll
        for (int r = 0; r < RPG; ++r)
#pragma unroll
            for (int j = 0; j < 4; ++j) { const size_t off = (size_t)(m0 + r) * DM + 4 * lane + 256 * j;
                if (XF32) vx[r][j] = *(const f32x4*)((const float*)xin_ + off);
                else raw[r][j] = *(const u32x2*)((const bf16_t*)xin_ + off); }
#pragma unroll
        for (int r = 0; r < RPG; ++r) {
            const int m = m0 + r;
            f32x4 vr[4];
#pragma unroll
            for (int j = 0; j < 4; ++j) { if (XF32) vr[j] = vx[r][j]; else { const u32x2 w = raw[r][j]; vr[j] = (f32x4){bf_lo(w.x), bf_hi(w.x), bf_lo(w.y), bf_hi(w.y)}; } }
            if (yp && RPG == 4) {
#pragma unroll
                for (int j = 0; j < 4; ++j) { const int col = 4 * lane + 256 * j;
                    f32x4 y = (f32x4){bf_lo(y0[r & 3][j].x), bf_hi(y0[r & 3][j].x), bf_lo(y0[r & 3][j].y), bf_hi(y0[r & 3][j].y)};
                    if (s1v[r & 3] >= 0) y += (f32x4){bf_lo(y1[r & 3][j].x), bf_hi(y1[r & 3][j].x), bf_lo(y1[r & 3][j].y), bf_hi(y1[r & 3][j].y)};
                    vr[j] += gp[j] * y;
                    if (MODE != 2) { u32x2 w; w.x = cvt_pk_bf16(vr[j][0], vr[j][1]); w.y = cvt_pk_bf16(vr[j][2], vr[j][3]); *(u32x2*)((bf16_t*)xout_ + (size_t)m * DM + col) = w; } }
            }
            float ss = 0.f;
#pragma unroll
            for (int j = 0; j < 4; ++j) ss += (vr[j][0] * vr[j][0] + vr[j][1] * vr[j][1]) + (vr[j][2] * vr[j][2] + vr[j][3] * vr[j][3]);
            const float rs = 1.0f / sqrtf(wave_sum(ss) * (1.f / DM) + EPS);
            if (MODE == 2) {
#pragma unroll
                for (int j = 0; j < 4; ++j) *(f32x4*)((float*)xout_ + (size_t)m * DM + 4 * lane + 256 * j) = vr[j] * rs * gs[j];
            } else {
                float lg[NEXP];
#pragma unroll
                for (int e = 0; e < NEXP; ++e) lg[e] = 0.f;
                float qinv = 0.f;
                if (F8O == 2) {
                    float am = 0.f;
#pragma unroll
                    for (int j = 0; j < 4; ++j) { const f32x4 h = vr[j] * rs * gs[j] + sh4[j]; am = fmaxf(am, fmaxf(fmaxf(fabsf(h[0]), fabsf(h[1])), fmaxf(fabsf(h[2]), fabsf(h[3])))); }
                    am = wave_max(am); qinv = am > 0.f ? 127.f / am : 0.f; if (lane == 0) asc[m] = am > 0.f ? am * (1.f / 127.f) : 1.f;
                }
#pragma unroll
                for (int j = 0; j < 4; ++j) {
                    const int col = 4 * lane + 256 * j;
                    const f32x4 h = vr[j] * rs * gs[j] + sh4[j];
                    if (F8O == 2) *(unsigned*)((unsigned char*)H + (size_t)m * DM + col) = pk_i8x4(h[0] * qinv, h[1] * qinv, h[2] * qinv, h[3] * qinv);
                    else if (F8O == 1) *(unsigned*)((unsigned char*)H + (size_t)m * DM + col) = pk_fp8x4(h[0] * HSCALE, h[1] * HSCALE, h[2] * HSCALE, h[3] * HSCALE);
                    else { u32x2 w; w.x = cvt_pk_bf16(h[0], h[1]); w.y = cvt_pk_bf16(h[2], h[3]); *(u32x2*)(H + (size_t)m * DM + col) = w; }
                    if (MODE == 1) {
#pragma unroll
                        for (int k = 0; k < 4; ++k) { const f32x4 w0 = *(const LAS f32x4*)(wr_l + (col + k) * 8 + (col >> 2) * 4), w1 = *(const LAS f32x4*)(wr_l + (col + k) * 8 + (col >> 2) * 4 + 4);
                            lg[0] += h[k] * w0[0]; lg[1] += h[k] * w0[1]; lg[2] += h[k] * w0[2]; lg[3] += h[k] * w0[3]; lg[4] += h[k] * w1[0]; lg[5] += h[k] * w1[1]; lg[6] += h[k] * w1[2]; lg[7] += h[k] * w1[3]; }
                    }
                }
                if (MODE == 1) {
#pragma unroll
                    for (int e = 0; e < NEXP; ++e) lg[e] = wave_sum(lg[e]);
                    int e0 = 0; float v0 = lg[0];
#pragma unroll
                    for (int e = 1; e < NEXP; ++e) if (lg[e] > v0) { v0 = lg[e]; e0 = e; }
                    int e1 = -1; float v1 = -INFINITY;
#pragma unroll
                    for (int e = 0; e < NEXP; ++e) if (e != e0 && lg[e] > v1) { v1 = lg[e]; e1 = e; }
                    const float g0 = 1.f / (1.f + __expf(v1 - v0)), g1 = 1.f - g0;
                    if (lane == 0) { const int rl = m - vcu * 64; rsel[rl * 2] = e0; rsel[rl * 2 + 1] = e1; rgate[rl * 2] = g0; rgate[rl * 2 + 1] = g1; }
                }
            }
        }
    }
    if (MODE == 1) {
        __syncthreads();
        if (tid < NEXP) { int c = 0; for (int p = 0; p < 128; ++p) if (rsel[p] == tid) { rrank[p] = c; ++c; }
            rbase[tid] = c ? (int)__hip_atomic_fetch_add(cnt + tid, (unsigned)c, RLX_AGENT) : 0; }
        __syncthreads();
        if (tid < 64) { const int m = vcu * 64 + tid; const int e0 = rsel[2 * tid], e1 = rsel[2 * tid + 1];
            re0[m] = e0; re1[m] = e1; rr0[m] = rbase[e0] + rrank[2 * tid]; rr1[m] = rbase[e1] + rrank[2 * tid + 1]; rg0[m] = rgate[2 * tid]; rg1[m] = rgate[2 * tid + 1]; }
    }
}

__device__ __forceinline__ void gather_phase(const bf16_t* H, bf16_t* HP, unsigned* cnt, const int* re0, const int* re1, const int* rr0, const int* rr1, const float* rg0, const float* rg1,
                                             int* slot0, int* slot1, float* gslot, int* pexp, const float* asc, float* asl, int vcu, int G, int wv) {
    const int tid = otid(wv), lane = tid & 63, wave = wv;
    const int gw = vcu * 8 + wave, NGW = G * 8;
    int off[NEXP]; int tot;
    { int s = 0;
#pragma unroll
        for (int e = 0; e < NEXP; ++e) { off[e] = s; s += (((int)__hip_atomic_load(cnt + e, RLX_AGENT) + 255) >> 8) << 8; }
        tot = s; }
    if (vcu == 0 && tid < 160) {
        int e = 0;
#pragma unroll
        for (int k = 1; k < NEXP; ++k) e += (tid * 256 >= off[k]) ? 1 : 0;
        pexp[tid] = e; if (tid == 0) pexp[160] = tot >> 8;
    }
    static_assert(F8_UP != 0, "gather_phase: 1-byte activation rows");
    const int m0 = gw * 8; (void)NGW;
    int s0[8], s1[8]; u32x4 xr[8];
#pragma unroll
    for (int k = 0; k < 8; ++k) { const int m = m0 + k; const int e0 = re0[m], e1 = re1[m]; int o0 = 0, o1 = 0;
#pragma unroll
        for (int e = 0; e < NEXP; ++e) { o0 = (e == e0) ? off[e] : o0; o1 = (e == e1) ? off[e] : o1; }
        s0[k] = o0 + rr0[m]; s1[k] = o1 + rr1[m];
        xr[k] = ((const u32x4*)((const unsigned char*)H + (size_t)m * DM))[lane]; }
#pragma unroll
    for (int k = 0; k < 8; ++k) { ((u32x4*)((unsigned char*)HP + (size_t)s0[k] * DM))[lane] = xr[k]; ((u32x4*)((unsigned char*)HP + (size_t)s1[k] * DM))[lane] = xr[k]; }
    if (lane < 8) { const int m = m0 + lane; int sa = s0[0], sb = s1[0];
#pragma unroll
        for (int k = 1; k < 8; ++k) { sa = (lane == k) ? s0[k] : sa; sb = (lane == k) ? s1[k] : sb; }
        slot0[m] = sa; slot1[m] = sb; gslot[sa] = rg0[m]; gslot[sb] = rg1[m]; if (F8_UP == 2) { const float a = asc[m]; asl[sa] = a; asl[sb] = a; } }
}

__global__ void __launch_bounds__(512, 2) mk_fwd(Args args) {
    extern __shared__ __attribute__((aligned(16))) unsigned char lds_raw[];
    LAS unsigned char* lds = (LAS unsigned char*)lds_raw;
    volatile LAS unsigned* MISC = (volatile LAS unsigned*)(lds + MISC_OFF);
    const int tid = threadIdx.x; const int wv = __builtin_amdgcn_readfirstlane(tid >> 6);
    constexpr int G = 256;
    const int bx = blockIdx.x; const int vcu = (bx % 8) * (G / 8) + bx / 8;
    gu32* ctl = (gu32*)(karg_ws(okarg()) + WS_CTL);
    for (int u = tid; u < (LDS_BYTES - LDSCTL_OFF) / 4; u += 512) ((LAS unsigned*)(lds + LDSCTL_OFF))[u] = 0u;
    __syncthreads();
    XcdBarrier bar = xcd_barrier_post((unsigned*)ctl + CW_BAR, MISC + 8);
    const int lo = karg_lo(okarg()), hi = karg_hi(okarg());
#define IN(k) (lo <= (k) && (k) < hi)
#define SEAM(k) do { if (IN(k) && IN((k) + 1)) { xcd_barrier(bar); if (PREPS(9) == 2) xcd_barrier(bar); } } while (0)

#define WSP(T, off) ((T*)(w + (off)))
    if (IN(0)) { prologue<7>(lds, vcu, G, wv); if (PROBE_PMASK) prologue<PROBE_PMASK>(lds, vcu, G, wv); }
    SEAM(0);

    for (int l = 0; l < DEPTH; ++l) {
        const int pb = 1 + l * NPH_L; const bool moe = (l & 1) != 0; const int li = l >> 1;
        if (IN(pb + 0)) {
            kptr_t ka = okarg(); const int bxo = osi(bx), vco = osi(vcu); (void)bxo; (void)vco; unsigned char* w = karg_ws(ka); const float* modl = WSP(float, WS_MOD) + (size_t)l * 8 * 6144; int* RT = WSP(int, WS_ROUTE);
            if (PROBE_NORM & 1) { bf16_t* dx = (bf16_t*)(w + WS_U); bf16_t* dh = (bf16_t*)(w + WS_U + 64 * MiB); float* da = (float*)(w + WS_U + 128 * MiB);
                if (l == 0) norm_phase<0, IN_I8 ? 2 : 0, true>(karg_in(ka, I_X), nullptr, da, nullptr, nullptr, nullptr, nullptr, karg_in(ka, I_GATTN), modl, 0, 1, dh, nullptr, nullptr, nullptr, nullptr, nullptr, nullptr, nullptr, nullptr, lds, vco, G, wv);
                else { const bool pm = ((l - 1) & 1) != 0;
                    norm_phase<0, IN_I8 ? 2 : 0>(WSP(bf16_t, WS_XB), dx, da, WSP(bf16_t, WS_YP), pm ? RT + 6 * M : nullptr, pm ? RT + 7 * M : nullptr, WSP(float, WS_MOD) + (size_t)(l - 1) * 8 * 6144 + 5 * DM, karg_in(ka, I_GATTN) + l * DM, modl, 0, 1, dh, nullptr, nullptr, nullptr, nullptr, nullptr, nullptr, nullptr, nullptr, lds, vco, G, wv); }
                __syncthreads(); }
            if (l == 0) norm_phase<0, IN_I8 ? 2 : 0, true>(karg_in(ka, I_X), nullptr, WSP(float, WS_ROUTE) + 8 * M, nullptr, nullptr, nullptr, nullptr, karg_in(ka, I_GATTN), modl, 0, 1, WSP(bf16_t, WS_H), nullptr, nullptr, nullptr, nullptr, nullptr, nullptr, nullptr, nullptr, lds, vco, G, wv);
            else { const bool pm = ((l - 1) & 1) != 0;
                norm_phase<0, IN_I8 ? 2 : 0>(WSP(bf16_t, WS_XB), WSP(bf16_t, WS_XB), WSP(float, WS_ROUTE) + 8 * M, WSP(bf16_t, WS_YP), pm ? RT + 6 * M : nullptr, pm ? RT + 7 * M : nullptr, WSP(float, WS_MOD) + (size_t)(l - 1) * 8 * 6144 + 5 * DM, karg_in(ka, I_GATTN) + l * DM, modl, 0, 1, WSP(bf16_t, WS_H), nullptr, nullptr, nullptr, nullptr, nullptr, nullptr, nullptr, nullptr, lds, vco, G, wv); }
        }
        SEAM(pb + 0);
        if (IN(pb + 1)) {
            kptr_t ka = okarg(); const int bxo = osi(bx), vco = osi(vcu); (void)bxo; (void)vco; unsigned char* w = karg_ws(ka);
            constexpr int KI = IN_I8 ? DM / 2 : DM;
            pg8::Gemm g{WSP(bf16_t, WS_H), (const bf16_t*)(w + WS_WIN + (size_t)l * INP * DM * (IN_I8 ? 1 : 2)), KI, KI, KI, 0};
            pg8::GroupOrder S; S.init(M / 256, INP / 256, G, bxo, nullptr);
            pg8::EpiProj<IN_I8 != 0> E{WSP(bf16_t, WS_PROJ), WSP(float, WS_ROWSS), WSP(float, WS_CS), WSP(float, WS_ROUTE) + 8 * M, WSP(float, WS_WSC2) + (size_t)l * INP};
            for (int rp = 0; rp < PREPS(4); ++rp) pg8::gemm_phase<pg8::EpiProj<IN_I8 != 0>, true, IN_I8 ? 2 : 0>(lds, g, S, E, wv);
        }
        SEAM(pb + 1);
        if (IN(pb + 2)) { for (int rp = 0; rp < PREPS(5); ++rp) {
            { kptr_t ka = okarg(); const int bxo = osi(bx), vco = osi(vcu); (void)bxo; (void)vco; unsigned char* w = karg_ws(ka);
              pg8::Gemm g{WSP(bf16_t, WS_PROJ) + C_MQ, WSP(bf16_t, WS_WUQ) + (size_t)l * NQ * QR, INP, QR, QR, 0};
              pg8::GroupOrder S; S.init(M / 256, NQ / 256, G, bxo, nullptr);
              pg8::EpiQ E{WSP(bf16_t, WS_QM), WSP(float, WS_ROWSS), WSP(float, WS_CS)};
              pg8::gemm_phase<pg8::EpiQ, true>(lds, g, S, E, wv); }
            { kptr_t ka = okarg(); const int bxo = osi(bx), vco = osi(vcu); (void)bxo; (void)vco; unsigned char* w = karg_ws(ka);
              pg8::Gemm g{WSP(bf16_t, WS_PROJ) + C_MKV, WSP(bf16_t, WS_WUKV) + (size_t)l * NKV * KVR, INP, KVR, KVR, 0};
              pg8::GroupOrder S; S.init(M / 256, NKV / 256, G, G - 1 - bxo, nullptr);
              pg8::EpiKV E{WSP(bf16_t, WS_KN), WSP(bf16_t, WS_VM), WSP(float, WS_ROWSS)};
              pg8::gemm_phase<pg8::EpiKV, true>(lds, g, S, E, wv); }
        } }
        SEAM(pb + 2);
        if (IN(pb + 3)) {
            kptr_t ka = okarg(); const int bxo = osi(bx), vco = osi(vcu); (void)bxo; (void)vco; unsigned char* w = karg_ws(ka);
            att::AttnArgs A{WSP(int, WS_MISC) + 2048, WSP(bf16_t, WS_PROJ), WSP(bf16_t, WS_QM), WSP(bf16_t, WS_KN), WSP(bf16_t, WS_VM), WSP(bf16_t, WS_AO), WSP(float, WS_STASH), (const int*)karg_in(ka, I_POS),
                            WSP(int, WS_MISC) + 64, WSP(int, WS_MISC) + 64 + 256, karg_in(ka, I_RELB), karg_in(ka, I_SUBG) + l * 128,
                            WSP(float, WS_MISC)[l], 0.8f - 0.6f * __expf(-0.3f * (float)l)};
            for (int rp = 0; rp < PREPS(1); ++rp) att::attn_phase<0>(lds, A, ctl + CW_QCTR + 64 * l + 32 * rp, wv);
            if (PROBE_ABL >= 0) { att::AttnArgs A2 = A; A2.ao = WSP(bf16_t, WS_YP); att::attn_phase<(PROBE_ABL >= 0 ? PROBE_ABL : 0)>(lds, A2, ctl + CW_QCTR + 64 * l + 48, wv); }
        }
        SEAM(pb + 3);
        if (IN(pb + 4)) {
            kptr_t ka = okarg(); const int bxo = osi(bx), vco = osi(vcu); (void)bxo; (void)vco; unsigned char* w = karg_ws(ka);
            pg8::Gemm g{WSP(bf16_t, WS_AO), WSP(bf16_t, WS_WO) + (size_t)l * DM * DM, DM, DM, DM, 0};
            pg8::GroupOrder S; S.init(M / 256, DM / 256, G, bxo, nullptr);
            pg8::EpiRes E{l == 0 ? karg_in(ka, I_X) : nullptr, WSP(bf16_t, WS_XB), WSP(bf16_t, WS_XB), WSP(float, WS_MOD) + (size_t)l * 8 * 6144 + 2 * DM};
            pg8::gemm_phase<pg8::EpiRes, false>(lds, g, S, E, wv);
        }
        SEAM(pb + 4);
        if (IN(pb + 5)) {
            kptr_t ka = okarg(); const int bxo = osi(bx), vco = osi(vcu); (void)bxo; (void)vco; unsigned char* w = karg_ws(ka); const float* modl = WSP(float, WS_MOD) + (size_t)l * 8 * 6144; int* RT = WSP(int, WS_ROUTE);
            if (PROBE_NORM & 2) { bf16_t* dh = (bf16_t*)(w + WS_U + 64 * MiB); float* da = (float*)(w + WS_U + 128 * MiB); int* dr = (int*)(w + WS_U + 130 * MiB);
                if (moe) norm_phase<1, F8_UP>(WSP(bf16_t, WS_XB), nullptr, da, nullptr, nullptr, nullptr, nullptr, karg_in(ka, I_GFFN) + l * DM, modl, 3, 4, dh, karg_in(ka, I_ROUTER) + (size_t)li * DM * NEXP, (unsigned*)ctl + CW_CNT + 64 * li + 32,
                                   dr, dr + M, dr + 2 * M, dr + 3 * M, (float*)(dr + 4 * M), (float*)(dr + 5 * M), lds, vco, G, wv);
                else norm_phase<0, F8_UP>(WSP(bf16_t, WS_XB), nullptr, da, nullptr, nullptr, nullptr, nullptr, karg_in(ka, I_GFFN) + l * DM, modl, 3, 4, dh, nullptr, nullptr, nullptr, nullptr, nullptr, nullptr, nullptr, nullptr, lds, vco, G, wv);
                __syncthreads(); }
            if (moe) norm_phase<1, F8_UP, false, 8>(WSP(bf16_t, WS_XB), nullptr, WSP(float, WS_ROUTE) + 8 * M, nullptr, nullptr, nullptr, nullptr, karg_in(ka, I_GFFN) + l * DM, modl, 3, 4, WSP(bf16_t, WS_H), karg_in(ka, I_ROUTER) + (size_t)li * DM * NEXP, (unsigned*)ctl + CW_CNT + 64 * li,
                                   RT, RT + M, RT + 2 * M, RT + 3 * M, (float*)(RT + 4 * M), (float*)(RT + 5 * M), lds, vco, G, wv);
            else norm_phase<0, F8_UP, false, 8>(WSP(bf16_t, WS_XB), nullptr, WSP(float, WS_ROUTE) + 8 * M, nullptr, nullptr, nullptr, nullptr, karg_in(ka, I_GFFN) + l * DM, modl, 3, 4, WSP(bf16_t, WS_H), nullptr, nullptr, nullptr, nullptr, nullptr, nullptr, nullptr, nullptr, lds, vco, G, wv);
        }
        SEAM(pb + 5);
        if (IN(pb + 6)) { if (moe) { kptr_t ka = okarg(); const int bxo = osi(bx), vco = osi(vcu); (void)bxo; (void)vco; unsigned char* w = karg_ws(ka); int* RT = WSP(int, WS_ROUTE);
            for (int rp = 0; rp < PREPS(8); ++rp) gather_phase(WSP(bf16_t, WS_H), WSP(bf16_t, WS_HPERM), (unsigned*)ctl + CW_CNT + 64 * li, RT, RT + M, RT + 2 * M, RT + 3 * M, (float*)(RT + 4 * M), (float*)(RT + 5 * M), RT + 6 * M, RT + 7 * M,
                         WSP(float, WS_GSLOT), WSP(int, WS_MISC) + 1024, WSP(float, WS_ROUTE) + 8 * M, WSP(float, WS_ASL), vco, G, wv); } }
        if (moe) SEAM(pb + 6);
        if (IN(pb + 7)) {
            kptr_t ka = okarg(); const int bxo = osi(bx), vco = osi(vcu); (void)bxo; (void)vco; unsigned char* w = karg_ws(ka); const int* pexp = moe ? WSP(int, WS_MISC) + 1024 : nullptr;
            constexpr int KU = F8_UP ? DM / 2 : DM;
            pg8::Gemm g{moe ? WSP(bf16_t, WS_HPERM) : WSP(bf16_t, WS_H), (const bf16_t*)((moe ? w + WS_WM13 : w + WS_WD13) + (moe ? (size_t)li * 8 * 2 * DFF * DM : (size_t)li * 2 * DFF * DM) * (F8_UP ? 1 : 2)), KU, KU, KU, (size_t)2 * DFF * KU};
            pg8::GroupOrder S; S.init(moe ? __builtin_amdgcn_readfirstlane(pexp[160]) : M / 256, 2 * DFF / 256, G, bxo, pexp);
            pg8::EpiSwiGLU<F8_UP == 2> E{w + WS_U, 0, moe ? WSP(float, WS_ASL) : WSP(float, WS_ROUTE) + 8 * M, WSP(float, WS_WSC) + (size_t)(moe ? 2 + li * 8 : li) * (2 * DFF)};
            for (int rp = 0; rp < PREPS(2); ++rp) pg8::gemm_phase<pg8::EpiSwiGLU<F8_UP == 2>, true, F8_UP, 127 - F8_H_LOG2, 127 - F8_W_LOG2>(lds, g, S, E, wv);
        }
        SEAM(pb + 7);
        if (IN(pb + 8)) {
            kptr_t ka = okarg(); const int bxo = osi(bx), vco = osi(vcu); (void)bxo; (void)vco; unsigned char* w = karg_ws(ka); const int* pexp = moe ? WSP(int, WS_MISC) + 1024 : nullptr;
            pg8::Gemm g{WSP(bf16_t, WS_U), (const bf16_t*)(moe ? w + WS_WM2 + (size_t)li * 8 * DM * DFF : w + WS_WD2 + (size_t)li * DM * DFF), DFF / 2, DFF / 2, DFF / 2, (size_t)DM * DFF / 2};
            pg8::GroupOrder S; S.init(moe ? __builtin_amdgcn_readfirstlane(pexp[160]) : M / 256, DM / 256, G, bxo, pexp);
            pg8::EpiDown E{WSP(bf16_t, WS_YP), moe ? WSP(float, WS_GSLOT) : nullptr};
            for (int rp = 0; rp < PREPS(3); ++rp) pg8::gemm_phase<pg8::EpiDown, true, true, 127 - F8_U_LOG2, 127 - F8_W_LOG2>(lds, g, S, E, wv);
        }
        SEAM(pb + 8);
    }
    if (IN(NPHASE - 1)) {
        kptr_t ka = okarg(); const int bxo = osi(bx), vco = osi(vcu); (void)bxo; (void)vco; unsigned char* w = karg_ws(ka); int* RT = WSP(int, WS_ROUTE);
        norm_phase<2>(WSP(bf16_t, WS_XB), karg_out(ka), nullptr, WSP(bf16_t, WS_YP), RT + 6 * M, RT + 7 * M, WSP(float, WS_MOD) + (size_t)3 * 8 * 6144 + 5 * DM, karg_in(ka, I_GFINAL), nullptr, 0, 0, nullptr, nullptr, nullptr, nullptr, nullptr, nullptr, nullptr, nullptr, nullptr, lds, vco, G, wv);
    }
#undef WSP
#undef IN
#undef SEAM
}

extern "C" void kernel_launch(void* const* d_in, const int* in_sizes, int n_in, void* d_out, int out_size, void* d_ws, size_t ws_size, hipStream_t stream) {
    static int grid = 0;
    if (grid == 0) {
        if (n_in != 24 || out_size != M * DM || ws_size < WS_END) { fprintf(stderr, "kernel_launch: built for 24 inputs, out %d floats, >= %zu bytes of workspace; got n_in %d out %d ws %zu\n", M * DM, (size_t)WS_END, n_in, out_size, ws_size); grid = -1; return; }
        int dev = 0, cus = 0, per_cu = 0;
        if (hipGetDevice(&dev) != hipSuccess || hipDeviceGetAttribute(&cus, hipDeviceAttributeMultiprocessorCount, dev) != hipSuccess) { grid = -1; return; }
        if (hipFuncSetAttribute((const void*)mk_fwd, hipFuncAttributeMaxDynamicSharedMemorySize, LDS_BYTES) != hipSuccess) { fprintf(stderr, "kernel_launch: hipFuncSetAttribute failed\n"); grid = -1; return; }
        if (hipOccupancyMaxActiveBlocksPerMultiprocessor(&per_cu, (const void*)mk_fwd, 512, LDS_BYTES) != hipSuccess || per_cu < 1) fprintf(stderr, "kernel_launch: occupancy query reports %d\n", per_cu);
        (void)hipGetLastError();
        if (cus < 256) { fprintf(stderr, "kernel_launch: %d CUs; this kernel needs 256 co-resident workgroups (one per CU)\n", cus); grid = -1; return; }
        grid = 256;
    }
    if (grid < 0) return;
    if (hipMemsetAsync((char*)d_ws + WS_CTL, 0, CTL_ZERO_BYTES, stream) != hipSuccess) return;
    Args a{};
    for (int i = 0; i < 24; ++i) a.in[i] = (const float*)d_in[i];
    a.out = (float*)d_out; a.ws = (unsigned char*)d_ws;
#if MK_SPLIT
    for (int p = 0; p < NPHASE; ++p) {
        if (p >= 1 && p < NPHASE - 1) { const int l = (p - 1) / NPH_L, k = (p - 1) % NPH_L; if (k == 6 && !(l & 1)) continue; }
        a.ph_lo = p; a.ph_hi = p + 1;
        hipLaunchKernelGGL(mk_fwd, dim3(grid), dim3(512), LDS_BYTES, stream, a);
    }
#else
    a.ph_lo = 0; a.ph_hi = NPHASE;
    hipLaunchKernelGGL(mk_fwd, dim3(grid), dim3(512), LDS_BYTES, stream, a);
#endif
    const hipError_t le = hipPeekAtLastError();
    if (le != hipSuccess) fprintf(stderr, "kernel_launch: launch failed: %s\n", hipGetErrorName(le));
}
```
